# Optimizing an MI355X kernel written in HIP

```python
import jax, jax.numpy as jnp
from jax import lax
import numpy as np

D_MODEL = 1024
BATCH = 32
SEQ = 2048
DEPTH = 1

D_MIX = D_MODEL
HEAD_DIM = 64
RWKV_WIDTH = D_MIX // 2
RWKV_HEADS = RWKV_WIDTH // HEAD_DIM
ATTN_WIDTH = D_MIX - RWKV_WIDTH
ATTN_Q_HEADS = ATTN_WIDTH // HEAD_DIM
ATTN_KV_HEADS = 2
ATTN_GROUP = ATTN_Q_HEADS // ATTN_KV_HEADS
ATTN_KV_WIDTH = ATTN_KV_HEADS * HEAD_DIM
WINDOW = 128
D_DECAY_LORA = 32
D_AAA_LORA = 32
D_GATE_LORA = 96
RWKV_COLS = 3 * RWKV_WIDTH + D_DECAY_LORA + D_AAA_LORA + D_GATE_LORA
ATTN_COLS = ATTN_WIDTH + 2 * ATTN_KV_WIDTH
IN_COLS = RWKV_COLS + ATTN_COLS
PEER_HEADS = 8
PEER_N_KEYS = 128
PEER_N_EXPERTS = PEER_N_KEYS * PEER_N_KEYS
PEER_D_KEY = 256
PEER_HALF = PEER_D_KEY // 2
PEER_TOPK = 16
PEER_TOKEN_BLOCK = 128
RMS_EPS = 1e-6
LNX_EPS = 64e-5
NEG_INF = -1e30

kernel_name = "hymba_rwkv7_swa_sink_peer_block"


def rms_norm(x, g):
    xf = x.astype(jnp.float32)
    y = xf * lax.rsqrt(jnp.mean(xf * xf, axis=-1, keepdims=True) + RMS_EPS)
    return (y * g.astype(jnp.float32)).astype(x.dtype)


def token_shift(p, mu):
    prev = jnp.pad(p[:, :-1], ((0, 0), (1, 0), (0, 0)))
    return p + mu * (prev - p)


def rwkv7_mixer(p, mu, w0, w_up, a0, a_up, g_up, k_k, k_a, r_k, lnx_w, lnx_b):
    B, S, _ = p.shape
    H, Dh, W = RWKV_HEADS, HEAD_DIM, RWKV_WIDTH
    f32 = jnp.float32
    p = token_shift(p.astype(f32), mu.astype(f32))
    r = p[..., :W]
    k = p[..., W:2 * W]
    v = p[..., 2 * W:3 * W]
    xw = p[..., 3 * W:3 * W + D_DECAY_LORA]
    xa = p[..., 3 * W + D_DECAY_LORA:3 * W + D_DECAY_LORA + D_AAA_LORA]
    xg = p[..., 3 * W + D_DECAY_LORA + D_AAA_LORA:]
    w = -jax.nn.softplus(-(w0 + jnp.tanh(xw) @ w_up)) - 0.5
    decay = jnp.exp(-jnp.exp(w))
    a = jax.nn.sigmoid(a0 + xa @ a_up)
    g = jax.nn.sigmoid(xg) @ g_up
    heads = lambda t: t.reshape(B, S, H, Dh)
    kk = heads(k * k_k)
    kk = kk / jnp.maximum(jnp.sqrt(jnp.sum(kk * kk, axis=-1, keepdims=True)), 1e-12)
    k = k * (1.0 + (a - 1.0) * k_a)
    r_h, k_h, v_h, a_h, w_h = heads(r), heads(k), heads(v), heads(a), heads(decay)
    tm = lambda t: jnp.moveaxis(t, 1, 0)
    seqs = (tm(r_h), tm(w_h), tm(k_h), tm(v_h), tm(-kk), tm(kk * a_h))

    def step(state, inp):
        r_t, w_t, k_t, v_t, a_t, b_t = inp
        sa = jnp.einsum('bhvk,bhk->bhv', state, a_t)
        state = (state * w_t[:, :, None, :] + sa[..., None] * b_t[:, :, None, :]
                 + v_t[..., None] * k_t[:, :, None, :])
        return state, jnp.einsum('bhvk,bhk->bhv', state, r_t)

    s0 = jnp.zeros((B, H, Dh, Dh), f32)
    _, ys = lax.scan(step, s0, seqs)
    y = jnp.moveaxis(ys, 0, 1)
    mean = jnp.mean(y, axis=-1, keepdims=True)
    var = jnp.mean(jnp.square(y - mean), axis=-1, keepdims=True)
    y = ((y - mean) * lax.rsqrt(var + LNX_EPS)).reshape(B, S, W) * lnx_w + lnx_b
    bonus = jnp.sum(r_h * k_h * r_k, axis=-1, keepdims=True) * v_h
    y = (y + bonus.reshape(B, S, W)) * g
    return y


def swa_sink_attention(q, k, v, sinks):
    B, S, _ = q.shape
    nb = S // WINDOW
    KV, G, Dh = ATTN_KV_HEADS, ATTN_GROUP, HEAD_DIM
    f32 = jnp.float32
    scale = 1.0 / np.sqrt(Dh)
    q = q.reshape(B, nb, WINDOW, KV, G, Dh)
    k = k.reshape(B, nb, WINDOW, KV, Dh)
    v = v.reshape(B, nb, WINDOW, KV, Dh)
    prev = lambda t: jnp.concatenate([jnp.zeros_like(t[:, :1]), t[:, :-1]], axis=1)
    k_ext = jnp.concatenate([prev(k), k], axis=2)
    v_ext = jnp.concatenate([prev(v), v], axis=2)
    qi = jnp.arange(WINDOW)[:, None]
    kj = jnp.arange(2 * WINDOW)[None, :]
    diff = qi + WINDOW - kj
    band = (diff >= 0) & (diff < WINDOW)
    in_current = kj >= WINDOW
    sink_logits = sinks.astype(f32).reshape(KV, G, 1, 1)

    def block(args):
        q_b, k_b, v_b, n = args
        allowed = band & ((n > 0) | in_current)
        s = jnp.einsum('bqkgd,bskd->bkgqs', q_b.astype(f32), k_b.astype(f32)) * scale
        s = jnp.where(allowed, s, NEG_INF)
        sink = jnp.broadcast_to(sink_logits, s.shape[:-1] + (1,))
        pr = jax.nn.softmax(jnp.concatenate([s, sink], axis=-1), axis=-1)[..., :-1]
        o = jnp.einsum('bkgqs,bskd->bqkgd', pr, v_b.astype(f32))
        return o.astype(q_b.dtype)

    mv = lambda t: jnp.moveaxis(t, 1, 0)
    o = lax.map(block, (mv(q), mv(k_ext), mv(v_ext), jnp.arange(nb)))
    return jnp.moveaxis(o, 0, 1).reshape(B, S, ATTN_WIDTH)


def peer_ffn(h, wq, subkeys, u_tab, v_tab):
    B, S, D = h.shape
    T = B * S
    nblk = T // PEER_TOKEN_BLOCK
    K, H = PEER_TOPK, PEER_HEADS
    f32 = jnp.float32
    xb = h.reshape(nblk, PEER_TOKEN_BLOCK, D)

    def block(x_b):
        q = (x_b @ wq).reshape(-1, H, 2, PEER_HALF).astype(f32)
        s = jnp.einsum('thcd,hcnd->thcn', q, subkeys.astype(f32))
        s_top, i_top = lax.top_k(s, K)
        cand_s = (s_top[:, :, 0, :, None] + s_top[:, :, 1, None, :]).reshape(-1, H, K * K)
        cand_i = (i_top[:, :, 0, :, None] * PEER_N_KEYS + i_top[:, :, 1, None, :]).reshape(-1, H, K * K)
        best_s, best_pos = lax.top_k(cand_s, K)
        idx = jnp.take_along_axis(cand_i, best_pos, axis=-1).reshape(-1, H * K)
        gate = jax.nn.softmax(best_s, axis=-1).reshape(-1, H * K).astype(x_b.dtype)
        u = u_tab[idx]
        act = jax.nn.gelu(jnp.einsum('td,ted->te', x_b, u), approximate=False)
        return jnp.einsum('te,ted->td', gate * act, v_tab[idx])

    y = lax.map(block, xb)
    return y.reshape(B, S, D)


def setup_inputs(seed: int = 0) -> dict:
    key = jax.random.key(seed)
    ks = jax.random.split(key, 26)
    L, D, W = DEPTH, D_MODEL, RWKV_WIDTH
    nrm = lambda k, shape, s: jax.random.normal(k, shape, jnp.float32) * s
    return {
        "x": nrm(ks[0], (BATCH, SEQ, D), 1.0),
        "ln1_g": 1.0 + nrm(ks[1], (L, D), 0.02),
        "w_in": nrm(ks[2], (L, D, IN_COLS), D ** -0.5),
        "b_attn": nrm(ks[3], (L, ATTN_COLS), 0.02),
        "mu_shift": jax.random.uniform(ks[4], (L, RWKV_COLS), jnp.float32),
        "w0": jax.random.uniform(ks[5], (L, W), jnp.float32, -4.0, 1.0),
        "w_up": nrm(ks[6], (L, D_DECAY_LORA, W), 0.1),
        "a0": nrm(ks[7], (L, W), 0.1),
        "a_up": nrm(ks[8], (L, D_AAA_LORA, W), 0.1),
        "g_up": nrm(ks[9], (L, D_GATE_LORA, W), D_GATE_LORA ** -0.5),
        "k_k": 0.85 + nrm(ks[10], (L, W), 0.02),
        "k_a": 1.0 + nrm(ks[11], (L, W), 0.02),
        "r_k": nrm(ks[12], (L, RWKV_HEADS, HEAD_DIM), 0.1),
        "lnx_w": 1.0 + nrm(ks[13], (L, W), 0.02),
        "lnx_b": nrm(ks[14], (L, W), 0.02),
        "attn_sinks": nrm(ks[15], (L, ATTN_Q_HEADS), 1.0),
        "attn_norm_g": 1.0 + nrm(ks[16], (L, ATTN_WIDTH), 0.02),
        "w_out": nrm(ks[17], (L, D_MIX, D), D_MIX ** -0.5),
        "ln2_g": 1.0 + nrm(ks[18], (L, D), 0.02),
        "peer_wq": nrm(ks[19], (L, D, PEER_HEADS * PEER_D_KEY), D ** -0.5),
        "peer_subkeys": nrm(ks[20], (L, PEER_HEADS, 2, PEER_N_KEYS, PEER_HALF), PEER_HALF ** -0.5),
        "peer_u": nrm(ks[21], (L, PEER_N_EXPERTS, D), D ** -0.5),
        "peer_v": nrm(ks[22], (L, PEER_N_EXPERTS, D), PEER_HEADS ** -0.5),
        "lnf_g": 1.0 + nrm(ks[23], (D,), 0.02),
    }


def reference(x, ln1_g, w_in, b_attn, mu_shift, w0, w_up, a0, a_up, g_up, k_k, k_a, r_k,
              lnx_w, lnx_b, attn_sinks, attn_norm_g, w_out, ln2_g, peer_wq, peer_subkeys,
              peer_u, peer_v, lnf_g):
    for l in range(DEPTH):
        h = rms_norm(x, ln1_g[l])
        p = h @ w_in[l]
        p_rwkv = p[..., :RWKV_COLS]
        p_attn = p[..., RWKV_COLS:] + b_attn[l]
        y_rwkv = rwkv7_mixer(p_rwkv, mu_shift[l], w0[l], w_up[l], a0[l], a_up[l], g_up[l],
                             k_k[l], k_a[l], r_k[l], lnx_w[l], lnx_b[l]).astype(x.dtype)
        q = p_attn[..., :ATTN_WIDTH]
        k = p_attn[..., ATTN_WIDTH:ATTN_WIDTH + ATTN_KV_WIDTH]
        v = p_attn[..., ATTN_WIDTH + ATTN_KV_WIDTH:]
        y_attn = rms_norm(swa_sink_attention(q, k, v, attn_sinks[l]), attn_norm_g[l])
        x = x + jnp.concatenate([y_rwkv, y_attn], axis=-1) @ w_out[l]
        x = x + peer_ffn(rms_norm(x, ln2_g[l]), peer_wq[l], peer_subkeys[l], peer_u[l], peer_v[l])
    return rms_norm(x, lnf_g)
```

```cpp
#ifndef EMU
#include <hip/hip_runtime.h>
#include <hip/hip_cooperative_groups.h>
#include <cstdio>
#include <cstdint>
namespace cg = cooperative_groups;
typedef short bf16x8 __attribute__((ext_vector_type(8)));
typedef short bf16x4 __attribute__((ext_vector_type(4)));
typedef float f32x16 __attribute__((ext_vector_type(16)));
typedef float f32x4 __attribute__((ext_vector_type(4)));
typedef float f32x2 __attribute__((ext_vector_type(2)));
typedef unsigned u32x4 __attribute__((ext_vector_type(4)));
typedef unsigned u32x2 __attribute__((ext_vector_type(2)));
#define TID ((int)threadIdx.x)
#define BSYNC() __syncthreads()
#define WSYNC() __builtin_amdgcn_wave_barrier()
__device__ __forceinline__ float shfl_xor_f(float v, int m) { return __shfl_xor(v, m); }
__device__ __forceinline__ float shfl_f(float v, int s) { return __shfl(v, s); }
__device__ __forceinline__ int shfl_i(int v, int s) { return __shfl(v, s); }
__device__ __forceinline__ f32x16 mfma32(bf16x8 a, bf16x8 b, f32x16 c) { return __builtin_amdgcn_mfma_f32_32x32x16_bf16(a, b, c, 0, 0, 0); }
__device__ __forceinline__ f32x4 mfma16(bf16x8 a, bf16x8 b, f32x4 c) { return __builtin_amdgcn_mfma_f32_16x16x32_bf16(a, b, c, 0, 0, 0); }
#else
#define WSYNC() emu_barrier(g_wave_bar[TID >> 6], 64)
#endif

#ifndef CFG_BATCH
#define CFG_BATCH 32
#endif
#ifndef CFG_SEQ
#define CFG_SEQ 2048
#endif
constexpr int D = 1024, BATCH = CFG_BATCH, SEQ = CFG_SEQ, T = BATCH * SEQ;
constexpr int NTHR = 512;
constexpr int PCOLS = 2560;
constexpr int PC_R = 0, PC_K = 512, PC_V = 1024, PC_Q = 1536, PC_AK = 2048, PC_AV = 2176, PC_LORA = 2304;
constexpr int NEXP = 16384;
constexpr float RMS_EPS = 1e-6f, LNX_EPS = 64e-5f;

constexpr size_t MiB = 1u << 20;
constexpr size_t al1m(size_t x) { return (x + MiB - 1) / MiB * MiB; }
constexpr size_t WS_CTL = 0;
constexpr size_t WS_BIASP = 1 * MiB;
constexpr size_t WS_WINT = 2 * MiB;
constexpr size_t WS_WOUTT = 7 * MiB;
constexpr size_t WS_WFT = 9 * MiB;
constexpr size_t WS_UB = 16 * MiB;
constexpr size_t WS_VB = 48 * MiB;
constexpr size_t WS_H = 80 * MiB;
constexpr size_t WS_Y = WS_H + al1m((size_t)T * D * 2);
constexpr size_t WS_P = WS_Y + al1m((size_t)T * D * 2);
constexpr size_t WS_IDX = WS_P + al1m((size_t)T * PCOLS * 2);
constexpr size_t WS_GATE = WS_IDX + al1m((size_t)T * 128 * 4);
constexpr size_t WS_END = WS_GATE + al1m((size_t)T * 128 * 4);

struct Params {
    const float* x; const float* ln1_g; const float* w_in; const float* b_attn; const float* mu_shift; const float* w0; const float* w_up; const float* a0;
    const float* a_up; const float* g_up; const float* k_k; const float* k_a; const float* r_k; const float* lnx_w; const float* lnx_b; const float* attn_sinks;
    const float* attn_norm_g; const float* w_out; const float* ln2_g; const float* peer_wq; const float* peer_subkeys; const float* peer_u; const float* peer_v; const float* lnf_g;
    float* out; unsigned char* ws;
};

__device__ __forceinline__ unsigned f2bf(float f) { unsigned u = __builtin_bit_cast(unsigned, f); return (u + 0x7fffu + ((u >> 16) & 1u)) >> 16; }
__device__ __forceinline__ unsigned pk2(float lo, float hi) { return f2bf(lo) | (f2bf(hi) << 16); }
__device__ __forceinline__ float bfl(unsigned short b) { return __builtin_bit_cast(float, (unsigned)b << 16); }
__device__ __forceinline__ float bf_lo(unsigned w) { return __builtin_bit_cast(float, w << 16); }
__device__ __forceinline__ float bf_hi(unsigned w) { return __builtin_bit_cast(float, w & 0xffff0000u); }
__device__ __forceinline__ float wave_sum(float v) {
#pragma unroll
    for (int o = 1; o < 64; o <<= 1) v += shfl_xor_f(v, o);
    return v;
}
__device__ __forceinline__ int crow(int r, int hi) { return (r & 3) + 8 * (r >> 2) + 4 * hi; }
__device__ __forceinline__ int win_src_col(int n) { if (n < 1536) return n; if (n < 2304) return n + 160; if (n < 2464) return n - 768; return -1; }
__device__ __forceinline__ float sigmoidf_(float z) { return 1.f / (1.f + expf(-z)); }

__device__ __forceinline__ void p0_transpose_tile(const float* W, int K, int ldw, unsigned short* WT, int k0, int n0, int mode, float* tl) {
    const int t = TID, kk = t >> 6, nn = t & 63;
    const int sc = mode ? win_src_col(n0 + nn) : (n0 + nn);
#pragma unroll
    for (int i = 0; i < 8; ++i) { const int k = kk + 8 * i; tl[k * 65 + nn] = sc >= 0 ? W[(size_t)(k0 + k) * ldw + sc] : 0.f; }
    BSYNC();
    const int n = t >> 3, c = t & 7;
    u32x4 o;
    o.x = pk2(tl[(8 * c + 0) * 65 + n], tl[(8 * c + 1) * 65 + n]); o.y = pk2(tl[(8 * c + 2) * 65 + n], tl[(8 * c + 3) * 65 + n]);
    o.z = pk2(tl[(8 * c + 4) * 65 + n], tl[(8 * c + 5) * 65 + n]); o.w = pk2(tl[(8 * c + 6) * 65 + n], tl[(8 * c + 7) * 65 + n]);
    *(u32x4*)(WT + (size_t)(n0 + n) * K + k0 + 8 * c) = o;
    BSYNC();
}
__device__ __forceinline__ void p0_wfused_item(const float* wq, const float* sk, unsigned short* WfT, int hc, int kt, float* lds) {
    float* skl = lds;
    float* wql = lds + 128 * 129;
    for (int i = TID; i < 16384; i += NTHR) { const int n = i >> 7, d = i & 127; skl[n * 129 + d] = sk[(size_t)hc * 16384 + i]; }
    for (int i = TID; i < 64 * 128; i += NTHR) { const int k = i >> 7, d = i & 127; wql[d * 64 + k] = wq[(size_t)(kt * 64 + k) * 2048 + hc * 128 + d]; }
    BSYNC();
    const int n = TID & 127, kg = TID >> 7;
    float acc[16];
#pragma unroll
    for (int j = 0; j < 16; ++j) acc[j] = 0.f;
    for (int d = 0; d < 128; ++d) {
        const float a = skl[n * 129 + d]; const float* bp = wql + d * 64 + kg * 16;
#pragma unroll
        for (int j = 0; j < 16; ++j) acc[j] += a * bp[j];
    }
    unsigned short* dst = WfT + (size_t)(hc * 128 + n) * D + kt * 64 + kg * 16;
    u32x4 o0, o1;
    o0.x = pk2(acc[0], acc[1]); o0.y = pk2(acc[2], acc[3]); o0.z = pk2(acc[4], acc[5]); o0.w = pk2(acc[6], acc[7]);
    o1.x = pk2(acc[8], acc[9]); o1.y = pk2(acc[10], acc[11]); o1.z = pk2(acc[12], acc[13]); o1.w = pk2(acc[14], acc[15]);
    *(u32x4*)dst = o0; *(u32x4*)(dst + 8) = o1;
    BSYNC();
}
__device__ __forceinline__ void rms_rows(const float* X, const float* g, unsigned short* H, int gw, int ngw) {
    const int lane = TID & 63;
    for (int m = gw; m < T; m += ngw) {
        const f32x4* xr = (const f32x4*)(X + (size_t)m * D) + lane; f32x4 v[4]; float s = 0.f;
#pragma unroll
        for (int j = 0; j < 4; ++j) { v[j] = xr[64 * j]; s += (v[j].x * v[j].x + v[j].y * v[j].y) + (v[j].z * v[j].z + v[j].w * v[j].w); }
        const float rstd = 1.0f / sqrtf(wave_sum(s) * (1.f / D) + RMS_EPS);
        u32x2* o8 = (u32x2*)(H + (size_t)m * D) + lane;
#pragma unroll
        for (int j = 0; j < 4; ++j) { const f32x4 gg = ((const f32x4*)g)[lane + 64 * j]; u32x2 w; w.x = pk2(v[j].x * rstd * gg.x, v[j].y * rstd * gg.y); w.y = pk2(v[j].z * rstd * gg.z, v[j].w * rstd * gg.w); o8[64 * j] = w; }
    }
}
__device__ __forceinline__ void p0_prologue(const Params& p, int bid, int nblk, char* smem) {
    float* lds = (float*)smem;
    unsigned char* ws = p.ws;
    unsigned short* WinT = (unsigned short*)(ws + WS_WINT); unsigned short* WoutT = (unsigned short*)(ws + WS_WOUTT); unsigned short* WfT = (unsigned short*)(ws + WS_WFT);
    constexpr int I_IN = 640, I_OUT = 256, I_WF = 256;
    for (int it = bid; it < I_IN + I_OUT + I_WF; it += nblk) {
        int r = it;
        if (r < I_IN) { p0_transpose_tile(p.w_in, D, 2464, WinT, (r / 40) * 64, (r % 40) * 64, 1, lds); continue; } r -= I_IN;
        if (r < I_OUT) { p0_transpose_tile(p.w_out, D, D, WoutT, (r / 16) * 64, (r % 16) * 64, 0, lds); continue; } r -= I_OUT;
        p0_wfused_item(p.peer_wq, p.peer_subkeys, WfT, r / 16, r % 16, lds);
    }
    const size_t gt = (size_t)bid * NTHR + TID, ngt = (size_t)nblk * NTHR;
    float* biasP = (float*)(ws + WS_BIASP);
    for (size_t i = gt; i < (size_t)PCOLS; i += ngt) biasP[i] = (i >= 1536 && i < 2304) ? p.b_attn[i - 1536] : 0.f;
    unsigned short* Ub = (unsigned short*)(ws + WS_UB); unsigned short* Vb = (unsigned short*)(ws + WS_VB);
    for (size_t i = gt; i < (size_t)NEXP * D / 8; i += ngt) {
        const f32x4 a = ((const f32x4*)p.peer_u)[2 * i], b = ((const f32x4*)p.peer_u)[2 * i + 1];
        u32x4 o; o.x = pk2(a.x, a.y); o.y = pk2(a.z, a.w); o.z = pk2(b.x, b.y); o.w = pk2(b.z, b.w); ((u32x4*)Ub)[i] = o;
        const f32x4 c = ((const f32x4*)p.peer_v)[2 * i], d = ((const f32x4*)p.peer_v)[2 * i + 1];
        u32x4 q; q.x = pk2(c.x, c.y); q.y = pk2(c.z, c.w); q.z = pk2(d.x, d.y); q.w = pk2(d.z, d.w); ((u32x4*)Vb)[i] = q;
    }
    rms_rows(p.x, p.ln1_g, (unsigned short*)(ws + WS_H), bid * (NTHR / 64) + (TID >> 6), nblk * (NTHR / 64));
}

constexpr int RCH = 32;
__device__ __forceinline__ void rwkv_unit(const Params& p, int b, int h, char* smem) {
    float* fl = (float*)smem;
    float* wup = fl;
    float* aup = wup + 2048;
    float* gup = aup + 2048;
    float* lora = gup + 6144;
    float* r_l = lora + RCH * 160;
    float* w_l = r_l + RCH * 64;
    float* k_l = w_l + RCH * 64;
    float* v_l = k_l + RCH * 64;
    float* a_l = v_l + RCH * 64;
    float* b_l = a_l + RCH * 64;
    float* g_l = b_l + RCH * 64;
    float* o_l = g_l + RCH * 64;
    float* bon = o_l + RCH * 64;
    float* par = bon + RCH;
    const unsigned short* P = (const unsigned short*)(p.ws + WS_P);
    unsigned short* Y = (unsigned short*)(p.ws + WS_Y);
    const int tid = TID;
    for (int i = tid; i < 2048; i += NTHR) { const int j = i >> 6, ch = i & 63; wup[i] = p.w_up[j * 512 + h * 64 + ch]; aup[i] = p.a_up[j * 512 + h * 64 + ch]; }
    for (int i = tid; i < 6144; i += NTHR) { const int j = i >> 6, ch = i & 63; gup[i] = p.g_up[j * 512 + h * 64 + ch]; }
    if (tid < 64) {
        const int c = h * 64 + tid;
        par[tid] = p.mu_shift[c]; par[64 + tid] = p.mu_shift[512 + c]; par[128 + tid] = p.mu_shift[1024 + c];
        par[352 + tid] = p.w0[c]; par[416 + tid] = p.a0[c]; par[480 + tid] = p.k_k[c]; par[544 + tid] = p.k_a[c]; par[608 + tid] = p.r_k[c]; par[672 + tid] = p.lnx_w[c]; par[736 + tid] = p.lnx_b[c];
    }
    if (tid < 160) par[192 + tid] = p.mu_shift[1536 + tid];
    float st[8];
#pragma unroll
    for (int i = 0; i < 8; ++i) st[i] = 0.f;
    BSYNC();
#pragma unroll 1
    for (int s0 = 0; s0 < SEQ; s0 += RCH) {
#pragma unroll 2
        for (int e = tid; e < RCH * 352; e += NTHR) {
            const int tok = e / 352, c = e - tok * 352;
            int col; float mu;
            if (c < 64) { col = PC_R + h * 64 + c; mu = par[c]; }
            else if (c < 128) { col = PC_K + h * 64 + (c - 64); mu = par[c]; }
            else if (c < 192) { col = PC_V + h * 64 + (c - 128); mu = par[c]; }
            else { col = PC_LORA + (c - 192); mu = par[c]; }
            const size_t t = (size_t)b * SEQ + s0 + tok;
            const float pc = bfl(P[t * PCOLS + col]);
            const float pp = (s0 + tok > 0) ? bfl(P[(t - 1) * PCOLS + col]) : 0.f;
            const float ps = pc + mu * (pp - pc);
            if (c < 64) r_l[tok * 64 + c] = ps;
            else if (c < 128) k_l[tok * 64 + (c - 64)] = ps;
            else if (c < 192) v_l[tok * 64 + (c - 128)] = ps;
            else { const int j = c - 192; lora[tok * 160 + j] = j < 32 ? tanhf(ps) : (j < 64 ? ps : sigmoidf_(ps)); }
        }
        BSYNC();
        {
            const int ch = tid & 63, tg = tid >> 6;
            float wr[4], ap[4], gg[4];
#pragma unroll
            for (int q = 0; q < 4; ++q) { wr[q] = 0.f; ap[q] = 0.f; gg[q] = 0.f; }
#pragma unroll 2
            for (int j = 0; j < 32; ++j) {
                const float wu = wup[j * 64 + ch], au = aup[j * 64 + ch];
#pragma unroll
                for (int q = 0; q < 4; ++q) { wr[q] += lora[(4 * tg + q) * 160 + j] * wu; ap[q] += lora[(4 * tg + q) * 160 + 32 + j] * au; }
            }
#pragma unroll 4
            for (int j = 0; j < 96; ++j) {
                const float gu = gup[j * 64 + ch];
#pragma unroll
                for (int q = 0; q < 4; ++q) gg[q] += lora[(4 * tg + q) * 160 + 64 + j] * gu;
            }
#pragma unroll
            for (int q = 0; q < 4; ++q) {
                const int tok = 4 * tg + q;
                const float z = -(par[352 + ch] + wr[q]);
                const float sp = fmaxf(z, 0.f) + log1pf(expf(-fabsf(z)));
                const float w = -sp - 0.5f;
                const float decay = expf(-expf(w));
                const float a = sigmoidf_(par[416 + ch] + ap[q]);
                const float kraw = k_l[tok * 64 + ch];
                const float kkv = kraw * par[480 + ch];
                const float nrm = sqrtf(wave_sum(kkv * kkv));
                const float kk = kkv / fmaxf(nrm, 1e-12f);
                const float kmod = kraw * (1.f + (a - 1.f) * par[544 + ch]);
                const float bo = wave_sum(r_l[tok * 64 + ch] * kmod * par[608 + ch]);
                w_l[tok * 64 + ch] = decay; k_l[tok * 64 + ch] = kmod; a_l[tok * 64 + ch] = -kk; b_l[tok * 64 + ch] = kk * a; g_l[tok * 64 + ch] = gg[q];
                if (ch == 0) bon[tok] = bo;
            }
        }
        BSYNC();
        {
            const int v = tid >> 3, kq = tid & 7;
#pragma unroll 1
            for (int tt = 0; tt < RCH; ++tt) {
                const f32x4 w0 = *(const f32x4*)(w_l + tt * 64 + 8 * kq), w1 = *(const f32x4*)(w_l + tt * 64 + 8 * kq + 4);
                const f32x4 a0 = *(const f32x4*)(a_l + tt * 64 + 8 * kq), a1 = *(const f32x4*)(a_l + tt * 64 + 8 * kq + 4);
                const f32x4 b0 = *(const f32x4*)(b_l + tt * 64 + 8 * kq), b1 = *(const f32x4*)(b_l + tt * 64 + 8 * kq + 4);
                const f32x4 k0 = *(const f32x4*)(k_l + tt * 64 + 8 * kq), k1 = *(const f32x4*)(k_l + tt * 64 + 8 * kq + 4);
                const f32x4 r0 = *(const f32x4*)(r_l + tt * 64 + 8 * kq), r1 = *(const f32x4*)(r_l + tt * 64 + 8 * kq + 4);
                const float vv = v_l[tt * 64 + v];
                float sa = 0.f;
#pragma unroll
                for (int i = 0; i < 4; ++i) { sa += st[i] * a0[i]; sa += st[4 + i] * a1[i]; }
                sa += shfl_xor_f(sa, 1); sa += shfl_xor_f(sa, 2); sa += shfl_xor_f(sa, 4);
                float o = 0.f;
#pragma unroll
                for (int i = 0; i < 4; ++i) {
                    st[i] = st[i] * w0[i] + sa * b0[i] + vv * k0[i]; o += st[i] * r0[i];
                    st[4 + i] = st[4 + i] * w1[i] + sa * b1[i] + vv * k1[i]; o += st[4 + i] * r1[i];
                }
                o += shfl_xor_f(o, 1); o += shfl_xor_f(o, 2); o += shfl_xor_f(o, 4);
                if (kq == 0) o_l[tt * 64 + v] = o;
            }
        }
        BSYNC();
        {
            const int ch = tid & 63, tg = tid >> 6;
#pragma unroll
            for (int q = 0; q < 4; ++q) {
                const int tok = 4 * tg + q;
                const float o = o_l[tok * 64 + ch];
                const float mean = wave_sum(o) * (1.f / 64.f);
                const float dv = o - mean;
                const float var = wave_sum(dv * dv) * (1.f / 64.f);
                float y = dv * (1.0f / sqrtf(var + LNX_EPS)) * par[672 + ch] + par[736 + ch];
                y = (y + bon[tok] * v_l[tok * 64 + ch]) * g_l[tok * 64 + ch];
                Y[((size_t)b * SEQ + s0 + tok) * D + h * 64 + ch] = (unsigned short)f2bf(y);
            }
        }
        BSYNC();
    }
}

constexpr int KPITCH = 72, VPITCH = 260;
__device__ __forceinline__ void attn_unit(const Params& p, int b, int n, char* smem) {
    unsigned short* Kl = (unsigned short*)smem;
    unsigned short* Vt = Kl + 2 * 256 * KPITCH;
    float* ssl = (float*)(Vt + 2 * 64 * VPITCH);
    float* rstdl = ssl + 1024;
    float* wsf = rstdl + 128;
    const unsigned short* P = (const unsigned short*)(p.ws + WS_P);
    unsigned short* Y = (unsigned short*)(p.ws + WS_Y);
    const int tid = TID, lane = tid & 63, w = tid >> 6, q = lane & 31, hh = lane >> 5, g = w >> 2;
    const long tb = (long)b * SEQ + (long)(n - 1) * 128;
    for (int i = tid; i < 4096; i += NTHR) {
        const int c = i & 7, kj = (i >> 3) & 255, gg = i >> 11;
        const bool valid = (n > 0) || (kj >= 128);
        u32x4 kv = (u32x4){0u, 0u, 0u, 0u}, vv = (u32x4){0u, 0u, 0u, 0u};
        if (valid) { const unsigned short* row = P + (size_t)(tb + kj) * PCOLS; kv = *(const u32x4*)(row + PC_AK + gg * 64 + c * 8); vv = *(const u32x4*)(row + PC_AV + gg * 64 + c * 8); }
        *(u32x4*)(Kl + (gg * 256 + kj) * KPITCH + c * 8) = kv;
        unsigned short* vd = Vt + (gg * 64 + c * 8) * VPITCH + kj;
        vd[0 * VPITCH] = (unsigned short)(vv.x & 0xffff); vd[1 * VPITCH] = (unsigned short)(vv.x >> 16);
        vd[2 * VPITCH] = (unsigned short)(vv.y & 0xffff); vd[3 * VPITCH] = (unsigned short)(vv.y >> 16);
        vd[4 * VPITCH] = (unsigned short)(vv.z & 0xffff); vd[5 * VPITCH] = (unsigned short)(vv.z >> 16);
        vd[6 * VPITCH] = (unsigned short)(vv.w & 0xffff); vd[7 * VPITCH] = (unsigned short)(vv.w >> 16);
    }
    BSYNC();
    const float sink = p.attn_sinks[w];
    const long tq_blk = (long)b * SEQ + (long)n * 128;
    for (int it = 0; it < 4; ++it) {
        bf16x8 qf[4];
#pragma unroll
        for (int ks = 0; ks < 4; ++ks) qf[ks] = *(const bf16x8*)(P + (size_t)(tq_blk + 32 * it + q) * PCOLS + PC_Q + w * 64 + 16 * ks + 8 * hh);
        f32x16 pb[5];
        float mloc = sink;
        const int iq = 32 * it + q;
#pragma unroll
        for (int bi = 0; bi < 5; ++bi) {
            const int jb = it + bi;
            const bool active = (n > 0) || (jb >= 4);
#pragma unroll
            for (int r = 0; r < 16; ++r) pb[bi][r] = 0.f;
            if (active) {
#pragma unroll
                for (int ks = 0; ks < 4; ++ks) { const bf16x8 kf = *(const bf16x8*)(Kl + (g * 256 + 32 * jb + q) * KPITCH + 16 * ks + 8 * hh); pb[bi] = mfma32(kf, qf[ks], pb[bi]); }
            }
#pragma unroll
            for (int r = 0; r < 16; ++r) {
                const int kj = 32 * jb + crow(r, hh);
                const bool ok = active && (kj >= iq + 1) && (kj <= iq + 128);
                const float s = ok ? pb[bi][r] * 0.125f : -1e30f;
                pb[bi][r] = s; mloc = fmaxf(mloc, s);
            }
        }
        mloc = fmaxf(mloc, shfl_xor_f(mloc, 32));
        float lsum = 0.f;
#pragma unroll
        for (int bi = 0; bi < 5; ++bi)
#pragma unroll
            for (int r = 0; r < 16; ++r) { const float e = expf(pb[bi][r] - mloc); pb[bi][r] = e; lsum += e; }
        lsum += shfl_xor_f(lsum, 32);
        lsum += expf(sink - mloc);
        f32x16 o[2];
#pragma unroll
        for (int r = 0; r < 16; ++r) { o[0][r] = 0.f; o[1][r] = 0.f; }
#pragma unroll
        for (int bi = 0; bi < 5; ++bi) {
            const int jb = it + bi;
            const bool active = (n > 0) || (jb >= 4);
            if (active) {
#pragma unroll
                for (int s2 = 0; s2 < 2; ++s2) {
                    bf16x8 pa;
#pragma unroll
                    for (int j = 0; j < 8; ++j) pa[j] = (short)f2bf(pb[bi][8 * s2 + j]);
#pragma unroll
                    for (int dt = 0; dt < 2; ++dt) {
                        const unsigned short* vp = Vt + (g * 64 + 32 * dt + q) * VPITCH + 32 * jb + 16 * s2 + 4 * hh;
                        const bf16x4 lo = *(const bf16x4*)vp, hi = *(const bf16x4*)(vp + 8);
                        const bf16x8 vf = (bf16x8){lo[0], lo[1], lo[2], lo[3], hi[0], hi[1], hi[2], hi[3]};
                        o[dt] = mfma32(pa, vf, o[dt]);
                    }
                }
            }
        }
        if (hh == 0) wsf[w * 32 + q] = 1.f / lsum;
        WSYNC();
        float ss[16];
#pragma unroll
        for (int r = 0; r < 16; ++r) { const float il = wsf[w * 32 + crow(r, hh)]; o[0][r] *= il; o[1][r] *= il; ss[r] = o[0][r] * o[0][r] + o[1][r] * o[1][r]; }
        WSYNC();
#pragma unroll
        for (int r = 0; r < 16; ++r) {
            float s = ss[r];
            s += shfl_xor_f(s, 1); s += shfl_xor_f(s, 2); s += shfl_xor_f(s, 4); s += shfl_xor_f(s, 8); s += shfl_xor_f(s, 16);
            if (q == 0) ssl[(32 * it + crow(r, hh)) * 8 + w] = s;
            const size_t trow = (size_t)(tq_blk + 32 * it + crow(r, hh));
            Y[trow * D + 512 + w * 64 + q] = (unsigned short)f2bf(o[0][r]);
            Y[trow * D + 512 + w * 64 + 32 + q] = (unsigned short)f2bf(o[1][r]);
        }
    }
    BSYNC();
    if (tid < 128) { float s = 0.f;
#pragma unroll
        for (int j = 0; j < 8; ++j) s += ssl[tid * 8 + j];
        rstdl[tid] = 1.0f / sqrtf(s * (1.f / 512.f) + RMS_EPS); }
    BSYNC();
    const float g0 = p.attn_norm_g[w * 64 + q], g1 = p.attn_norm_g[w * 64 + 32 + q];
    for (int it = 0; it < 4; ++it)
#pragma unroll
        for (int r = 0; r < 16; ++r) {
            const int qi = 32 * it + crow(r, hh); const float rs = rstdl[qi];
            unsigned short* yp = Y + (size_t)(tq_blk + qi) * D + 512 + w * 64 + q;
            yp[0] = (unsigned short)f2bf(bfl(yp[0]) * rs * g0); yp[32] = (unsigned short)f2bf(bfl(yp[32]) * rs * g1);
        }
    BSYNC();
}

__device__ __forceinline__ void ins16(float (&l)[16], float x) {
#pragma unroll
    for (int i = 0; i < 16; ++i) { const float t = fmaxf(l[i], x); x = fminf(l[i], x); l[i] = t; }
}
__device__ __forceinline__ void topk_half(float* S, float* lists, int trow0, int hd, int* IDX, float* GATE) {
    const int tid = TID, row = tid & 127, grp = (tid >> 7) & 1, half = tid >> 8;
    float l[16];
#pragma unroll
    for (int i = 0; i < 16; ++i) l[i] = -3.0e38f;
    const float* src = S + row * 260 + grp * 128 + half * 64;
    for (int c = 0; c < 64; c += 4) {
        const f32x4 v = *(const f32x4*)(src + c);
#pragma unroll
        for (int i = 0; i < 4; ++i) { const unsigned nidx = (unsigned)(half * 64 + c + i); const float sv = v[i]; const float key = __builtin_bit_cast(float, (__builtin_bit_cast(unsigned, sv) & ~127u) | (127u - nidx)); ins16(l, key); }
    }
    float* slot = lists + (row * 2 + grp) * 16;
    if (half == 1) {
#pragma unroll
        for (int i = 0; i < 16; ++i) slot[i] = l[i];
    }
    BSYNC();
    if (half == 0) {
#pragma unroll
        for (int i = 0; i < 16; ++i) ins16(l, slot[i]);
        if (grp == 1) {
#pragma unroll
            for (int i = 0; i < 16; ++i) slot[i] = l[i];
        }
    }
    BSYNC();
    if (tid < 128) {
        const float* bl = lists + (row * 2 + 1) * 16;
        float bs[16];
#pragma unroll
        for (int i = 0; i < 16; ++i) bs[i] = bl[i];
        float c16[16];
#pragma unroll
        for (int i = 0; i < 16; ++i) c16[i] = -3.0e38f;
#pragma unroll
        for (int i = 0; i < 16; ++i) {
            const int jmax = 16 / (i + 1);
            const float ai = __builtin_bit_cast(float, __builtin_bit_cast(unsigned, l[i]) & ~127u);
#pragma unroll
            for (int j = 0; j < 16; ++j) if (j < jmax) {
                const float bj = __builtin_bit_cast(float, __builtin_bit_cast(unsigned, bs[j]) & ~127u);
                const float sm = ai + bj;
                ins16(c16, __builtin_bit_cast(float, (__builtin_bit_cast(unsigned, sm) & ~255u) | (unsigned)(i * 16 + j)));
            }
        }
        float ev[16]; float den = 0.f;
        const float mx = __builtin_bit_cast(float, __builtin_bit_cast(unsigned, c16[0]) & ~255u);
#pragma unroll
        for (int k = 0; k < 16; ++k) { const float sv = __builtin_bit_cast(float, __builtin_bit_cast(unsigned, c16[k]) & ~255u); ev[k] = expf(sv - mx); den += ev[k]; }
        const float inv = 1.f / den;
        int* ip = IDX + (size_t)(trow0 + row) * 128 + hd * 16; float* gp = GATE + (size_t)(trow0 + row) * 128 + hd * 16;
#pragma unroll
        for (int k = 0; k < 16; ++k) {
            const unsigned code = __builtin_bit_cast(unsigned, c16[k]) & 255u; const int ci = (int)(code >> 4), cj = (int)(code & 15u);
            unsigned abits = 0u, bbits = 0u;
#pragma unroll
            for (int i = 0; i < 16; ++i) { abits = (ci == i) ? __builtin_bit_cast(unsigned, l[i]) : abits; bbits = (cj == i) ? __builtin_bit_cast(unsigned, bs[i]) : bbits; }
            const int ia = 127 - (int)(abits & 127u), ib = 127 - (int)(bbits & 127u);
            ip[k] = ia * 128 + ib; gp[k] = ev[k] * inv;
        }
    }
    BSYNC();
}

__device__ __forceinline__ float gelu_erf(float v) { return 0.5f * v * (1.f + erff(v * 0.70710678118654752f)); }
__device__ __forceinline__ void peer_phase(const Params& p, int gw, int ngw) {
    const int lane = TID & 63;
    const unsigned short* H = (const unsigned short*)(p.ws + WS_H);
    const unsigned short* Ub = (const unsigned short*)(p.ws + WS_UB); const unsigned short* Vb = (const unsigned short*)(p.ws + WS_VB);
    const int* IDX = (const int*)(p.ws + WS_IDX); const float* GATE = (const float*)(p.ws + WS_GATE);
    float* X1 = p.out;
    for (int t = gw; t < T; t += ngw) {
        u32x4 hv[2];
        hv[0] = *(const u32x4*)(H + (size_t)t * D + 8 * lane); hv[1] = *(const u32x4*)(H + (size_t)t * D + 512 + 8 * lane);
        float hf[16];
#pragma unroll
        for (int j = 0; j < 2; ++j) { hf[8 * j + 0] = bf_lo(hv[j].x); hf[8 * j + 1] = bf_hi(hv[j].x); hf[8 * j + 2] = bf_lo(hv[j].y); hf[8 * j + 3] = bf_hi(hv[j].y);
            hf[8 * j + 4] = bf_lo(hv[j].z); hf[8 * j + 5] = bf_hi(hv[j].z); hf[8 * j + 6] = bf_lo(hv[j].w); hf[8 * j + 7] = bf_hi(hv[j].w); }
        const int myi0 = IDX[(size_t)t * 128 + lane], myi1 = IDX[(size_t)t * 128 + 64 + lane];
        const float myg0 = GATE[(size_t)t * 128 + lane], myg1 = GATE[(size_t)t * 128 + 64 + lane];
        float acc[16];
#pragma unroll
        for (int i = 0; i < 16; ++i) acc[i] = 0.f;
        for (int kk = 0; kk < 128; kk += 4) {
            u32x4 ur[4][2], vr[4][2]; float gt[4];
#pragma unroll
            for (int u = 0; u < 4; ++u) {
                const int k = kk + u;
                const int e = shfl_i(k < 64 ? myi0 : myi1, k & 63);
                gt[u] = shfl_f(k < 64 ? myg0 : myg1, k & 63);
                ur[u][0] = *(const u32x4*)(Ub + (size_t)e * D + 8 * lane); ur[u][1] = *(const u32x4*)(Ub + (size_t)e * D + 512 + 8 * lane);
                vr[u][0] = *(const u32x4*)(Vb + (size_t)e * D + 8 * lane); vr[u][1] = *(const u32x4*)(Vb + (size_t)e * D + 512 + 8 * lane);
            }
#pragma unroll
            for (int u = 0; u < 4; ++u) {
                float d = 0.f;
#pragma unroll
                for (int j = 0; j < 2; ++j) {
                    d += hf[8 * j + 0] * bf_lo(ur[u][j].x) + hf[8 * j + 1] * bf_hi(ur[u][j].x) + hf[8 * j + 2] * bf_lo(ur[u][j].y) + hf[8 * j + 3] * bf_hi(ur[u][j].y)
                       + hf[8 * j + 4] * bf_lo(ur[u][j].z) + hf[8 * j + 5] * bf_hi(ur[u][j].z) + hf[8 * j + 6] * bf_lo(ur[u][j].w) + hf[8 * j + 7] * bf_hi(ur[u][j].w);
                }
                d = wave_sum(d);
                const float a = gelu_erf(d) * gt[u];
#pragma unroll
                for (int j = 0; j < 2; ++j) {
                    acc[8 * j + 0] += a * bf_lo(vr[u][j].x); acc[8 * j + 1] += a * bf_hi(vr[u][j].x); acc[8 * j + 2] += a * bf_lo(vr[u][j].y); acc[8 * j + 3] += a * bf_hi(vr[u][j].y);
                    acc[8 * j + 4] += a * bf_lo(vr[u][j].z); acc[8 * j + 5] += a * bf_hi(vr[u][j].z); acc[8 * j + 6] += a * bf_lo(vr[u][j].w); acc[8 * j + 7] += a * bf_hi(vr[u][j].w);
                }
            }
        }
        float* xr = X1 + (size_t)t * D;
        float ssq = 0.f; f32x4 xv[4];
#pragma unroll
        for (int j = 0; j < 2; ++j) {
            xv[2 * j] = *(const f32x4*)(xr + 512 * j + 8 * lane); xv[2 * j + 1] = *(const f32x4*)(xr + 512 * j + 8 * lane + 4);
#pragma unroll
            for (int i = 0; i < 4; ++i) { xv[2 * j][i] += acc[8 * j + i]; xv[2 * j + 1][i] += acc[8 * j + 4 + i]; ssq += xv[2 * j][i] * xv[2 * j][i] + xv[2 * j + 1][i] * xv[2 * j + 1][i]; }
        }
        const float rstd = 1.0f / sqrtf(wave_sum(ssq) * (1.f / D) + RMS_EPS);
#pragma unroll
        for (int j = 0; j < 2; ++j) {
            const f32x4 g0 = *(const f32x4*)(p.lnf_g + 512 * j + 8 * lane), g1 = *(const f32x4*)(p.lnf_g + 512 * j + 8 * lane + 4);
            f32x4 o0, o1;
#pragma unroll
            for (int i = 0; i < 4; ++i) { o0[i] = xv[2 * j][i] * rstd * g0[i]; o1[i] = xv[2 * j + 1][i] * rstd * g1[i]; }
            *(f32x4*)(xr + 512 * j + 8 * lane) = o0; *(f32x4*)(xr + 512 * j + 8 * lane + 4) = o1;
        }
    }
}

#ifndef EMU
namespace pg8 {
#define PG8_LAS __attribute__((address_space(3)))
typedef unsigned short bf16_t;
typedef short bf16x8 __attribute__((ext_vector_type(8)));
typedef float f32x4 __attribute__((ext_vector_type(4)));
typedef unsigned u32x4 __attribute__((ext_vector_type(4)));
constexpr int BM = 256, BK = 64, HALF = 128, HTB = HALF * BK * 2  , STAGE_BYTES = 8 * HTB, NXCD = 8, WGM = 8;

__host__ __device__ __forceinline__ int lds_byte(int r, int c) { const int st = (r >> 4) * 2 + (c >> 5), rr = r & 15, cc = c & 31, ob = rr * 64 + cc * 2; return st * 1024 + (ob ^ (((ob >> 9) & 1) << 5)); }
__host__ __device__ __forceinline__ void stage_rc(int b, int& R, int& C) { const int st = b / 1024, sb = b % 1024, swz = sb ^ (((sb >> 9) & 1) << 5); R = (st >> 1) * 16 + swz / 64; C = (st & 1) * 32 + (swz % 64) / 2; }
__host__ __device__ __forceinline__ int perm32(int rho) { const int n = rho >> 4, i = rho & 15; return 8 * (i >> 2) + 4 * n + (i & 3); }

struct Unit { int pm, pn; };
struct Gemm { const bf16_t* A; const bf16_t* Bt; int M, N, K; };

struct StaticOrder {
    int nM, nN, nwg, G, c;
    __host__ __device__ void init(int M, int N, int G_, int c_) { nM = M / BM; nN = N / BM; nwg = nM * nN; G = G_; c = c_; }
    __host__ __device__ bool next(int i, Unit& u) const {
        const long L = (long)i * G + c; if (L >= nwg) return false;
        int wgid = (int)L; { const int q = nwg / NXCD, r = nwg % NXCD, xcd = wgid % NXCD, off = wgid / NXCD; wgid = (xcd < r ? xcd * (q + 1) : r * (q + 1) + (xcd - r) * q) + off; }
        const int nig = WGM * nN, gid = wgid / nig, fm = gid * WGM, gsz = (nM - fm) < WGM ? (nM - fm) : WGM;
        u.pm = fm + ((wgid % nig) % gsz); u.pn = (wgid % nig) / gsz; return true;
    }
    __device__ __forceinline__ void a_ready(const Unit&) const {}
    __device__ __forceinline__ void done(const Unit&) const {}
};

__device__ __forceinline__ unsigned cvt_pk_bf16(float lo, float hi) { unsigned r; asm volatile("v_cvt_pk_bf16_f32 %0, %1, %2" : "=v"(r) : "v"(lo), "v"(hi)); return r; }
typedef float f32x2 __attribute__((ext_vector_type(2)));
__device__ __forceinline__ f32x2 gelu_pk(f32x2 v) {
    const f32x2 av = __builtin_elementwise_abs(v), d = av * 0.2316418882f + 1.0f;
    f32x2 t; t.x = __builtin_amdgcn_rcpf(d.x); t.y = __builtin_amdgcn_rcpf(d.y);
    f32x2 q = t * 0.5307027145f + (-0.7265760135f); q = q * t + 0.7107068705f; q = q * t + (-0.142248368f); q = q * t + 0.127414796f; q = q * t;
    const f32x2 s = (v * v) * (-0.72134752044f);
    f32x2 e; e.x = __builtin_amdgcn_exp2f(s.x); e.y = __builtin_amdgcn_exp2f(s.y);
    const f32x2 m = v * (q * e), r = v - m;
    f32x2 o; o.x = v.x < 0.f ? m.x : r.x; o.y = v.y < 0.f ? m.y : r.y; return o;
}

template <int ACT  > struct EpiBf16 {
    static constexpr bool PERM = true, AFTER_DRAIN = false; static_assert(ACT == 0 || ACT == 1, "EpiBf16: ACT is 0 (none) or 1 (gelu_pk)");
    bf16_t* O; int ldc; const float* bias; int split_cols; size_t split_stride; float scale0;
    __device__ __forceinline__ void operator()(const f32x4 (&acc)[2][2][4][2], const Unit& u, int wr, int wc, int fr, int fq) const {
        const int row0 = u.pm * BM + wr * 64 + fr; int colt = u.pn * BM; bf16_t* base = O;
        float sc = 1.f; if (split_cols) { const int t = colt / split_cols; base += (size_t)t * split_stride; colt -= t * split_cols; if (t == 0) sc = scale0; }
        const int col0 = colt + wc * 32 + 8 * fq, bcol0 = u.pn * BM + wc * 32 + 8 * fq;
        f32x4 bv[2][2];
#pragma unroll
        for (int bj = 0; bj < 2; ++bj)
#pragma unroll
            for (int n = 0; n < 2; ++n) bv[bj][n] = bias ? *(const f32x4*)(bias + bcol0 + bj * HALF + 4 * n) : (f32x4){0.f, 0.f, 0.f, 0.f};
#pragma unroll
        for (int ai = 0; ai < 2; ++ai)
#pragma unroll
            for (int m = 0; m < 4; ++m) { bf16_t* rowp = base + (size_t)(row0 + ai * HALF + m * 16) * ldc + col0;
#pragma unroll
                for (int bj = 0; bj < 2; ++bj) { f32x4 v0 = acc[ai][bj][m][0] + bv[bj][0], v1 = acc[ai][bj][m][1] + bv[bj][1];
                    if (ACT == 1) { f32x2 a = gelu_pk((f32x2){v0[0], v0[1]}), b = gelu_pk((f32x2){v0[2], v0[3]}), c = gelu_pk((f32x2){v1[0], v1[1]}), d = gelu_pk((f32x2){v1[2], v1[3]});
                        v0 = (f32x4){a.x, a.y, b.x, b.y}; v1 = (f32x4){c.x, c.y, d.x, d.y}; }
                    v0 = v0 * sc; v1 = v1 * sc; u32x4 w; w.x = cvt_pk_bf16(v0[0], v0[1]); w.y = cvt_pk_bf16(v0[2], v0[3]); w.z = cvt_pk_bf16(v1[0], v1[1]); w.w = cvt_pk_bf16(v1[2], v1[3]);
                    *(u32x4*)(rowp + bj * HALF) = w; } }
    }
};
template <class Epi, class Sched, bool ALIGN_EPI = false, bool SP2 = false>
__device__ __forceinline__ void gemm_phase(PG8_LAS unsigned char* lds, const Gemm g, const Sched& S, const Epi& E) {
    const int tid = threadIdx.x, wid = __builtin_amdgcn_readfirstlane(tid >> 6), lane = tid & 63, wr = wid >> 2, wc = wid & 3, fr = lane & 15, fq = lane >> 4;
    const int K = g.K, nt = K / BK;
    unsigned voffA[2], voffB[2];
#pragma unroll
    for (int i = 0; i < 2; ++i) { int R, C; stage_rc(tid * 16 + i * 8192, R, C); const int Rb = Epi::PERM ? ((R & ~31) + perm32(R & 31)) : R;
        voffA[i] = (unsigned)(R * K + C) * 2u; voffB[i] = (unsigned)(Rb * K + C) * 2u; }
    const size_t kstep = (size_t)(BK * 2);
    const size_t hstep = (size_t)HALF * K * 2;
    const size_t tstep = 2 * hstep;
    const unsigned ldsw = (unsigned)wid * 1024u;
    const int aoff = lds_byte(wr * 64 + fr, fq * 8), boff = lds_byte(wc * 32 + fr, fq * 8);
#define PG8_SA(b, h) (((b) * 2 + (h)) * HTB)
#define PG8_SB(b, h) ((4 + (b) * 2 + (h)) * HTB)
#define PG8_STAGE(bufoff, gbase, voff) do { _Pragma("unroll") for (int _i = 0; _i < 2; ++_i) \
        __builtin_amdgcn_global_load_lds((const unsigned*)((const char*)(gbase) + (voff)[_i]), (PG8_LAS unsigned*)(lds + (bufoff) + ldsw + _i * 8192), 16, 0, 0); } while (0)
#define PG8_LDA(dst, b, h) do { _Pragma("unroll") for (int m = 0; m < 4; ++m) _Pragma("unroll") for (int k = 0; k < 2; ++k) dst[m][k] = *(const PG8_LAS bf16x8*)(lds + PG8_SA(b, h) + aoff + m * 2048 + k * 1024); } while (0)
#define PG8_LDB(dst, b, h) do { _Pragma("unroll") for (int n = 0; n < 2; ++n) _Pragma("unroll") for (int k = 0; k < 2; ++k) dst[n][k] = *(const PG8_LAS bf16x8*)(lds + PG8_SB(b, h) + boff + n * 2048 + k * 1024); } while (0)
#define PG8_MMA(ai, bj, At, Bt) do { __builtin_amdgcn_s_setprio(1); _Pragma("unroll") for (int m = 0; m < 4; ++m) _Pragma("unroll") for (int n = 0; n < 2; ++n) _Pragma("unroll") for (int k = 0; k < 2; ++k) \
        acc[ai][bj][m][n] = __builtin_amdgcn_mfma_f32_16x16x32_bf16(Bt[n][k], At[m][k], acc[ai][bj][m][n], 0, 0, 0); __builtin_amdgcn_s_setprio(0); } while (0)
#define PG8_WAIT_V(n) asm volatile("s_waitcnt vmcnt(" #n ")" ::: "memory")
#define PG8_WAIT_L(n) asm volatile("s_waitcnt lgkmcnt(" #n ")" ::: "memory")
#define PG8_BAR __builtin_amdgcn_s_barrier()
#define PG8_SCHED __builtin_amdgcn_sched_barrier(0)
    Unit cur, nxt; int ui = 0;
    if (!S.next(0, cur)) return;
    f32x4 acc[2][2][4][2];
#pragma unroll
    for (int a = 0; a < 2; ++a)
#pragma unroll
        for (int b = 0; b < 2; ++b)
#pragma unroll
            for (int m = 0; m < 4; ++m)
#pragma unroll
                for (int n = 0; n < 2; ++n) acc[a][b][m][n] = (f32x4){0.f, 0.f, 0.f, 0.f};
    bf16x8 At[4][2], B0[2][2], B1[2][2];
    const char* cA = (const char*)g.A + (size_t)cur.pm * tstep; const char* cB = (const char*)g.Bt + (size_t)cur.pn * tstep;
    S.a_ready(cur);
    if constexpr (SP2) {
        PG8_STAGE(PG8_SB(0, 0), cB, voffB); PG8_STAGE(PG8_SB(0, 1), cB + hstep, voffB); PG8_STAGE(PG8_SA(0, 0), cA, voffA); PG8_STAGE(PG8_SA(0, 1), cA + hstep, voffA);
        if (wr == 1) PG8_BAR;
        PG8_WAIT_V(2); PG8_BAR;
        PG8_STAGE(PG8_SB(1, 0), cB + kstep, voffB); PG8_STAGE(PG8_SA(1, 0), cA + kstep, voffA); PG8_STAGE(PG8_SB(1, 1), cB + hstep + kstep, voffB);
        PG8_WAIT_V(6); PG8_BAR;
    } else {
        PG8_STAGE(PG8_SB(0, 0), cB, voffB); PG8_STAGE(PG8_SA(0, 0), cA, voffA); PG8_STAGE(PG8_SB(0, 1), cB + hstep, voffB); PG8_STAGE(PG8_SA(0, 1), cA + hstep, voffA);
        if (wr == 1) PG8_BAR;
        PG8_WAIT_V(4); PG8_BAR;
        PG8_STAGE(PG8_SB(1, 0), cB + kstep, voffB); PG8_STAGE(PG8_SA(1, 0), cA + kstep, voffA); PG8_STAGE(PG8_SB(1, 1), cB + hstep + kstep, voffB);
        PG8_WAIT_V(6); PG8_BAR;
    }
    for (;;) {
        const bool has_next = S.next(ui + 1, nxt);
        const char* nA = has_next ? (const char*)g.A + (size_t)nxt.pm * tstep : cA; const char* nB = has_next ? (const char*)g.Bt + (size_t)nxt.pn * tstep : cB;
        for (int t = 0; t < nt; t += 2) {
            const bool last = (t == nt - 2);
            const char* a1 = cA + (size_t)(t + 1) * kstep;
            const char* a2 = last ? nA : cA + (size_t)(t + 2) * kstep; const char* b2 = last ? nB : cB + (size_t)(t + 2) * kstep;
            const char* a3 = a2 + kstep; const char* b3 = b2 + kstep;
            if (last && has_next) S.a_ready(nxt);
            if constexpr (SP2) {
            PG8_LDB(B0, 0, 0); PG8_LDB(B1, 0, 1); PG8_SCHED; PG8_LDA(At, 0, 0); PG8_STAGE(PG8_SA(1, 1), a1 + hstep, voffA);
            PG8_WAIT_V(8); PG8_WAIT_L(0); PG8_BAR; PG8_MMA(0, 0, At, B0); PG8_MMA(0, 1, At, B1); PG8_BAR; PG8_SCHED;
            PG8_LDA(At, 0, 1); PG8_STAGE(PG8_SB(0, 0), b2, voffB); PG8_STAGE(PG8_SB(0, 1), b2 + hstep, voffB); PG8_STAGE(PG8_SA(0, 0), a2, voffA);
            PG8_WAIT_V(8); PG8_WAIT_L(0); PG8_BAR; PG8_MMA(1, 0, At, B0); PG8_MMA(1, 1, At, B1); PG8_BAR; PG8_SCHED;
            PG8_LDB(B0, 1, 0); PG8_LDB(B1, 1, 1); PG8_SCHED; PG8_LDA(At, 1, 0); PG8_STAGE(PG8_SA(0, 1), a2 + hstep, voffA);
            PG8_WAIT_V(8); PG8_WAIT_L(0); PG8_BAR; PG8_MMA(0, 0, At, B0); PG8_MMA(0, 1, At, B1); PG8_BAR; PG8_SCHED;
            PG8_LDA(At, 1, 1); PG8_STAGE(PG8_SB(1, 0), b3, voffB); PG8_STAGE(PG8_SB(1, 1), b3 + hstep, voffB); PG8_STAGE(PG8_SA(1, 0), a3, voffA);
            PG8_WAIT_V(8); PG8_WAIT_L(0); PG8_BAR; PG8_MMA(1, 0, At, B0); PG8_MMA(1, 1, At, B1); PG8_BAR; PG8_SCHED;
            } else {
            PG8_LDB(B0, 0, 0); PG8_SCHED; PG8_LDA(At, 0, 0); PG8_STAGE(PG8_SA(1, 1), a1 + hstep, voffA);
            PG8_WAIT_L(8); PG8_BAR; PG8_WAIT_L(0); PG8_MMA(0, 0, At, B0); PG8_BAR; PG8_SCHED;
            PG8_LDB(B1, 0, 1); PG8_STAGE(PG8_SB(0, 0), b2, voffB);
            PG8_BAR; PG8_WAIT_L(0); PG8_MMA(0, 1, At, B1); PG8_BAR;
            PG8_LDA(At, 0, 1); PG8_STAGE(PG8_SA(0, 0), a2, voffA);
            PG8_BAR; PG8_WAIT_L(0); PG8_MMA(1, 0, At, B0); PG8_BAR; PG8_SCHED;
            PG8_STAGE(PG8_SB(0, 1), b2 + hstep, voffB);
            PG8_WAIT_V(6); PG8_BAR; PG8_MMA(1, 1, At, B1); PG8_BAR;
            PG8_LDB(B0, 1, 0); PG8_SCHED; PG8_LDA(At, 1, 0); PG8_STAGE(PG8_SA(0, 1), a2 + hstep, voffA);
            PG8_WAIT_L(8); PG8_BAR; PG8_WAIT_L(0); PG8_MMA(0, 0, At, B0); PG8_BAR; PG8_SCHED;
            PG8_LDB(B1, 1, 1); PG8_STAGE(PG8_SB(1, 0), b3, voffB);
            PG8_BAR; PG8_WAIT_L(0); PG8_MMA(0, 1, At, B1); PG8_BAR;
            PG8_LDA(At, 1, 1); PG8_STAGE(PG8_SA(1, 0), a3, voffA);
            PG8_BAR; PG8_WAIT_L(0); PG8_MMA(1, 0, At, B0); PG8_BAR; PG8_SCHED;
            PG8_STAGE(PG8_SB(1, 1), b3 + hstep, voffB);
            PG8_WAIT_V(6); PG8_BAR; PG8_MMA(1, 1, At, B1); PG8_BAR;
            }
        }
        if constexpr (ALIGN_EPI) { if (wr == 0) PG8_BAR; }
        if constexpr (!Epi::AFTER_DRAIN) { E(acc, cur, wr, wc, fr, fq); S.done(cur); }
        if (!has_next) break;
#pragma unroll
        for (int a = 0; a < 2; ++a)
#pragma unroll
            for (int b = 0; b < 2; ++b)
#pragma unroll
                for (int m = 0; m < 4; ++m)
#pragma unroll
                    for (int n = 0; n < 2; ++n) acc[a][b][m][n] = (f32x4){0.f, 0.f, 0.f, 0.f};
        cur = nxt; cA = nA; cB = nB; ++ui;
        if constexpr (ALIGN_EPI) { if (wr == 1) PG8_BAR; }
    }
    PG8_WAIT_V(0);
    if constexpr (!ALIGN_EPI) { if (wr == 0) PG8_BAR; }
    PG8_BAR;
    if constexpr (Epi::AFTER_DRAIN) { E.fused(acc, cur, wr, wc, fr, fq, lds, wid, lane); S.done(cur); }
#undef PG8_SA
#undef PG8_SB
#undef PG8_STAGE
#undef PG8_LDA
#undef PG8_LDB
#undef PG8_MMA
#undef PG8_WAIT_V
#undef PG8_WAIT_L
#undef PG8_BAR
#undef PG8_SCHED
}
}

struct OneUnit {
    pg8::Unit u;
    __device__ __forceinline__ bool next(int i, pg8::Unit& o) const { if (i) return false; o = u; return true; }
    __device__ __forceinline__ void a_ready(const pg8::Unit&) const {}
    __device__ __forceinline__ void done(const pg8::Unit&) const {}
};
struct EpiResF32 {
    static constexpr bool PERM = false, AFTER_DRAIN = false;
    const float* base; float* out;
    __device__ __forceinline__ void operator()(const pg8::f32x4 (&acc)[2][2][4][2], const pg8::Unit& u, int wr, int wc, int fr, int fq) const {
#pragma unroll
        for (int ai = 0; ai < 2; ++ai)
#pragma unroll
            for (int m = 0; m < 4; ++m) {
                const size_t row = (size_t)u.pm * 256 + ai * 128 + wr * 64 + m * 16 + fr;
#pragma unroll
                for (int bj = 0; bj < 2; ++bj)
#pragma unroll
                    for (int n = 0; n < 2; ++n) {
                        const size_t off = row * D + u.pn * 256 + bj * 128 + wc * 32 + n * 16 + 4 * fq;
                        const pg8::f32x4 b = *(const pg8::f32x4*)(base + off);
                        *(pg8::f32x4*)(out + off) = b + acc[ai][bj][m][n];
                    }
            }
    }
};
struct EpiTopK {
    static constexpr bool PERM = false, AFTER_DRAIN = true;
    int* IDX; float* GATE;
    __device__ __forceinline__ void fused(pg8::f32x4 (&acc)[2][2][4][2], const pg8::Unit& u, int wr, int wc, int fr, int fq, PG8_LAS unsigned char* lds, int wid, int lane) const {
        float* S = (float*)lds; float* lists = S + 128 * 260;
#pragma unroll
        for (int ai = 0; ai < 2; ++ai) {
#pragma unroll
            for (int bj = 0; bj < 2; ++bj)
#pragma unroll
                for (int m = 0; m < 4; ++m)
#pragma unroll
                    for (int n = 0; n < 2; ++n) *(pg8::f32x4*)(S + (wr * 64 + m * 16 + fr) * 260 + bj * 128 + wc * 32 + n * 16 + 4 * fq) = acc[ai][bj][m][n];
            __syncthreads();
            topk_half(S, lists, u.pm * 256 + ai * 128, u.pn, IDX, GATE);
        }
    }
};

#ifndef PHM
#define PHM 255
#endif
constexpr int LDS_BYTES = 155648;
__global__ void __launch_bounds__(NTHR, 2) fwd_kernel(Params p) {
    extern __shared__ __attribute__((aligned(16))) unsigned char lds[];
    cg::grid_group grid = cg::this_grid();
    const int bid = blockIdx.x, nblk = gridDim.x;
    unsigned char* ws = p.ws;
#if PHM & 1
    p0_prologue(p, bid, nblk, (char*)lds);
#endif
    grid.sync();
#if PHM & 2
    {
        pg8::Gemm g{(const pg8::bf16_t*)(ws + WS_H), (const pg8::bf16_t*)(ws + WS_WINT), T, PCOLS, D};
        pg8::StaticOrder S; S.init(T, PCOLS, nblk, bid);
        pg8::EpiBf16<0> E{(pg8::bf16_t*)(ws + WS_P), PCOLS, (const float*)(ws + WS_BIASP), 0, 0, 1.f};
        pg8::gemm_phase<pg8::EpiBf16<0>, pg8::StaticOrder, true, true>((PG8_LAS unsigned char*)lds, g, S, E);
    }
#endif
    grid.sync();
#if PHM & 4
    for (int u = bid; u < BATCH * 8; u += nblk) rwkv_unit(p, u >> 3, u & 7, (char*)lds);
#endif
#if PHM & 8
    for (int u = bid; u < BATCH * (SEQ / 128); u += nblk) attn_unit(p, u / (SEQ / 128), u % (SEQ / 128), (char*)lds);
#endif
    grid.sync();
#if PHM & 16
    {
        pg8::Gemm g{(const pg8::bf16_t*)(ws + WS_Y), (const pg8::bf16_t*)(ws + WS_WOUTT), T, D, D};
        pg8::StaticOrder S; S.init(T, D, nblk, bid);
        EpiResF32 E{p.x, p.out};
        pg8::gemm_phase<EpiResF32, pg8::StaticOrder, true, true>((PG8_LAS unsigned char*)lds, g, S, E);
    }
#endif
    grid.sync();
#if PHM & 32
    rms_rows(p.out, p.ln2_g, (unsigned short*)(ws + WS_H), bid * (NTHR / 64) + (TID >> 6), nblk * (NTHR / 64));
#endif
    grid.sync();
#if PHM & 64
    {
        pg8::Gemm g{(const pg8::bf16_t*)(ws + WS_H), (const pg8::bf16_t*)(ws + WS_WFT), T, 2048, D};
        pg8::StaticOrder S; S.init(T, 2048, nblk, bid);
        EpiTopK E{(int*)(ws + WS_IDX), (float*)(ws + WS_GATE)};
        OneUnit one;
        for (int i = 0; S.next(i, one.u); ++i) pg8::gemm_phase<EpiTopK, OneUnit, false, true>((PG8_LAS unsigned char*)lds, g, one, E);
    }
#endif
    grid.sync();
#if PHM & 128
    peer_phase(p, bid * (NTHR / 64) + (TID >> 6), nblk * (NTHR / 64));
#endif
}

extern "C" void kernel_launch(void* const* d_in, const int* in_sizes, int n_in, void* d_out, int out_size, void* d_ws, size_t ws_size, hipStream_t stream) {
    static int grid = 0;
    if (grid == 0) {
        if (n_in != 24 || out_size != T * D || ws_size < WS_END) { fprintf(stderr, "kernel_launch: unexpected shapes (n_in %d, out %d, ws %zu < %zu)\n", n_in, out_size, ws_size, (size_t)WS_END); grid = -1; return; }
        int dev = 0, cus = 0, per_cu = 0;
        hipGetDevice(&dev);
        hipDeviceGetAttribute(&cus, hipDeviceAttributeMultiprocessorCount, dev);
        hipFuncSetAttribute((const void*)fwd_kernel, hipFuncAttributeMaxDynamicSharedMemorySize, LDS_BYTES);
        hipOccupancyMaxActiveBlocksPerMultiprocessor(&per_cu, (const void*)fwd_kernel, NTHR, LDS_BYTES);
        if (per_cu < 1) { fprintf(stderr, "kernel_launch: occupancy query says %d blocks per CU\n", per_cu); per_cu = 1; }
        if (per_cu > 1) per_cu = 1;
        grid = cus * per_cu;
        (void)hipGetLastError();
    }
    if (grid < 0) return;
    Params p{};
    const float** pp = (const float**)&p;
    for (int i = 0; i < 24; ++i) pp[i] = (const float*)d_in[i];
    p.out = (float*)d_out; p.ws = (unsigned char*)d_ws;
    void* args[] = {&p};
    hipError_t e = hipLaunchCooperativeKernel((const void*)fwd_kernel, dim3(grid), dim3(NTHR), args, LDS_BYTES, stream);
    if (e != hipSuccess) fprintf(stderr, "cooperative launch failed: %s (grid %d)\n", hipGetErrorString(e), grid);
}
#endif
```

```cpp
#ifndef EMU
#include <hip/hip_runtime.h>
#include <hip/hip_cooperative_groups.h>
#include <cstdio>
#include <cstdint>
namespace cg = cooperative_groups;
typedef short bf16x8 __attribute__((ext_vector_type(8)));
typedef short bf16x4 __attribute__((ext_vector_type(4)));
typedef float f32x16 __attribute__((ext_vector_type(16)));
typedef float f32x4 __attribute__((ext_vector_type(4)));
typedef float f32x2 __attribute__((ext_vector_type(2)));
typedef unsigned u32x4 __attribute__((ext_vector_type(4)));
typedef unsigned u32x2 __attribute__((ext_vector_type(2)));
#define TID ((int)threadIdx.x)
#define BSYNC() __syncthreads()
#define WSYNC() __builtin_amdgcn_wave_barrier()
__device__ __forceinline__ float shfl_xor_f(float v, int m) { return __shfl_xor(v, m); }
__device__ __forceinline__ float shfl_f(float v, int s) { return __shfl(v, s); }
__device__ __forceinline__ int shfl_i(int v, int s) { return __shfl(v, s); }
__device__ __forceinline__ float rdlane_f(float v, int l) { return __builtin_bit_cast(float, __builtin_amdgcn_readlane(__builtin_bit_cast(int, v), l)); }
__device__ __forceinline__ int rdlane_i(int v, int l) { return __builtin_amdgcn_readlane(v, l); }
__device__ __forceinline__ f32x2 cvt_pk_f32_fp8(unsigned w, bool hi) { return hi ? __builtin_amdgcn_cvt_pk_f32_fp8((int)w, true) : __builtin_amdgcn_cvt_pk_f32_fp8((int)w, false); }
__device__ __forceinline__ unsigned cvt_pk_fp8_f32(float a, float b, unsigned old, bool hi) { return hi ? (unsigned)__builtin_amdgcn_cvt_pk_fp8_f32(a, b, (int)old, true) : (unsigned)__builtin_amdgcn_cvt_pk_fp8_f32(a, b, (int)old, false); }
__device__ __forceinline__ f32x16 mfma32(bf16x8 a, bf16x8 b, f32x16 c) { return __builtin_amdgcn_mfma_f32_32x32x16_bf16(a, b, c, 0, 0, 0); }
__device__ __forceinline__ f32x4 mfma16(bf16x8 a, bf16x8 b, f32x4 c) { return __builtin_amdgcn_mfma_f32_16x16x32_bf16(a, b, c, 0, 0, 0); }
#else
#define WSYNC() emu_barrier(g_wave_bar[TID >> 6], 64)
#endif

#ifndef CFG_BATCH
#define CFG_BATCH 32
#endif
#ifndef CFG_SEQ
#define CFG_SEQ 2048
#endif
constexpr int D = 1024, BATCH = CFG_BATCH, SEQ = CFG_SEQ, T = BATCH * SEQ;
constexpr int NTHR = 512;
constexpr int PCOLS = 2560;
constexpr int PC_R = 0, PC_K = 512, PC_V = 1024, PC_Q = 1536, PC_AK = 2048, PC_AV = 2176, PC_LORA = 2304;
constexpr int NEXP = 16384;
constexpr float RMS_EPS = 1e-6f, LNX_EPS = 64e-5f;

constexpr size_t MiB = 1u << 20;
constexpr size_t al1m(size_t x) { return (x + MiB - 1) / MiB * MiB; }
constexpr size_t WS_CTL = 0;
constexpr size_t WS_BIASP = 1 * MiB;
constexpr size_t WS_WINT = 2 * MiB;
constexpr size_t WS_WOUTT = 7 * MiB;
constexpr size_t WS_WFT = 9 * MiB;
constexpr size_t WS_U8 = 16 * MiB;
constexpr size_t WS_V8 = 32 * MiB;
constexpr size_t WS_USC = 48 * MiB;
constexpr size_t WS_VSC = 49 * MiB;
constexpr size_t WS_H = 80 * MiB;
constexpr size_t WS_Y = WS_H + al1m((size_t)T * D * 2);
constexpr size_t WS_P = WS_Y + al1m((size_t)T * D * 2);
constexpr size_t WS_IDX = WS_P + al1m((size_t)T * PCOLS * 2);
constexpr size_t WS_GATE = WS_IDX + al1m((size_t)T * 128 * 4);
constexpr size_t WS_END = WS_GATE + al1m((size_t)T * 128 * 4);

struct Params {
    const float* x; const float* ln1_g; const float* w_in; const float* b_attn; const float* mu_shift; const float* w0; const float* w_up; const float* a0;
    const float* a_up; const float* g_up; const float* k_k; const float* k_a; const float* r_k; const float* lnx_w; const float* lnx_b; const float* attn_sinks;
    const float* attn_norm_g; const float* w_out; const float* ln2_g; const float* peer_wq; const float* peer_subkeys; const float* peer_u; const float* peer_v; const float* lnf_g;
    float* out; unsigned char* ws;
};

__device__ __forceinline__ unsigned f2bf(float f) { unsigned u = __builtin_bit_cast(unsigned, f); return (u + 0x7fffu + ((u >> 16) & 1u)) >> 16; }
__device__ __forceinline__ unsigned pk2(float lo, float hi) { return f2bf(lo) | (f2bf(hi) << 16); }
__device__ __forceinline__ float bfl(unsigned short b) { return __builtin_bit_cast(float, (unsigned)b << 16); }
__device__ __forceinline__ float bf_lo(unsigned w) { return __builtin_bit_cast(float, w << 16); }
__device__ __forceinline__ float bf_hi(unsigned w) { return __builtin_bit_cast(float, w & 0xffff0000u); }
__device__ __forceinline__ float wave_sum(float v) {
#pragma unroll
    for (int o = 1; o < 64; o <<= 1) v += shfl_xor_f(v, o);
    return v;
}
__device__ __forceinline__ int crow(int r, int hi) { return (r & 3) + 8 * (r >> 2) + 4 * hi; }
__device__ __forceinline__ int win_src_col(int n) { if (n < 1536) return n; if (n < 2304) return n + 160; if (n < 2464) return n - 768; return -1; }
__device__ __forceinline__ float sigmoidf_(float z) { return 1.f / (1.f + expf(-z)); }

__device__ __forceinline__ void p0_transpose_tile(const float* W, int K, int ldw, unsigned short* WT, int k0, int n0, int mode, float* tl) {
    const int t = TID, kk = t >> 6, nn = t & 63;
    const int sc = mode ? win_src_col(n0 + nn) : (n0 + nn);
#pragma unroll
    for (int i = 0; i < 8; ++i) { const int k = kk + 8 * i; tl[k * 65 + nn] = sc >= 0 ? W[(size_t)(k0 + k) * ldw + sc] : 0.f; }
    BSYNC();
    const int n = t >> 3, c = t & 7;
    u32x4 o;
    o.x = pk2(tl[(8 * c + 0) * 65 + n], tl[(8 * c + 1) * 65 + n]); o.y = pk2(tl[(8 * c + 2) * 65 + n], tl[(8 * c + 3) * 65 + n]);
    o.z = pk2(tl[(8 * c + 4) * 65 + n], tl[(8 * c + 5) * 65 + n]); o.w = pk2(tl[(8 * c + 6) * 65 + n], tl[(8 * c + 7) * 65 + n]);
    *(u32x4*)(WT + (size_t)(n0 + n) * K + k0 + 8 * c) = o;
    BSYNC();
}
__device__ __forceinline__ void p0_wfused_item(const float* wq, const float* sk, unsigned short* WfT, int hc, int kt, float* lds) {
    float* skl = lds;
    float* wql = lds + 128 * 129;
    for (int i = TID; i < 16384; i += NTHR) { const int n = i >> 7, d = i & 127; skl[n * 129 + d] = sk[(size_t)hc * 16384 + i]; }
    for (int i = TID; i < 64 * 128; i += NTHR) { const int k = i >> 7, d = i & 127; wql[d * 64 + k] = wq[(size_t)(kt * 64 + k) * 2048 + hc * 128 + d]; }
    BSYNC();
    const int n = TID & 127, kg = TID >> 7;
    float acc[16];
#pragma unroll
    for (int j = 0; j < 16; ++j) acc[j] = 0.f;
    for (int d = 0; d < 128; ++d) {
        const float a = skl[n * 129 + d]; const float* bp = wql + d * 64 + kg * 16;
#pragma unroll
        for (int j = 0; j < 16; ++j) acc[j] += a * bp[j];
    }
    unsigned short* dst = WfT + (size_t)(hc * 128 + n) * D + kt * 64 + kg * 16;
    u32x4 o0, o1;
    o0.x = pk2(acc[0], acc[1]); o0.y = pk2(acc[2], acc[3]); o0.z = pk2(acc[4], acc[5]); o0.w = pk2(acc[6], acc[7]);
    o1.x = pk2(acc[8], acc[9]); o1.y = pk2(acc[10], acc[11]); o1.z = pk2(acc[12], acc[13]); o1.w = pk2(acc[14], acc[15]);
    *(u32x4*)dst = o0; *(u32x4*)(dst + 8) = o1;
    BSYNC();
}
__device__ __forceinline__ void rms_rows(const float* X, const float* g, unsigned short* H, int gw, int ngw) {
    const int lane = TID & 63;
    for (int m = gw; m < T; m += ngw) {
        const f32x4* xr = (const f32x4*)(X + (size_t)m * D) + lane; f32x4 v[4]; float s = 0.f;
#pragma unroll
        for (int j = 0; j < 4; ++j) { v[j] = xr[64 * j]; s += (v[j].x * v[j].x + v[j].y * v[j].y) + (v[j].z * v[j].z + v[j].w * v[j].w); }
        const float rstd = 1.0f / sqrtf(wave_sum(s) * (1.f / D) + RMS_EPS);
        u32x2* o8 = (u32x2*)(H + (size_t)m * D) + lane;
#pragma unroll
        for (int j = 0; j < 4; ++j) { const f32x4 gg = ((const f32x4*)g)[lane + 64 * j]; u32x2 w; w.x = pk2(v[j].x * rstd * gg.x, v[j].y * rstd * gg.y); w.y = pk2(v[j].z * rstd * gg.z, v[j].w * rstd * gg.w); o8[64 * j] = w; }
    }
}
__device__ __forceinline__ void p0_prologue(const Params& p, int bid, int nblk, char* smem) {
    float* lds = (float*)smem;
    unsigned char* ws = p.ws;
    unsigned short* WinT = (unsigned short*)(ws + WS_WINT); unsigned short* WoutT = (unsigned short*)(ws + WS_WOUTT); unsigned short* WfT = (unsigned short*)(ws + WS_WFT);
    constexpr int I_IN = 640, I_OUT = 256, I_WF = 256;
    for (int it = bid; it < I_IN + I_OUT + I_WF; it += nblk) {
        int r = it;
        if (r < I_IN) { p0_transpose_tile(p.w_in, D, 2464, WinT, (r / 40) * 64, (r % 40) * 64, 1, lds); continue; } r -= I_IN;
        if (r < I_OUT) { p0_transpose_tile(p.w_out, D, D, WoutT, (r / 16) * 64, (r % 16) * 64, 0, lds); continue; } r -= I_OUT;
        p0_wfused_item(p.peer_wq, p.peer_subkeys, WfT, r / 16, r % 16, lds);
    }
    const size_t gt = (size_t)bid * NTHR + TID, ngt = (size_t)nblk * NTHR;
    float* biasP = (float*)(ws + WS_BIASP);
    for (size_t i = gt; i < (size_t)PCOLS; i += ngt) biasP[i] = (i >= 1536 && i < 2304) ? p.b_attn[i - 1536] : 0.f;
    {
        const int lane = TID & 63; const int gw = bid * (NTHR / 64) + (TID >> 6), ngw = nblk * (NTHR / 64);
        for (int rr = gw; rr < 2 * NEXP; rr += ngw) {
            const int tab = rr >= NEXP, row = rr - tab * NEXP;
            const float* src = (tab ? p.peer_v : p.peer_u) + (size_t)row * D;
            unsigned* dst = (unsigned*)(ws + (tab ? WS_V8 : WS_U8) + (size_t)row * D);
            f32x4 v[4]; float mx = 0.f;
#pragma unroll
            for (int j = 0; j < 4; ++j) { v[j] = ((const f32x4*)src)[lane + 64 * j]; mx = fmaxf(mx, fmaxf(fmaxf(fabsf(v[j].x), fabsf(v[j].y)), fmaxf(fabsf(v[j].z), fabsf(v[j].w)))); }
#pragma unroll
            for (int o = 1; o < 64; o <<= 1) mx = fmaxf(mx, shfl_xor_f(mx, o));
            int ex = 0; if (mx > 0.f) ex = ilogbf(mx);
            const float sc = ldexpf(1.f, 7 - ex), inv = ldexpf(1.f, ex - 7);
#pragma unroll
            for (int j = 0; j < 4; ++j) { unsigned w = 0u; w = cvt_pk_fp8_f32(v[j].x * sc, v[j].y * sc, w, false); w = cvt_pk_fp8_f32(v[j].z * sc, v[j].w * sc, w, true); dst[lane + 64 * j] = w; }
            if (lane == 0) ((float*)(ws + (tab ? WS_VSC : WS_USC)))[row] = inv;
        }
    }
    rms_rows(p.x, p.ln1_g, (unsigned short*)(ws + WS_H), bid * (NTHR / 64) + (TID >> 6), nblk * (NTHR / 64));
}

constexpr int RCH = 32;
__device__ __forceinline__ void rwkv_unit(const Params& p, int b, int h, char* smem) {
    float* fl = (float*)smem;
    float* wup = fl;
    float* aup = wup + 2048;
    float* gup = aup + 2048;
    float* lora = gup + 6144;
    float* r_l = lora + RCH * 160;
    float* w_l = r_l + RCH * 64;
    float* k_l = w_l + RCH * 64;
    float* v_l = k_l + RCH * 64;
    float* a_l = v_l + RCH * 64;
    float* b_l = a_l + RCH * 64;
    float* g_l = b_l + RCH * 64;
    float* o_l = g_l + RCH * 64;
    float* bon = o_l + RCH * 64;
    float* par = bon + RCH;
    const unsigned short* P = (const unsigned short*)(p.ws + WS_P);
    unsigned short* Y = (unsigned short*)(p.ws + WS_Y);
    const int tid = TID;
    for (int i = tid; i < 2048; i += NTHR) { const int j = i >> 6, ch = i & 63; wup[i] = p.w_up[j * 512 + h * 64 + ch]; aup[i] = p.a_up[j * 512 + h * 64 + ch]; }
    for (int i = tid; i < 6144; i += NTHR) { const int j = i >> 6, ch = i & 63; gup[i] = p.g_up[j * 512 + h * 64 + ch]; }
    if (tid < 64) {
        const int c = h * 64 + tid;
        par[tid] = p.mu_shift[c]; par[64 + tid] = p.mu_shift[512 + c]; par[128 + tid] = p.mu_shift[1024 + c];
        par[352 + tid] = p.w0[c]; par[416 + tid] = p.a0[c]; par[480 + tid] = p.k_k[c]; par[544 + tid] = p.k_a[c]; par[608 + tid] = p.r_k[c]; par[672 + tid] = p.lnx_w[c]; par[736 + tid] = p.lnx_b[c];
    }
    if (tid < 160) par[192 + tid] = p.mu_shift[1536 + tid];
    float st[8];
#pragma unroll
    for (int i = 0; i < 8; ++i) st[i] = 0.f;
    BSYNC();
#pragma unroll 1
    for (int s0 = 0; s0 < SEQ; s0 += RCH) {
#pragma unroll 2
        for (int e = tid; e < RCH * 352; e += NTHR) {
            const int tok = e / 352, c = e - tok * 352;
            int col; float mu;
            if (c < 64) { col = PC_R + h * 64 + c; mu = par[c]; }
            else if (c < 128) { col = PC_K + h * 64 + (c - 64); mu = par[c]; }
            else if (c < 192) { col = PC_V + h * 64 + (c - 128); mu = par[c]; }
            else { col = PC_LORA + (c - 192); mu = par[c]; }
            const size_t t = (size_t)b * SEQ + s0 + tok;
            const float pc = bfl(P[t * PCOLS + col]);
            const float pp = (s0 + tok > 0) ? bfl(P[(t - 1) * PCOLS + col]) : 0.f;
            const float ps = pc + mu * (pp - pc);
            if (c < 64) r_l[tok * 64 + c] = ps;
            else if (c < 128) k_l[tok * 64 + (c - 64)] = ps;
            else if (c < 192) v_l[tok * 64 + (c - 128)] = ps;
            else { const int j = c - 192; lora[tok * 160 + j] = j < 32 ? tanhf(ps) : (j < 64 ? ps : sigmoidf_(ps)); }
        }
        BSYNC();
        {
            const int ch = tid & 63, tg = tid >> 6;
            float wr[4], ap[4], gg[4];
#pragma unroll
            for (int q = 0; q < 4; ++q) { wr[q] = 0.f; ap[q] = 0.f; gg[q] = 0.f; }
#pragma unroll 2
            for (int j = 0; j < 32; ++j) {
                const float wu = wup[j * 64 + ch], au = aup[j * 64 + ch];
#pragma unroll
                for (int q = 0; q < 4; ++q) { wr[q] += lora[(4 * tg + q) * 160 + j] * wu; ap[q] += lora[(4 * tg + q) * 160 + 32 + j] * au; }
            }
#pragma unroll 4
            for (int j = 0; j < 96; ++j) {
                const float gu = gup[j * 64 + ch];
#pragma unroll
                for (int q = 0; q < 4; ++q) gg[q] += lora[(4 * tg + q) * 160 + 64 + j] * gu;
            }
#pragma unroll
            for (int q = 0; q < 4; ++q) {
                const int tok = 4 * tg + q;
                const float z = -(par[352 + ch] + wr[q]);
                const float sp = fmaxf(z, 0.f) + log1pf(expf(-fabsf(z)));
                const float w = -sp - 0.5f;
                const float decay = expf(-expf(w));
                const float a = sigmoidf_(par[416 + ch] + ap[q]);
                const float kraw = k_l[tok * 64 + ch];
                const float kkv = kraw * par[480 + ch];
                const float nrm = sqrtf(wave_sum(kkv * kkv));
                const float kk = kkv / fmaxf(nrm, 1e-12f);
                const float kmod = kraw * (1.f + (a - 1.f) * par[544 + ch]);
                const float bo = wave_sum(r_l[tok * 64 + ch] * kmod * par[608 + ch]);
                w_l[tok * 64 + ch] = decay; k_l[tok * 64 + ch] = kmod; a_l[tok * 64 + ch] = -kk; b_l[tok * 64 + ch] = kk * a; g_l[tok * 64 + ch] = gg[q];
                if (ch == 0) bon[tok] = bo;
            }
        }
        BSYNC();
        {
            const int v = tid >> 3, kq = tid & 7;
#pragma unroll 1
            for (int tt = 0; tt < RCH; ++tt) {
                const f32x4 w0 = *(const f32x4*)(w_l + tt * 64 + 8 * kq), w1 = *(const f32x4*)(w_l + tt * 64 + 8 * kq + 4);
                const f32x4 a0 = *(const f32x4*)(a_l + tt * 64 + 8 * kq), a1 = *(const f32x4*)(a_l + tt * 64 + 8 * kq + 4);
                const f32x4 b0 = *(const f32x4*)(b_l + tt * 64 + 8 * kq), b1 = *(const f32x4*)(b_l + tt * 64 + 8 * kq + 4);
                const f32x4 k0 = *(const f32x4*)(k_l + tt * 64 + 8 * kq), k1 = *(const f32x4*)(k_l + tt * 64 + 8 * kq + 4);
                const f32x4 r0 = *(const f32x4*)(r_l + tt * 64 + 8 * kq), r1 = *(const f32x4*)(r_l + tt * 64 + 8 * kq + 4);
                const float vv = v_l[tt * 64 + v];
                float sa = 0.f;
#pragma unroll
                for (int i = 0; i < 4; ++i) { sa += st[i] * a0[i]; sa += st[4 + i] * a1[i]; }
                sa += shfl_xor_f(sa, 1); sa += shfl_xor_f(sa, 2); sa += shfl_xor_f(sa, 4);
                float o = 0.f;
#pragma unroll
                for (int i = 0; i < 4; ++i) {
                    st[i] = st[i] * w0[i] + sa * b0[i] + vv * k0[i]; o += st[i] * r0[i];
                    st[4 + i] = st[4 + i] * w1[i] + sa * b1[i] + vv * k1[i]; o += st[4 + i] * r1[i];
                }
                o += shfl_xor_f(o, 1); o += shfl_xor_f(o, 2); o += shfl_xor_f(o, 4);
                if (kq == 0) o_l[tt * 64 + v] = o;
            }
        }
        BSYNC();
        {
            const int ch = tid & 63, tg = tid >> 6;
#pragma unroll
            for (int q = 0; q < 4; ++q) {
                const int tok = 4 * tg + q;
                const float o = o_l[tok * 64 + ch];
                const float mean = wave_sum(o) * (1.f / 64.f);
                const float dv = o - mean;
                const float var = wave_sum(dv * dv) * (1.f / 64.f);
                float y = dv * (1.0f / sqrtf(var + LNX_EPS)) * par[672 + ch] + par[736 + ch];
                y = (y + bon[tok] * v_l[tok * 64 + ch]) * g_l[tok * 64 + ch];
                Y[((size_t)b * SEQ + s0 + tok) * D + h * 64 + ch] = (unsigned short)f2bf(y);
            }
        }
        BSYNC();
    }
}

constexpr int KPITCH = 72, VPITCH = 260;
__device__ __forceinline__ void attn_unit(const Params& p, int b, int n, char* smem) {
    unsigned short* Kl = (unsigned short*)smem;
    unsigned short* Vt = Kl + 2 * 256 * KPITCH;
    float* ssl = (float*)(Vt + 2 * 64 * VPITCH);
    float* rstdl = ssl + 1024;
    float* wsf = rstdl + 128;
    const unsigned short* P = (const unsigned short*)(p.ws + WS_P);
    unsigned short* Y = (unsigned short*)(p.ws + WS_Y);
    const int tid = TID, lane = tid & 63, w = tid >> 6, q = lane & 31, hh = lane >> 5, g = w >> 2;
    const long tb = (long)b * SEQ + (long)(n - 1) * 128;
    for (int i = tid; i < 4096; i += NTHR) {
        const int c = i & 7, kj = (i >> 3) & 255, gg = i >> 11;
        const bool valid = (n > 0) || (kj >= 128);
        u32x4 kv = (u32x4){0u, 0u, 0u, 0u}, vv = (u32x4){0u, 0u, 0u, 0u};
        if (valid) { const unsigned short* row = P + (size_t)(tb + kj) * PCOLS; kv = *(const u32x4*)(row + PC_AK + gg * 64 + c * 8); vv = *(const u32x4*)(row + PC_AV + gg * 64 + c * 8); }
        *(u32x4*)(Kl + (gg * 256 + kj) * KPITCH + c * 8) = kv;
        unsigned short* vd = Vt + (gg * 64 + c * 8) * VPITCH + kj;
        vd[0 * VPITCH] = (unsigned short)(vv.x & 0xffff); vd[1 * VPITCH] = (unsigned short)(vv.x >> 16);
        vd[2 * VPITCH] = (unsigned short)(vv.y & 0xffff); vd[3 * VPITCH] = (unsigned short)(vv.y >> 16);
        vd[4 * VPITCH] = (unsigned short)(vv.z & 0xffff); vd[5 * VPITCH] = (unsigned short)(vv.z >> 16);
        vd[6 * VPITCH] = (unsigned short)(vv.w & 0xffff); vd[7 * VPITCH] = (unsigned short)(vv.w >> 16);
    }
    BSYNC();
    const float sink = p.attn_sinks[w];
    const long tq_blk = (long)b * SEQ + (long)n * 128;
    for (int it = 0; it < 4; ++it) {
        bf16x8 qf[4];
#pragma unroll
        for (int ks = 0; ks < 4; ++ks) qf[ks] = *(const bf16x8*)(P + (size_t)(tq_blk + 32 * it + q) * PCOLS + PC_Q + w * 64 + 16 * ks + 8 * hh);
        f32x16 pb[5];
        float mloc = sink;
        const int iq = 32 * it + q;
#pragma unroll
        for (int bi = 0; bi < 5; ++bi) {
            const int jb = it + bi;
            const bool active = (n > 0) || (jb >= 4);
#pragma unroll
            for (int r = 0; r < 16; ++r) pb[bi][r] = 0.f;
            if (active) {
#pragma unroll
                for (int ks = 0; ks < 4; ++ks) { const bf16x8 kf = *(const bf16x8*)(Kl + (g * 256 + 32 * jb + q) * KPITCH + 16 * ks + 8 * hh); pb[bi] = mfma32(kf, qf[ks], pb[bi]); }
            }
#pragma unroll
            for (int r = 0; r < 16; ++r) {
                const int kj = 32 * jb + crow(r, hh);
                const bool ok = active && (kj >= iq + 1) && (kj <= iq + 128);
                const float s = ok ? pb[bi][r] * 0.125f : -1e30f;
                pb[bi][r] = s; mloc = fmaxf(mloc, s);
            }
        }
        mloc = fmaxf(mloc, shfl_xor_f(mloc, 32));
        float lsum = 0.f;
#pragma unroll
        for (int bi = 0; bi < 5; ++bi)
#pragma unroll
            for (int r = 0; r < 16; ++r) { const float e = expf(pb[bi][r] - mloc); pb[bi][r] = e; lsum += e; }
        lsum += shfl_xor_f(lsum, 32);
        lsum += expf(sink - mloc);
        f32x16 o[2];
#pragma unroll
        for (int r = 0; r < 16; ++r) { o[0][r] = 0.f; o[1][r] = 0.f; }
#pragma unroll
        for (int bi = 0; bi < 5; ++bi) {
            const int jb = it + bi;
            const bool active = (n > 0) || (jb >= 4);
            if (active) {
#pragma unroll
                for (int s2 = 0; s2 < 2; ++s2) {
                    bf16x8 pa;
#pragma unroll
                    for (int j = 0; j < 8; ++j) pa[j] = (short)f2bf(pb[bi][8 * s2 + j]);
#pragma unroll
                    for (int dt = 0; dt < 2; ++dt) {
                        const unsigned short* vp = Vt + (g * 64 + 32 * dt + q) * VPITCH + 32 * jb + 16 * s2 + 4 * hh;
                        const bf16x4 lo = *(const bf16x4*)vp, hi = *(const bf16x4*)(vp + 8);
                        const bf16x8 vf = (bf16x8){lo[0], lo[1], lo[2], lo[3], hi[0], hi[1], hi[2], hi[3]};
                        o[dt] = mfma32(pa, vf, o[dt]);
                    }
                }
            }
        }
        if (hh == 0) wsf[w * 32 + q] = 1.f / lsum;
        WSYNC();
        float ss[16];
#pragma unroll
        for (int r = 0; r < 16; ++r) { const float il = wsf[w * 32 + crow(r, hh)]; o[0][r] *= il; o[1][r] *= il; ss[r] = o[0][r] * o[0][r] + o[1][r] * o[1][r]; }
        WSYNC();
#pragma unroll
        for (int r = 0; r < 16; ++r) {
            float s = ss[r];
            s += shfl_xor_f(s, 1); s += shfl_xor_f(s, 2); s += shfl_xor_f(s, 4); s += shfl_xor_f(s, 8); s += shfl_xor_f(s, 16);
            if (q == 0) ssl[(32 * it + crow(r, hh)) * 8 + w] = s;
            const size_t trow = (size_t)(tq_blk + 32 * it + crow(r, hh));
            Y[trow * D + 512 + w * 64 + q] = (unsigned short)f2bf(o[0][r]);
            Y[trow * D + 512 + w * 64 + 32 + q] = (unsigned short)f2bf(o[1][r]);
        }
    }
    BSYNC();
    if (tid < 128) { float s = 0.f;
#pragma unroll
        for (int j = 0; j < 8; ++j) s += ssl[tid * 8 + j];
        rstdl[tid] = 1.0f / sqrtf(s * (1.f / 512.f) + RMS_EPS); }
    BSYNC();
    const float g0 = p.attn_norm_g[w * 64 + q], g1 = p.attn_norm_g[w * 64 + 32 + q];
    for (int it = 0; it < 4; ++it)
#pragma unroll
        for (int r = 0; r < 16; ++r) {
            const int qi = 32 * it + crow(r, hh); const float rs = rstdl[qi];
            unsigned short* yp = Y + (size_t)(tq_blk + qi) * D + 512 + w * 64 + q;
            yp[0] = (unsigned short)f2bf(bfl(yp[0]) * rs * g0); yp[32] = (unsigned short)f2bf(bfl(yp[32]) * rs * g1);
        }
    BSYNC();
}

__device__ __forceinline__ void ins16(float (&l)[16], float x) {
#pragma unroll
    for (int i = 0; i < 16; ++i) { const float t = fmaxf(l[i], x); x = fminf(l[i], x); l[i] = t; }
}
__device__ __forceinline__ void topk_half(float* S, float* lists, int trow0, int hd, int* IDX, float* GATE) {
    const int tid = TID, row = tid & 127, grp = (tid >> 7) & 1, half = tid >> 8;
    float l[16];
#pragma unroll
    for (int i = 0; i < 16; ++i) l[i] = -3.0e38f;
    const float* src = S + row * 260 + grp * 128 + half * 64;
    for (int c = 0; c < 64; c += 4) {
        const f32x4 v = *(const f32x4*)(src + c);
#pragma unroll
        for (int i = 0; i < 4; ++i) { const unsigned nidx = (unsigned)(half * 64 + c + i); const float sv = v[i]; const float key = __builtin_bit_cast(float, (__builtin_bit_cast(unsigned, sv) & ~127u) | (127u - nidx)); ins16(l, key); }
    }
    float* slot = lists + (row * 2 + grp) * 16;
    if (half == 1) {
#pragma unroll
        for (int i = 0; i < 16; ++i) slot[i] = l[i];
    }
    BSYNC();
    if (half == 0) {
#pragma unroll
        for (int i = 0; i < 16; ++i) ins16(l, slot[i]);
        if (grp == 1) {
#pragma unroll
            for (int i = 0; i < 16; ++i) slot[i] = l[i];
        }
    }
    BSYNC();
    if (tid < 128) {
        const float* bl = lists + (row * 2 + 1) * 16;
        float bs[16];
#pragma unroll
        for (int i = 0; i < 16; ++i) bs[i] = bl[i];
        float c16[16];
#pragma unroll
        for (int i = 0; i < 16; ++i) c16[i] = -3.0e38f;
#pragma unroll
        for (int i = 0; i < 16; ++i) {
            const int jmax = 16 / (i + 1);
            const float ai = __builtin_bit_cast(float, __builtin_bit_cast(unsigned, l[i]) & ~127u);
#pragma unroll
            for (int j = 0; j < 16; ++j) if (j < jmax) {
                const float bj = __builtin_bit_cast(float, __builtin_bit_cast(unsigned, bs[j]) & ~127u);
                const float sm = ai + bj;
                ins16(c16, __builtin_bit_cast(float, (__builtin_bit_cast(unsigned, sm) & ~255u) | (unsigned)(i * 16 + j)));
            }
        }
        float ev[16]; float den = 0.f;
        const float mx = __builtin_bit_cast(float, __builtin_bit_cast(unsigned, c16[0]) & ~255u);
#pragma unroll
        for (int k = 0; k < 16; ++k) { const float sv = __builtin_bit_cast(float, __builtin_bit_cast(unsigned, c16[k]) & ~255u); ev[k] = expf(sv - mx); den += ev[k]; }
        const float inv = 1.f / den;
        int* ip = IDX + (size_t)(trow0 + row) * 128 + hd * 16; float* gp = GATE + (size_t)(trow0 + row) * 128 + hd * 16;
#pragma unroll
        for (int k = 0; k < 16; ++k) {
            const unsigned code = __builtin_bit_cast(unsigned, c16[k]) & 255u; const int ci = (int)(code >> 4), cj = (int)(code & 15u);
            unsigned abits = 0u, bbits = 0u;
#pragma unroll
            for (int i = 0; i < 16; ++i) { abits = (ci == i) ? __builtin_bit_cast(unsigned, l[i]) : abits; bbits = (cj == i) ? __builtin_bit_cast(unsigned, bs[i]) : bbits; }
            const int ia = 127 - (int)(abits & 127u), ib = 127 - (int)(bbits & 127u);
            ip[k] = ia * 128 + ib; gp[k] = ev[k] * inv;
        }
    }
    BSYNC();
}

__device__ __forceinline__ float gelu_erf(float v) { return 0.5f * v * (1.f + erff(v * 0.70710678118654752f)); }
__device__ __forceinline__ void cvt16_fp8(const u32x4 w, float (&f)[16]) {
#pragma unroll
    for (int q = 0; q < 4; ++q) { const unsigned ww = w[q]; const f32x2 a = cvt_pk_f32_fp8(ww, false), b = cvt_pk_f32_fp8(ww, true); f[4 * q] = a.x; f[4 * q + 1] = a.y; f[4 * q + 2] = b.x; f[4 * q + 3] = b.y; }
}
__device__ __forceinline__ float reduce4(const float (&d)[4], int lane) {
    const bool b5 = (lane & 32) != 0, b4 = (lane & 16) != 0;
    float r[2];
#pragma unroll
    for (int i = 0; i < 2; ++i) { const float x = b5 ? d[2 + i] : d[i], y = b5 ? d[i] : d[2 + i]; r[i] = x + shfl_xor_f(y, 32); }
    float t = (b4 ? r[1] : r[0]) + shfl_xor_f(b4 ? r[0] : r[1], 16);
    t += shfl_xor_f(t, 8); t += shfl_xor_f(t, 4); t += shfl_xor_f(t, 2); t += shfl_xor_f(t, 1);
    return t;
}
__device__ __forceinline__ void peer_phase(const Params& p, int gw, int ngw) {
    const int lane = TID & 63;
    const unsigned short* H = (const unsigned short*)(p.ws + WS_H);
    const unsigned char* U8 = p.ws + WS_U8; const unsigned char* V8 = p.ws + WS_V8;
    const float* USC = (const float*)(p.ws + WS_USC); const float* VSC = (const float*)(p.ws + WS_VSC);
    const int* IDX = (const int*)(p.ws + WS_IDX); const float* GATE = (const float*)(p.ws + WS_GATE);
    float* X1 = p.out;
#define PEER_LOAD(UA, VA, bb) do { _Pragma("unroll") for (int u = 0; u < 4; ++u) { const int k = 4 * (bb) + u; const int e = rdlane_i(k < 64 ? myi0 : myi1, k & 63); \
        UA[u] = *(const u32x4*)(U8 + (size_t)e * D + 16 * lane); VA[u] = *(const u32x4*)(V8 + (size_t)e * D + 16 * lane); } } while (0)
#define PEER_COMPUTE(UA, VA, bb) do { float dd[4]; \
        _Pragma("unroll") for (int u = 0; u < 4; ++u) { float uf[16]; cvt16_fp8(UA[u], uf); float d = 0.f; _Pragma("unroll") for (int i = 0; i < 16; ++i) d += hf[i] * uf[i]; dd[u] = d; } \
        const float dsum = reduce4(dd, lane); const int kk = 4 * (bb) + (lane >> 4); \
        const float usc = shfl_f(kk < 64 ? myu0 : myu1, kk & 63), cf = shfl_f(kk < 64 ? myc0 : myc1, kk & 63); \
        const float av = gelu_erf(dsum * usc) * cf; \
        _Pragma("unroll") for (int u = 0; u < 4; ++u) { const float au = rdlane_f(av, 16 * u); float vf[16]; cvt16_fp8(VA[u], vf); _Pragma("unroll") for (int i = 0; i < 16; ++i) acc[i] += au * vf[i]; } } while (0)
    for (int t = gw; t < T; t += ngw) {
        const u32x4 hv0 = *(const u32x4*)(H + (size_t)t * D + 16 * lane), hv1 = *(const u32x4*)(H + (size_t)t * D + 16 * lane + 8);
        float hf[16];
        hf[0] = bf_lo(hv0.x); hf[1] = bf_hi(hv0.x); hf[2] = bf_lo(hv0.y); hf[3] = bf_hi(hv0.y); hf[4] = bf_lo(hv0.z); hf[5] = bf_hi(hv0.z); hf[6] = bf_lo(hv0.w); hf[7] = bf_hi(hv0.w);
        hf[8] = bf_lo(hv1.x); hf[9] = bf_hi(hv1.x); hf[10] = bf_lo(hv1.y); hf[11] = bf_hi(hv1.y); hf[12] = bf_lo(hv1.z); hf[13] = bf_hi(hv1.z); hf[14] = bf_lo(hv1.w); hf[15] = bf_hi(hv1.w);
        const int myi0 = IDX[(size_t)t * 128 + lane], myi1 = IDX[(size_t)t * 128 + 64 + lane];
        const float myu0 = USC[myi0], myu1 = USC[myi1];
        const float myc0 = GATE[(size_t)t * 128 + lane] * VSC[myi0], myc1 = GATE[(size_t)t * 128 + 64 + lane] * VSC[myi1];
        float acc[16];
#pragma unroll
        for (int i = 0; i < 16; ++i) acc[i] = 0.f;
        u32x4 ua[4], va[4], ub[4], vb[4];
        PEER_LOAD(ua, va, 0);
#pragma unroll 1
        for (int b = 0; b < 32; b += 2) {
            PEER_LOAD(ub, vb, b + 1);
            PEER_COMPUTE(ua, va, b);
            if (b + 2 < 32) PEER_LOAD(ua, va, b + 2);
            PEER_COMPUTE(ub, vb, b + 1);
        }
        float* xr = X1 + (size_t)t * D + 16 * lane;
        float ssq = 0.f; f32x4 xv[4];
#pragma unroll
        for (int j = 0; j < 4; ++j) { xv[j] = *(const f32x4*)(xr + 4 * j);
#pragma unroll
            for (int i = 0; i < 4; ++i) { xv[j][i] += acc[4 * j + i]; ssq += xv[j][i] * xv[j][i]; } }
        const float rstd = 1.0f / sqrtf(wave_sum(ssq) * (1.f / D) + RMS_EPS);
#pragma unroll
        for (int j = 0; j < 4; ++j) { const f32x4 gg = *(const f32x4*)(p.lnf_g + 16 * lane + 4 * j); f32x4 o;
#pragma unroll
            for (int i = 0; i < 4; ++i) o[i] = xv[j][i] * rstd * gg[i];
            *(f32x4*)(xr + 4 * j) = o; }
    }
#undef PEER_LOAD
#undef PEER_COMPUTE
}

#ifndef EMU
namespace pg8 {
#define PG8_LAS __attribute__((address_space(3)))
typedef unsigned short bf16_t;
typedef short bf16x8 __attribute__((ext_vector_type(8)));
typedef float f32x4 __attribute__((ext_vector_type(4)));
typedef unsigned u32x4 __attribute__((ext_vector_type(4)));
constexpr int BM = 256, BK = 64, HALF = 128, HTB = HALF * BK * 2  , STAGE_BYTES = 8 * HTB, NXCD = 8, WGM = 8;

__host__ __device__ __forceinline__ int lds_byte(int r, int c) { const int st = (r >> 4) * 2 + (c >> 5), rr = r & 15, cc = c & 31, ob = rr * 64 + cc * 2; return st * 1024 + (ob ^ (((ob >> 9) & 1) << 5)); }
__host__ __device__ __forceinline__ void stage_rc(int b, int& R, int& C) { const int st = b / 1024, sb = b % 1024, swz = sb ^ (((sb >> 9) & 1) << 5); R = (st >> 1) * 16 + swz / 64; C = (st & 1) * 32 + (swz % 64) / 2; }
__host__ __device__ __forceinline__ int perm32(int rho) { const int n = rho >> 4, i = rho & 15; return 8 * (i >> 2) + 4 * n + (i & 3); }

struct Unit { int pm, pn; };
struct Gemm { const bf16_t* A; const bf16_t* Bt; int M, N, K; };

struct StaticOrder {
    int nM, nN, nwg, G, c;
    __host__ __device__ void init(int M, int N, int G_, int c_) { nM = M / BM; nN = N / BM; nwg = nM * nN; G = G_; c = c_; }
    __host__ __device__ bool next(int i, Unit& u) const {
        const long L = (long)i * G + c; if (L >= nwg) return false;
        int wgid = (int)L; { const int q = nwg / NXCD, r = nwg % NXCD, xcd = wgid % NXCD, off = wgid / NXCD; wgid = (xcd < r ? xcd * (q + 1) : r * (q + 1) + (xcd - r) * q) + off; }
        const int nig = WGM * nN, gid = wgid / nig, fm = gid * WGM, gsz = (nM - fm) < WGM ? (nM - fm) : WGM;
        u.pm = fm + ((wgid % nig) % gsz); u.pn = (wgid % nig) / gsz; return true;
    }
    __device__ __forceinline__ void a_ready(const Unit&) const {}
    __device__ __forceinline__ void done(const Unit&) const {}
};

__device__ __forceinline__ unsigned cvt_pk_bf16(float lo, float hi) { unsigned r; asm volatile("v_cvt_pk_bf16_f32 %0, %1, %2" : "=v"(r) : "v"(lo), "v"(hi)); return r; }
typedef float f32x2 __attribute__((ext_vector_type(2)));
__device__ __forceinline__ f32x2 gelu_pk(f32x2 v) {
    const f32x2 av = __builtin_elementwise_abs(v), d = av * 0.2316418882f + 1.0f;
    f32x2 t; t.x = __builtin_amdgcn_rcpf(d.x); t.y = __builtin_amdgcn_rcpf(d.y);
    f32x2 q = t * 0.5307027145f + (-0.7265760135f); q = q * t + 0.7107068705f; q = q * t + (-0.142248368f); q = q * t + 0.127414796f; q = q * t;
    const f32x2 s = (v * v) * (-0.72134752044f);
    f32x2 e; e.x = __builtin_amdgcn_exp2f(s.x); e.y = __builtin_amdgcn_exp2f(s.y);
    const f32x2 m = v * (q * e), r = v - m;
    f32x2 o; o.x = v.x < 0.f ? m.x : r.x; o.y = v.y < 0.f ? m.y : r.y; return o;
}

template <int ACT  > struct EpiBf16 {
    static constexpr bool PERM = true, AFTER_DRAIN = false; static_assert(ACT == 0 || ACT == 1, "EpiBf16: ACT is 0 (none) or 1 (gelu_pk)");
    bf16_t* O; int ldc; const float* bias; int split_cols; size_t split_stride; float scale0;
    __device__ __forceinline__ void operator()(const f32x4 (&acc)[2][2][4][2], const Unit& u, int wr, int wc, int fr, int fq) const {
        const int row0 = u.pm * BM + wr * 64 + fr; int colt = u.pn * BM; bf16_t* base = O;
        float sc = 1.f; if (split_cols) { const int t = colt / split_cols; base += (size_t)t * split_stride; colt -= t * split_cols; if (t == 0) sc = scale0; }
        const int col0 = colt + wc * 32 + 8 * fq, bcol0 = u.pn * BM + wc * 32 + 8 * fq;
        f32x4 bv[2][2];
#pragma unroll
        for (int bj = 0; bj < 2; ++bj)
#pragma unroll
            for (int n = 0; n < 2; ++n) bv[bj][n] = bias ? *(const f32x4*)(bias + bcol0 + bj * HALF + 4 * n) : (f32x4){0.f, 0.f, 0.f, 0.f};
#pragma unroll
        for (int ai = 0; ai < 2; ++ai)
#pragma unroll
            for (int m = 0; m < 4; ++m) { bf16_t* rowp = base + (size_t)(row0 + ai * HALF + m * 16) * ldc + col0;
#pragma unroll
                for (int bj = 0; bj < 2; ++bj) { f32x4 v0 = acc[ai][bj][m][0] + bv[bj][0], v1 = acc[ai][bj][m][1] + bv[bj][1];
                    if (ACT == 1) { f32x2 a = gelu_pk((f32x2){v0[0], v0[1]}), b = gelu_pk((f32x2){v0[2], v0[3]}), c = gelu_pk((f32x2){v1[0], v1[1]}), d = gelu_pk((f32x2){v1[2], v1[3]});
                        v0 = (f32x4){a.x, a.y, b.x, b.y}; v1 = (f32x4){c.x, c.y, d.x, d.y}; }
                    v0 = v0 * sc; v1 = v1 * sc; u32x4 w; w.x = cvt_pk_bf16(v0[0], v0[1]); w.y = cvt_pk_bf16(v0[2], v0[3]); w.z = cvt_pk_bf16(v1[0], v1[1]); w.w = cvt_pk_bf16(v1[2], v1[3]);
                    *(u32x4*)(rowp + bj * HALF) = w; } }
    }
};
template <class Epi, class Sched, bool ALIGN_EPI = false, bool SP2 = false>
__device__ __forceinline__ void gemm_phase(PG8_LAS unsigned char* lds, const Gemm g, const Sched& S, const Epi& E) {
    const int tid = threadIdx.x, wid = __builtin_amdgcn_readfirstlane(tid >> 6), lane = tid & 63, wr = wid >> 2, wc = wid & 3, fr = lane & 15, fq = lane >> 4;
    const int K = g.K, nt = K / BK;
    unsigned voffA[2], voffB[2];
#pragma unroll
    for (int i = 0; i < 2; ++i) { int R, C; stage_rc(tid * 16 + i * 8192, R, C); const int Rb = Epi::PERM ? ((R & ~31) + perm32(R & 31)) : R;
        voffA[i] = (unsigned)(R * K + C) * 2u; voffB[i] = (unsigned)(Rb * K + C) * 2u; }
    const size_t kstep = (size_t)(BK * 2);
    const size_t hstep = (size_t)HALF * K * 2;
    const size_t tstep = 2 * hstep;
    const unsigned ldsw = (unsigned)wid * 1024u;
    const int aoff = lds_byte(wr * 64 + fr, fq * 8), boff = lds_byte(wc * 32 + fr, fq * 8);
#define PG8_SA(b, h) (((b) * 2 + (h)) * HTB)
#define PG8_SB(b, h) ((4 + (b) * 2 + (h)) * HTB)
#define PG8_STAGE(bufoff, gbase, voff) do { _Pragma("unroll") for (int _i = 0; _i < 2; ++_i) \
        __builtin_amdgcn_global_load_lds((const unsigned*)((const char*)(gbase) + (voff)[_i]), (PG8_LAS unsigned*)(lds + (bufoff) + ldsw + _i * 8192), 16, 0, 0); } while (0)
#define PG8_LDA(dst, b, h) do { _Pragma("unroll") for (int m = 0; m < 4; ++m) _Pragma("unroll") for (int k = 0; k < 2; ++k) dst[m][k] = *(const PG8_LAS bf16x8*)(lds + PG8_SA(b, h) + aoff + m * 2048 + k * 1024); } while (0)
#define PG8_LDB(dst, b, h) do { _Pragma("unroll") for (int n = 0; n < 2; ++n) _Pragma("unroll") for (int k = 0; k < 2; ++k) dst[n][k] = *(const PG8_LAS bf16x8*)(lds + PG8_SB(b, h) + boff + n * 2048 + k * 1024); } while (0)
#define PG8_MMA(ai, bj, At, Bt) do { __builtin_amdgcn_s_setprio(1); _Pragma("unroll") for (int m = 0; m < 4; ++m) _Pragma("unroll") for (int n = 0; n < 2; ++n) _Pragma("unroll") for (int k = 0; k < 2; ++k) \
        acc[ai][bj][m][n] = __builtin_amdgcn_mfma_f32_16x16x32_bf16(Bt[n][k], At[m][k], acc[ai][bj][m][n], 0, 0, 0); __builtin_amdgcn_s_setprio(0); } while (0)
#define PG8_WAIT_V(n) asm volatile("s_waitcnt vmcnt(" #n ")" ::: "memory")
#define PG8_WAIT_L(n) asm volatile("s_waitcnt lgkmcnt(" #n ")" ::: "memory")
#define PG8_BAR __builtin_amdgcn_s_barrier()
#define PG8_SCHED __builtin_amdgcn_sched_barrier(0)
    Unit cur, nxt; int ui = 0;
    if (!S.next(0, cur)) return;
    f32x4 acc[2][2][4][2];
#pragma unroll
    for (int a = 0; a < 2; ++a)
#pragma unroll
        for (int b = 0; b < 2; ++b)
#pragma unroll
            for (int m = 0; m < 4; ++m)
#pragma unroll
                for (int n = 0; n < 2; ++n) acc[a][b][m][n] = (f32x4){0.f, 0.f, 0.f, 0.f};
    bf16x8 At[4][2], B0[2][2], B1[2][2];
    const char* cA = (const char*)g.A + (size_t)cur.pm * tstep; const char* cB = (const char*)g.Bt + (size_t)cur.pn * tstep;
    S.a_ready(cur);
    if constexpr (SP2) {
        PG8_STAGE(PG8_SB(0, 0), cB, voffB); PG8_STAGE(PG8_SB(0, 1), cB + hstep, voffB); PG8_STAGE(PG8_SA(0, 0), cA, voffA); PG8_STAGE(PG8_SA(0, 1), cA + hstep, voffA);
        if (wr == 1) PG8_BAR;
        PG8_WAIT_V(2); PG8_BAR;
        PG8_STAGE(PG8_SB(1, 0), cB + kstep, voffB); PG8_STAGE(PG8_SA(1, 0), cA + kstep, voffA); PG8_STAGE(PG8_SB(1, 1), cB + hstep + kstep, voffB);
        PG8_WAIT_V(6); PG8_BAR;
    } else {
        PG8_STAGE(PG8_SB(0, 0), cB, voffB); PG8_STAGE(PG8_SA(0, 0), cA, voffA); PG8_STAGE(PG8_SB(0, 1), cB + hstep, voffB); PG8_STAGE(PG8_SA(0, 1), cA + hstep, voffA);
        if (wr == 1) PG8_BAR;
        PG8_WAIT_V(4); PG8_BAR;
        PG8_STAGE(PG8_SB(1, 0), cB + kstep, voffB); PG8_STAGE(PG8_SA(1, 0), cA + kstep, voffA); PG8_STAGE(PG8_SB(1, 1), cB + hstep + kstep, voffB);
        PG8_WAIT_V(6); PG8_BAR;
    }
    for (;;) {
        const bool has_next = S.next(ui + 1, nxt);
        const char* nA = has_next ? (const char*)g.A + (size_t)nxt.pm * tstep : cA; const char* nB = has_next ? (const char*)g.Bt + (size_t)nxt.pn * tstep : cB;
        for (int t = 0; t < nt; t += 2) {
            const bool last = (t == nt - 2);
            const char* a1 = cA + (size_t)(t + 1) * kstep;
            const char* a2 = last ? nA : cA + (size_t)(t + 2) * kstep; const char* b2 = last ? nB : cB + (size_t)(t + 2) * kstep;
            const char* a3 = a2 + kstep; const char* b3 = b2 + kstep;
            if (last && has_next) S.a_ready(nxt);
            if constexpr (SP2) {
            PG8_LDB(B0, 0, 0); PG8_LDB(B1, 0, 1); PG8_SCHED; PG8_LDA(At, 0, 0); PG8_STAGE(PG8_SA(1, 1), a1 + hstep, voffA);
            PG8_WAIT_V(8); PG8_WAIT_L(0); PG8_BAR; PG8_MMA(0, 0, At, B0); PG8_MMA(0, 1, At, B1); PG8_BAR; PG8_SCHED;
            PG8_LDA(At, 0, 1); PG8_STAGE(PG8_SB(0, 0), b2, voffB); PG8_STAGE(PG8_SB(0, 1), b2 + hstep, voffB); PG8_STAGE(PG8_SA(0, 0), a2, voffA);
            PG8_WAIT_V(8); PG8_WAIT_L(0); PG8_BAR; PG8_MMA(1, 0, At, B0); PG8_MMA(1, 1, At, B1); PG8_BAR; PG8_SCHED;
            PG8_LDB(B0, 1, 0); PG8_LDB(B1, 1, 1); PG8_SCHED; PG8_LDA(At, 1, 0); PG8_STAGE(PG8_SA(0, 1), a2 + hstep, voffA);
            PG8_WAIT_V(8); PG8_WAIT_L(0); PG8_BAR; PG8_MMA(0, 0, At, B0); PG8_MMA(0, 1, At, B1); PG8_BAR; PG8_SCHED;
            PG8_LDA(At, 1, 1); PG8_STAGE(PG8_SB(1, 0), b3, voffB); PG8_STAGE(PG8_SB(1, 1), b3 + hstep, voffB); PG8_STAGE(PG8_SA(1, 0), a3, voffA);
            PG8_WAIT_V(8); PG8_WAIT_L(0); PG8_BAR; PG8_MMA(1, 0, At, B0); PG8_MMA(1, 1, At, B1); PG8_BAR; PG8_SCHED;
            } else {
            PG8_LDB(B0, 0, 0); PG8_SCHED; PG8_LDA(At, 0, 0); PG8_STAGE(PG8_SA(1, 1), a1 + hstep, voffA);
            PG8_WAIT_L(8); PG8_BAR; PG8_WAIT_L(0); PG8_MMA(0, 0, At, B0); PG8_BAR; PG8_SCHED;
            PG8_LDB(B1, 0, 1); PG8_STAGE(PG8_SB(0, 0), b2, voffB);
            PG8_BAR; PG8_WAIT_L(0); PG8_MMA(0, 1, At, B1); PG8_BAR;
            PG8_LDA(At, 0, 1); PG8_STAGE(PG8_SA(0, 0), a2, voffA);
            PG8_BAR; PG8_WAIT_L(0); PG8_MMA(1, 0, At, B0); PG8_BAR; PG8_SCHED;
            PG8_STAGE(PG8_SB(0, 1), b2 + hstep, voffB);
            PG8_WAIT_V(6); PG8_BAR; PG8_MMA(1, 1, At, B1); PG8_BAR;
            PG8_LDB(B0, 1, 0); PG8_SCHED; PG8_LDA(At, 1, 0); PG8_STAGE(PG8_SA(0, 1), a2 + hstep, voffA);
            PG8_WAIT_L(8); PG8_BAR; PG8_WAIT_L(0); PG8_MMA(0, 0, At, B0); PG8_BAR; PG8_SCHED;
            PG8_LDB(B1, 1, 1); PG8_STAGE(PG8_SB(1, 0), b3, voffB);
            PG8_BAR; PG8_WAIT_L(0); PG8_MMA(0, 1, At, B1); PG8_BAR;
            PG8_LDA(At, 1, 1); PG8_STAGE(PG8_SA(1, 0), a3, voffA);
            PG8_BAR; PG8_WAIT_L(0); PG8_MMA(1, 0, At, B0); PG8_BAR; PG8_SCHED;
            PG8_STAGE(PG8_SB(1, 1), b3 + hstep, voffB);
            PG8_WAIT_V(6); PG8_BAR; PG8_MMA(1, 1, At, B1); PG8_BAR;
            }
        }
        if constexpr (ALIGN_EPI) { if (wr == 0) PG8_BAR; }
        if constexpr (!Epi::AFTER_DRAIN) { E(acc, cur, wr, wc, fr, fq); S.done(cur); }
        if (!has_next) break;
#pragma unroll
        for (int a = 0; a < 2; ++a)
#pragma unroll
            for (int b = 0; b < 2; ++b)
#pragma unroll
                for (int m = 0; m < 4; ++m)
#pragma unroll
                    for (int n = 0; n < 2; ++n) acc[a][b][m][n] = (f32x4){0.f, 0.f, 0.f, 0.f};
        cur = nxt; cA = nA; cB = nB; ++ui;
        if constexpr (ALIGN_EPI) { if (wr == 1) PG8_BAR; }
    }
    PG8_WAIT_V(0);
    if constexpr (!ALIGN_EPI) { if (wr == 0) PG8_BAR; }
    PG8_BAR;
    if constexpr (Epi::AFTER_DRAIN) { E.fused(acc, cur, wr, wc, fr, fq, lds, wid, lane); S.done(cur); }
#undef PG8_SA
#undef PG8_SB
#undef PG8_STAGE
#undef PG8_LDA
#undef PG8_LDB
#undef PG8_MMA
#undef PG8_WAIT_V
#undef PG8_WAIT_L
#undef PG8_BAR
#undef PG8_SCHED
}
}

struct OneUnit {
    pg8::Unit u;
    __device__ __forceinline__ bool next(int i, pg8::Unit& o) const { if (i) return false; o = u; return true; }
    __device__ __forceinline__ void a_ready(const pg8::Unit&) const {}
    __device__ __forceinline__ void done(const pg8::Unit&) const {}
};
struct EpiResF32 {
    static constexpr bool PERM = false, AFTER_DRAIN = false;
    const float* base; float* out;
    __device__ __forceinline__ void operator()(const pg8::f32x4 (&acc)[2][2][4][2], const pg8::Unit& u, int wr, int wc, int fr, int fq) const {
#pragma unroll
        for (int ai = 0; ai < 2; ++ai)
#pragma unroll
            for (int m = 0; m < 4; ++m) {
                const size_t row = (size_t)u.pm * 256 + ai * 128 + wr * 64 + m * 16 + fr;
#pragma unroll
                for (int bj = 0; bj < 2; ++bj)
#pragma unroll
                    for (int n = 0; n < 2; ++n) {
                        const size_t off = row * D + u.pn * 256 + bj * 128 + wc * 32 + n * 16 + 4 * fq;
                        const pg8::f32x4 b = *(const pg8::f32x4*)(base + off);
                        *(pg8::f32x4*)(out + off) = b + acc[ai][bj][m][n];
                    }
            }
    }
};
struct EpiTopK {
    static constexpr bool PERM = false, AFTER_DRAIN = true;
    int* IDX; float* GATE;
    __device__ __forceinline__ void fused(pg8::f32x4 (&acc)[2][2][4][2], const pg8::Unit& u, int wr, int wc, int fr, int fq, PG8_LAS unsigned char* lds, int wid, int lane) const {
        float* S = (float*)lds; float* lists = S + 128 * 260;
#pragma unroll
        for (int ai = 0; ai < 2; ++ai) {
#pragma unroll
            for (int bj = 0; bj < 2; ++bj)
#pragma unroll
                for (int m = 0; m < 4; ++m)
#pragma unroll
                    for (int n = 0; n < 2; ++n) *(pg8::f32x4*)(S + (wr * 64 + m * 16 + fr) * 260 + bj * 128 + wc * 32 + n * 16 + 4 * fq) = acc[ai][bj][m][n];
            __syncthreads();
            topk_half(S, lists, u.pm * 256 + ai * 128, u.pn, IDX, GATE);
        }
    }
};

#ifndef PHM
#define PHM 255
#endif
constexpr int LDS_BYTES = 155648;
__global__ void __launch_bounds__(NTHR, 2) fwd_kernel(Params p) {
    extern __shared__ __attribute__((aligned(16))) unsigned char lds[];
    cg::grid_group grid = cg::this_grid();
    const int bid = blockIdx.x, nblk = gridDim.x;
    unsigned char* ws = p.ws;
#if PHM & 1
    p0_prologue(p, bid, nblk, (char*)lds);
#endif
    grid.sync();
#if PHM & 2
    {
        pg8::Gemm g{(const pg8::bf16_t*)(ws + WS_H), (const pg8::bf16_t*)(ws + WS_WINT), T, PCOLS, D};
        pg8::StaticOrder S; S.init(T, PCOLS, nblk, bid);
        pg8::EpiBf16<0> E{(pg8::bf16_t*)(ws + WS_P), PCOLS, (const float*)(ws + WS_BIASP), 0, 0, 1.f};
        pg8::gemm_phase<pg8::EpiBf16<0>, pg8::StaticOrder, true, true>((PG8_LAS unsigned char*)lds, g, S, E);
    }
#endif
    grid.sync();
#if PHM & 4
    for (int u = bid; u < BATCH * 8; u += nblk) rwkv_unit(p, u >> 3, u & 7, (char*)lds);
#endif
#if PHM & 8
    for (int u = bid; u < BATCH * (SEQ / 128); u += nblk) attn_unit(p, u / (SEQ / 128), u % (SEQ / 128), (char*)lds);
#endif
    grid.sync();
#if PHM & 16
    {
        pg8::Gemm g{(const pg8::bf16_t*)(ws + WS_Y), (const pg8::bf16_t*)(ws + WS_WOUTT), T, D, D};
        pg8::StaticOrder S; S.init(T, D, nblk, bid);
        EpiResF32 E{p.x, p.out};
        pg8::gemm_phase<EpiResF32, pg8::StaticOrder, true, true>((PG8_LAS unsigned char*)lds, g, S, E);
    }
#endif
    grid.sync();
#if PHM & 32
    rms_rows(p.out, p.ln2_g, (unsigned short*)(ws + WS_H), bid * (NTHR / 64) + (TID >> 6), nblk * (NTHR / 64));
#endif
    grid.sync();
#if PHM & 64
    {
        pg8::Gemm g{(const pg8::bf16_t*)(ws + WS_H), (const pg8::bf16_t*)(ws + WS_WFT), T, 2048, D};
        pg8::StaticOrder S; S.init(T, 2048, nblk, bid);
        EpiTopK E{(int*)(ws + WS_IDX), (float*)(ws + WS_GATE)};
        OneUnit one;
        for (int i = 0; S.next(i, one.u); ++i) pg8::gemm_phase<EpiTopK, OneUnit, false, true>((PG8_LAS unsigned char*)lds, g, one, E);
    }
#endif
    grid.sync();
#if PHM & 128
    peer_phase(p, bid * (NTHR / 64) + (TID >> 6), nblk * (NTHR / 64));
#endif
}

extern "C" void kernel_launch(void* const* d_in, const int* in_sizes, int n_in, void* d_out, int out_size, void* d_ws, size_t ws_size, hipStream_t stream) {
    static int grid = 0;
    if (grid == 0) {
        if (n_in != 24 || out_size != T * D || ws_size < WS_END) { fprintf(stderr, "kernel_launch: unexpected shapes (n_in %d, out %d, ws %zu < %zu)\n", n_in, out_size, ws_size, (size_t)WS_END); grid = -1; return; }
        int dev = 0, cus = 0, per_cu = 0;
        hipGetDevice(&dev);
        hipDeviceGetAttribute(&cus, hipDeviceAttributeMultiprocessorCount, dev);
        hipFuncSetAttribute((const void*)fwd_kernel, hipFuncAttributeMaxDynamicSharedMemorySize, LDS_BYTES);
        hipOccupancyMaxActiveBlocksPerMultiprocessor(&per_cu, (const void*)fwd_kernel, NTHR, LDS_BYTES);
        if (per_cu < 1) { fprintf(stderr, "kernel_launch: occupancy query says %d blocks per CU\n", per_cu); per_cu = 1; }
        if (per_cu > 1) per_cu = 1;
        grid = cus * per_cu;
        (void)hipGetLastError();
    }
    if (grid < 0) return;
    Params p{};
    const float** pp = (const float**)&p;
    for (int i = 0; i < 24; ++i) pp[i] = (const float*)d_in[i];
    p.out = (float*)d_out; p.ws = (unsigned char*)d_ws;
    void* args[] = {&p};
    hipError_t e = hipLaunchCooperativeKernel((const void*)fwd_kernel, dim3(grid), dim3(NTHR), args, LDS_BYTES, stream);
    if (e != hipSuccess) fprintf(stderr, "cooperative launch failed: %s (grid %d)\n", hipGetErrorString(e), grid);
}
#endif
```

```cpp
#ifndef EMU
#include <hip/hip_runtime.h>
#include <hip/hip_cooperative_groups.h>
#include <cstdio>
#include <cstdint>
namespace cg = cooperative_groups;
typedef short bf16x8 __attribute__((ext_vector_type(8)));
typedef short bf16x4 __attribute__((ext_vector_type(4)));
typedef float f32x16 __attribute__((ext_vector_type(16)));
typedef float f32x4 __attribute__((ext_vector_type(4)));
typedef float f32x2 __attribute__((ext_vector_type(2)));
typedef unsigned u32x4 __attribute__((ext_vector_type(4)));
typedef unsigned u32x2 __attribute__((ext_vector_type(2)));
#define TID ((int)threadIdx.x)
#define BSYNC() __syncthreads()
#define WSYNC() __builtin_amdgcn_wave_barrier()
#define OPAQUE(x) asm volatile("" : "+v"(x))
__device__ __forceinline__ float shfl_xor_f(float v, int m) { return __shfl_xor(v, m); }
__device__ __forceinline__ float shfl_f(float v, int s) { return __shfl(v, s); }
__device__ __forceinline__ int shfl_i(int v, int s) { return __shfl(v, s); }
__device__ __forceinline__ float rdlane_f(float v, int l) { return __builtin_bit_cast(float, __builtin_amdgcn_readlane(__builtin_bit_cast(int, v), l)); }
__device__ __forceinline__ int rdlane_i(int v, int l) { return __builtin_amdgcn_readlane(v, l); }
__device__ __forceinline__ f32x2 cvt_pk_f32_fp8(unsigned w, bool hi) { return hi ? __builtin_amdgcn_cvt_pk_f32_fp8((int)w, true) : __builtin_amdgcn_cvt_pk_f32_fp8((int)w, false); }
__device__ __forceinline__ unsigned cvt_pk_fp8_f32(float a, float b, unsigned old, bool hi) { return hi ? (unsigned)__builtin_amdgcn_cvt_pk_fp8_f32(a, b, (int)old, true) : (unsigned)__builtin_amdgcn_cvt_pk_fp8_f32(a, b, (int)old, false); }
__device__ __forceinline__ f32x16 mfma32(bf16x8 a, bf16x8 b, f32x16 c) { return __builtin_amdgcn_mfma_f32_32x32x16_bf16(a, b, c, 0, 0, 0); }
__device__ __forceinline__ f32x4 mfma16(bf16x8 a, bf16x8 b, f32x4 c) { return __builtin_amdgcn_mfma_f32_16x16x32_bf16(a, b, c, 0, 0, 0); }
#else
#define WSYNC() emu_barrier(g_wave_bar[TID >> 6], 64)
#define OPAQUE(x)
#endif

#ifndef CFG_BATCH
#define CFG_BATCH 32
#endif
#ifndef CFG_SEQ
#define CFG_SEQ 2048
#endif
constexpr int D = 1024, BATCH = CFG_BATCH, SEQ = CFG_SEQ, T = BATCH * SEQ;
constexpr int NTHR = 512;
constexpr int PCOLS = 2560;
constexpr int PC_R = 0, PC_K = 512, PC_V = 1024, PC_Q = 1536, PC_AK = 2048, PC_AV = 2176, PC_LORA = 2304;
constexpr int NEXP = 16384;
constexpr float RMS_EPS = 1e-6f, LNX_EPS = 64e-5f;

constexpr size_t MiB = 1u << 20;
constexpr size_t al1m(size_t x) { return (x + MiB - 1) / MiB * MiB; }
constexpr size_t WS_CTL = 0;
constexpr size_t WS_BIASP = 1 * MiB;
constexpr size_t WS_WINT = 2 * MiB;
constexpr size_t WS_WOUTT = 7 * MiB;
constexpr size_t WS_WFT = 9 * MiB;
constexpr size_t WS_U8 = 16 * MiB;
constexpr size_t WS_V8 = 32 * MiB;
constexpr size_t WS_FRG = 50 * MiB;
constexpr size_t WS_USC = 48 * MiB;
constexpr size_t WS_VSC = 49 * MiB;
constexpr size_t WS_H = 80 * MiB;
constexpr size_t WS_Y = WS_H + al1m((size_t)T * D * 2);
constexpr size_t WS_P = WS_Y + al1m((size_t)T * D * 2);
constexpr size_t WS_IDX = WS_P + al1m((size_t)T * PCOLS * 2);
constexpr size_t WS_GATE = WS_IDX + al1m((size_t)T * 128 * 4);
constexpr size_t WS_END = WS_GATE + al1m((size_t)T * 128 * 4);

struct Params {
    const float* x; const float* ln1_g; const float* w_in; const float* b_attn; const float* mu_shift; const float* w0; const float* w_up; const float* a0;
    const float* a_up; const float* g_up; const float* k_k; const float* k_a; const float* r_k; const float* lnx_w; const float* lnx_b; const float* attn_sinks;
    const float* attn_norm_g; const float* w_out; const float* ln2_g; const float* peer_wq; const float* peer_subkeys; const float* peer_u; const float* peer_v; const float* lnf_g;
    float* out; unsigned char* ws;
};

__device__ __forceinline__ unsigned f2bf(float f) { unsigned u = __builtin_bit_cast(unsigned, f); return (u + 0x7fffu + ((u >> 16) & 1u)) >> 16; }
__device__ __forceinline__ unsigned pk2(float lo, float hi) { return f2bf(lo) | (f2bf(hi) << 16); }
__device__ __forceinline__ float bfl(unsigned short b) { return __builtin_bit_cast(float, (unsigned)b << 16); }
__device__ __forceinline__ float bf_lo(unsigned w) { return __builtin_bit_cast(float, w << 16); }
__device__ __forceinline__ float bf_hi(unsigned w) { return __builtin_bit_cast(float, w & 0xffff0000u); }
__device__ __forceinline__ float wave_sum(float v) {
#pragma unroll
    for (int o = 1; o < 64; o <<= 1) v += shfl_xor_f(v, o);
    return v;
}
__device__ __forceinline__ int crow(int r, int hi) { return (r & 3) + 8 * (r >> 2) + 4 * hi; }
__device__ __forceinline__ int win_src_col(int n) { if (n < 1536) return n; if (n < 2304) return n + 160; if (n < 2464) return n - 768; return -1; }
__device__ __forceinline__ float sigmoidf_(float z) { return 1.f / (1.f + expf(-z)); }

__device__ __forceinline__ void p0_transpose_tile(const float* W, int K, int ldw, unsigned short* WT, int k0, int n0, int mode, float* tl) {
    const int t = TID, kk = t >> 6, nn = t & 63;
    const int sc = mode ? win_src_col(n0 + nn) : (n0 + nn);
#pragma unroll
    for (int i = 0; i < 8; ++i) { const int k = kk + 8 * i; tl[k * 65 + nn] = sc >= 0 ? W[(size_t)(k0 + k) * ldw + sc] : 0.f; }
    BSYNC();
    const int n = t >> 3, c = t & 7;
    u32x4 o;
    o.x = pk2(tl[(8 * c + 0) * 65 + n], tl[(8 * c + 1) * 65 + n]); o.y = pk2(tl[(8 * c + 2) * 65 + n], tl[(8 * c + 3) * 65 + n]);
    o.z = pk2(tl[(8 * c + 4) * 65 + n], tl[(8 * c + 5) * 65 + n]); o.w = pk2(tl[(8 * c + 6) * 65 + n], tl[(8 * c + 7) * 65 + n]);
    *(u32x4*)(WT + (size_t)(n0 + n) * K + k0 + 8 * c) = o;
    BSYNC();
}
__device__ __forceinline__ void p0_wfused_item(const float* wq, const float* sk, unsigned short* WfT, int hc, int kt, float* lds) {
    float* skl = lds;
    float* wql = lds + 128 * 129;
    for (int i = TID; i < 16384; i += NTHR) { const int n = i >> 7, d = i & 127; skl[n * 129 + d] = sk[(size_t)hc * 16384 + i]; }
    for (int i = TID; i < 64 * 128; i += NTHR) { const int k = i >> 7, d = i & 127; wql[d * 64 + k] = wq[(size_t)(kt * 64 + k) * 2048 + hc * 128 + d]; }
    BSYNC();
    const int n = TID & 127, kg = TID >> 7;
    float acc[16];
#pragma unroll
    for (int j = 0; j < 16; ++j) acc[j] = 0.f;
    for (int d = 0; d < 128; ++d) {
        const float a = skl[n * 129 + d]; const float* bp = wql + d * 64 + kg * 16;
#pragma unroll
        for (int j = 0; j < 16; ++j) acc[j] += a * bp[j];
    }
    unsigned short* dst = WfT + (size_t)(hc * 128 + n) * D + kt * 64 + kg * 16;
    u32x4 o0, o1;
    o0.x = pk2(acc[0], acc[1]); o0.y = pk2(acc[2], acc[3]); o0.z = pk2(acc[4], acc[5]); o0.w = pk2(acc[6], acc[7]);
    o1.x = pk2(acc[8], acc[9]); o1.y = pk2(acc[10], acc[11]); o1.z = pk2(acc[12], acc[13]); o1.w = pk2(acc[14], acc[15]);
    *(u32x4*)dst = o0; *(u32x4*)(dst + 8) = o1;
    BSYNC();
}
__device__ __forceinline__ void rms_rows(const float* X, const float* g, unsigned short* H, int gw, int ngw) {
    const int lane = TID & 63;
    for (int m = gw; m < T; m += ngw) {
        const f32x4* xr = (const f32x4*)(X + (size_t)m * D) + lane; f32x4 v[4]; float s = 0.f;
#pragma unroll
        for (int j = 0; j < 4; ++j) { v[j] = xr[64 * j]; s += (v[j].x * v[j].x + v[j].y * v[j].y) + (v[j].z * v[j].z + v[j].w * v[j].w); }
        const float rstd = 1.0f / sqrtf(wave_sum(s) * (1.f / D) + RMS_EPS);
        u32x2* o8 = (u32x2*)(H + (size_t)m * D) + lane;
#pragma unroll
        for (int j = 0; j < 4; ++j) { const f32x4 gg = ((const f32x4*)g)[lane + 64 * j]; u32x2 w; w.x = pk2(v[j].x * rstd * gg.x, v[j].y * rstd * gg.y); w.y = pk2(v[j].z * rstd * gg.z, v[j].w * rstd * gg.w); o8[64 * j] = w; }
    }
}
__device__ __forceinline__ void p0_prologue(const Params& p, int bid, int nblk, char* smem) {
    float* lds = (float*)smem;
    unsigned char* ws = p.ws;
    unsigned short* WinT = (unsigned short*)(ws + WS_WINT); unsigned short* WoutT = (unsigned short*)(ws + WS_WOUTT); unsigned short* WfT = (unsigned short*)(ws + WS_WFT);
    constexpr int I_IN = 640, I_OUT = 256, I_WF = 256;
    for (int it = bid; it < I_IN + I_OUT + I_WF; it += nblk) {
        int r = it;
        if (r < I_IN) { p0_transpose_tile(p.w_in, D, 2464, WinT, (r / 40) * 64, (r % 40) * 64, 1, lds); continue; } r -= I_IN;
        if (r < I_OUT) { p0_transpose_tile(p.w_out, D, D, WoutT, (r / 16) * 64, (r % 16) * 64, 0, lds); continue; } r -= I_OUT;
        p0_wfused_item(p.peer_wq, p.peer_subkeys, WfT, r / 16, r % 16, lds);
    }
    const size_t gt = (size_t)bid * NTHR + TID, ngt = (size_t)nblk * NTHR;
    float* biasP = (float*)(ws + WS_BIASP);
    for (size_t i = gt; i < (size_t)PCOLS; i += ngt) biasP[i] = (i >= 1536 && i < 2304) ? p.b_attn[i - 1536] : 0.f;
    {
        const int lane = TID & 63; const int gw = bid * (NTHR / 64) + (TID >> 6), ngw = nblk * (NTHR / 64);
        for (int rr = gw; rr < 2 * NEXP; rr += ngw) {
            const int tab = rr >= NEXP, row = rr - tab * NEXP;
            const float* src = (tab ? p.peer_v : p.peer_u) + (size_t)row * D;
            unsigned* dst = (unsigned*)(ws + (tab ? WS_V8 : WS_U8) + (size_t)row * D);
            f32x4 v[4]; float mx = 0.f;
#pragma unroll
            for (int j = 0; j < 4; ++j) { v[j] = ((const f32x4*)src)[lane + 64 * j]; mx = fmaxf(mx, fmaxf(fmaxf(fabsf(v[j].x), fabsf(v[j].y)), fmaxf(fabsf(v[j].z), fabsf(v[j].w)))); }
#pragma unroll
            for (int o = 1; o < 64; o <<= 1) mx = fmaxf(mx, shfl_xor_f(mx, o));
            int ex = 0; if (mx > 0.f) ex = ilogbf(mx);
            const float sc = ldexpf(1.f, 7 - ex), inv = ldexpf(1.f, ex - 7);
#pragma unroll
            for (int j = 0; j < 4; ++j) { unsigned w = 0u; w = cvt_pk_fp8_f32(v[j].x * sc, v[j].y * sc, w, false); w = cvt_pk_fp8_f32(v[j].z * sc, v[j].w * sc, w, true); dst[lane + 64 * j] = w; }
            if (lane == 0) ((float*)(ws + (tab ? WS_VSC : WS_USC)))[row] = inv;
        }
    }
    for (size_t i = gt; i < (size_t)8 * 10 * 2 * 64; i += ngt) {
        const int ln = (int)(i & 63), tc = (int)((i >> 6) & 1), f = (int)((i >> 7) % 10), hd = (int)((i >> 7) / 10);
        const float* src = f < 2 ? p.w_up : (f < 4 ? p.a_up : p.g_up); const int ks = f < 2 ? f : (f < 4 ? f - 2 : f - 4);
        const int cg = hd * 64 + 32 * tc + (ln & 31);
        float v8[8];
#pragma unroll
        for (int j = 0; j < 8; ++j) v8[j] = src[(16 * ks + 8 * (ln >> 5) + j) * 512 + cg];
        u32x4 o; o.x = pk2(v8[0], v8[1]); o.y = pk2(v8[2], v8[3]); o.z = pk2(v8[4], v8[5]); o.w = pk2(v8[6], v8[7]);
        ((u32x4*)(ws + WS_FRG))[i] = o;
    }
    rms_rows(p.x, p.ln1_g, (unsigned short*)(ws + WS_H), bid * (NTHR / 64) + (TID >> 6), nblk * (NTHR / 64));
}

constexpr int MP = 72;
constexpr int SLOTB = 64 * MP * 2;
constexpr int LP = 168;
constexpr int RW_PAR = 0;
constexpr int RW_SB = 4096;
constexpr int RW_AT = RW_SB + SLOTB, RW_RT = RW_AT + SLOTB, RW_BHT = RW_RT + SLOTB, RW_KHT = RW_BHT + SLOTB, RW_VT = RW_KHT + SLOTB, RW_GM = RW_VT + SLOTB;
constexpr int RW_RA = RW_GM + SLOTB;
constexpr int RW_P = RW_RA, RW_PT = RW_P + SLOTB, RW_TM = RW_PT + SLOTB, RW_AAK = RW_TM + SLOTB, RW_ARB = RW_AAK + SLOTB, RW_ARK = RW_ARB + SLOTB;
constexpr int RW_RB = RW_RA + 6 * SLOTB;
constexpr int RW_BH = RW_RB, RW_KH = RW_RB + SLOTB, RW_WT = RW_RB, RW_UT = RW_RB + SLOTB;
constexpr int RW_TOT = RW_RB + 3 * SLOTB;
constexpr int RW_BON = RW_TOT + 2048;
constexpr int RW_GC = RW_BON + 256;
constexpr int RW_END = RW_GC + 256;
static_assert(RW_END <= 155648, "rwkv LDS map");

__device__ __forceinline__ f32x16 zero16() { f32x16 z;
#pragma unroll
    for (int i = 0; i < 16; ++i) z[i] = 0.f; return z; }
__device__ __forceinline__ f32x16 tile_mm(f32x16 acc, const unsigned short* A, const unsigned short* B, int tr, int tc, int lane) {
    const unsigned short* ap = A + (32 * tr + (lane & 31)) * MP + 8 * (lane >> 5);
    const unsigned short* bp = B + (32 * tc + (lane & 31)) * MP + 8 * (lane >> 5);
#pragma unroll
    for (int ks = 0; ks < 4; ++ks) acc = mfma32(*(const bf16x8*)(ap + 16 * ks), *(const bf16x8*)(bp + 16 * ks), acc);
    return acc;
}
__device__ __forceinline__ void store_rm(const f32x16& acc, unsigned short* M, int tr, int tc, int lane) {
    unsigned short* base = M + (32 * tr + 4 * (lane >> 5)) * MP + 32 * tc + (lane & 31);
#pragma unroll
    for (int r = 0; r < 16; ++r) base[((r & 3) + 8 * (r >> 2)) * MP] = (unsigned short)f2bf(acc[r]);
}
__device__ __forceinline__ void store_tr(const f32x16& acc, unsigned short* MT, int tr, int tc, int lane) {
    unsigned short* base = MT + (32 * tc + (lane & 31)) * MP + 32 * tr + 4 * (lane >> 5);
#pragma unroll
    for (int g4 = 0; g4 < 4; ++g4) { u32x2 w; w.x = pk2(acc[4 * g4], acc[4 * g4 + 1]); w.y = pk2(acc[4 * g4 + 2], acc[4 * g4 + 3]); *(u32x2*)(base + 8 * g4) = w; }
}
__device__ __forceinline__ float fexp(float x) { return __expf(x); }

__device__ __forceinline__ void rwkv_unit(const Params& p, int b, int h, char* smem) {
    float* par = (float*)(smem + RW_PAR);
    unsigned short* Sb = (unsigned short*)(smem + RW_SB);
    unsigned short* At = (unsigned short*)(smem + RW_AT); unsigned short* Rt = (unsigned short*)(smem + RW_RT);
    unsigned short* BhT = (unsigned short*)(smem + RW_BHT); unsigned short* KhT = (unsigned short*)(smem + RW_KHT);
    unsigned short* VT = (unsigned short*)(smem + RW_VT); unsigned short* Gm = (unsigned short*)(smem + RW_GM);
    float* lres = (float*)(smem + RW_RA); float* Ol = (float*)(smem + RW_RA);
    unsigned short* Pm = (unsigned short*)(smem + RW_P); unsigned short* PT = (unsigned short*)(smem + RW_PT); unsigned short* Tm = (unsigned short*)(smem + RW_TM);
    unsigned short* Aak = (unsigned short*)(smem + RW_AAK); unsigned short* Arb = (unsigned short*)(smem + RW_ARB); unsigned short* Ark = (unsigned short*)(smem + RW_ARK);
    unsigned short* lora = (unsigned short*)(smem + RW_RB); unsigned short* Bh = (unsigned short*)(smem + RW_BH); unsigned short* Kh = (unsigned short*)(smem + RW_KH);
    unsigned short* WT = (unsigned short*)(smem + RW_WT); unsigned short* UT = (unsigned short*)(smem + RW_UT);
    float* tot = (float*)(smem + RW_TOT); float* bon = (float*)(smem + RW_BON); float* gC = (float*)(smem + RW_GC);
    const unsigned short* P = (const unsigned short*)(p.ws + WS_P);
    unsigned short* Y = (unsigned short*)(p.ws + WS_Y);
    int tid = TID; OPAQUE(tid);
    const int w = tid >> 6; int lane = tid & 63;
    const int ch = tid & 63, tg = w;
    const int q4 = w & 3, qtr = q4 >> 1, qtc = q4 & 1;
    if (tid < 64) {
        const int c = h * 64 + tid;
        par[tid] = p.mu_shift[c]; par[64 + tid] = p.mu_shift[512 + c]; par[128 + tid] = p.mu_shift[1024 + c];
        par[352 + tid] = p.w0[c]; par[416 + tid] = p.a0[c]; par[480 + tid] = p.k_k[c]; par[544 + tid] = p.k_a[c]; par[608 + tid] = p.r_k[c]; par[672 + tid] = p.lnx_w[c]; par[736 + tid] = p.lnx_b[c];
    }
    if (tid < 160) par[192 + tid] = p.mu_shift[1536 + tid];
    for (int i = tid; i < 64 * MP; i += NTHR) Sb[i] = 0;
    const bf16x8* frg = (const bf16x8*)(p.ws + WS_FRG) + ((size_t)(h * 10 + (w < 4 ? 0 : 4)) * 2 + qtc) * 64 + (tid & 63);
    f32x16 sreg = zero16();
    const float mu_r = p.mu_shift[h * 64 + ch], mu_k = p.mu_shift[512 + h * 64 + ch], mu_v = p.mu_shift[1024 + h * 64 + ch];
    const float c_w0 = p.w0[h * 64 + ch], c_a0 = p.a0[h * 64 + ch], c_kk = p.k_k[h * 64 + ch], c_ka = p.k_a[h * 64 + ch], c_rk = p.r_k[h * 64 + ch], c_lw = p.lnx_w[h * 64 + ch], c_lb = p.lnx_b[h * 64 + ch];
    BSYNC();
#pragma unroll 1
    for (int s0 = 0; s0 < SEQ; s0 += 64) {
        const size_t tbase = (size_t)b * SEQ + s0;
        OPAQUE(lane);
        const int hh = lane >> 5, l31 = lane & 31;
        bf16x8 fr[6];
#pragma unroll
        for (int f = 0; f < 6; ++f) fr[f] = frg[128 * (w < 4 ? (f & 3) : f)];
        float rr[9], kr[9], vr[9];
        {
            const int tfirst = s0 + 8 * tg - 1;
#pragma unroll
            for (int i = 0; i < 9; ++i) {
                const int sp = tfirst + i;
                if (sp >= 0) { const unsigned short* row = P + ((size_t)b * SEQ + sp) * PCOLS + h * 64 + ch; rr[i] = bfl(row[PC_R]); kr[i] = bfl(row[PC_K]); vr[i] = bfl(row[PC_V]); }
                else { rr[i] = 0.f; kr[i] = 0.f; vr[i] = 0.f; }
            }
        }
        for (int it = tid; it < 64 * 20; it += NTHR) {
            const int tok = it / 20, c = it - tok * 20;
            const unsigned short* row = P + (tbase + tok) * PCOLS + PC_LORA + 8 * c;
            const u32x4 cu = *(const u32x4*)row;
            u32x4 pv = (u32x4){0u, 0u, 0u, 0u};
            if (s0 + tok > 0) pv = *(const u32x4*)(row - PCOLS);
            float o8[8];
#pragma unroll
            for (int j = 0; j < 4; ++j) {
                const unsigned cw = cu[j], pw = pv[j];
                const float c0 = bf_lo(cw), c1 = bf_hi(cw), p0 = bf_lo(pw), p1 = bf_hi(pw);
                const float m0 = par[192 + 8 * c + 2 * j], m1 = par[192 + 8 * c + 2 * j + 1];
                o8[2 * j] = c0 + m0 * (p0 - c0); o8[2 * j + 1] = c1 + m1 * (p1 - c1);
            }
            if (c < 4) {
#pragma unroll
                for (int j = 0; j < 8; ++j) { const float e2 = fexp(2.f * o8[j]); o8[j] = 1.f - 2.f / (e2 + 1.f); }
            } else if (c >= 8) {
#pragma unroll
                for (int j = 0; j < 8; ++j) o8[j] = 1.f / (1.f + fexp(-o8[j]));
            }
            u32x4 ow; ow.x = pk2(o8[0], o8[1]); ow.y = pk2(o8[2], o8[3]); ow.z = pk2(o8[4], o8[5]); ow.w = pk2(o8[6], o8[7]);
            *(u32x4*)(lora + tok * LP + 8 * c) = ow;
        }
        BSYNC();
        {
            const unsigned short* ap = lora + (32 * qtr + l31) * LP + 8 * hh;
            if (w < 4) {
                f32x16 aw = zero16(), aa = zero16();
#pragma unroll
                for (int ks = 0; ks < 2; ++ks) { aw = mfma32(*(const bf16x8*)(ap + 16 * ks), fr[ks], aw); aa = mfma32(*(const bf16x8*)(ap + 32 + 16 * ks), fr[2 + ks], aa); }
                { float* lb = lres + (32 * qtr + 4 * hh) * 64 + 32 * qtc + l31;
#pragma unroll
                for (int r = 0; r < 16; ++r) { lb[((r & 3) + 8 * (r >> 2)) * 64] = aw[r]; lb[4096 + ((r & 3) + 8 * (r >> 2)) * 64] = aa[r]; } }
            } else {
                f32x16 ag = zero16();
#pragma unroll
                for (int ks = 0; ks < 6; ++ks) ag = mfma32(*(const bf16x8*)(ap + 64 + 16 * ks), fr[ks], ag);
                store_rm(ag, Gm, qtr, qtc, lane);
            }
        }
        BSYNC();
        {
            float lw[8], kkv[8], bb[8], km[8], rs[8], vs[8], csl[8];
            float cs = 0.f;
#pragma unroll
            for (int i = 0; i < 8; ++i) {
                const int t = 8 * tg + i;
                rs[i] = rr[i + 1] + mu_r * (rr[i] - rr[i + 1]);
                const float ksh = kr[i + 1] + mu_k * (kr[i] - kr[i + 1]);
                vs[i] = vr[i + 1] + mu_v * (vr[i] - vr[i + 1]);
                const float z = -(c_w0 + lres[t * 64 + ch]);
                const float sp = fmaxf(z, 0.f) + __logf(1.f + fexp(-fabsf(z)));
                lw[i] = -fexp(-sp - 0.5f);
                const float alpha = 1.f / (1.f + fexp(-(c_a0 + lres[4096 + t * 64 + ch])));
                const float kx = ksh * c_kk;
                const float nrm = sqrtf(wave_sum(kx * kx));
                kkv[i] = kx / fmaxf(nrm, 1e-12f);
                bb[i] = kkv[i] * alpha;
                km[i] = ksh * (1.f + (alpha - 1.f) * c_ka);
                const float bo = wave_sum(rs[i] * km[i] * c_rk);
                if (ch == 0) bon[t] = bo;
                cs += lw[i]; csl[i] = cs;
            }
            tot[tg * 64 + ch] = cs;
            BSYNC();
            float pre = 0.f;
            for (int g = 0; g < tg; ++g) pre += tot[g * 64 + ch];
            u32x4 bt, kt, vt; float tb[8], tk[8];
#pragma unroll
            for (int i = 0; i < 8; ++i) {
                const int t = 8 * tg + i;
                const float c = pre + csl[i];
                const float gt = fexp(c), gp = fexp(c - lw[i]), gi = fexp(-c);
                At[t * MP + ch] = (unsigned short)f2bf(-kkv[i] * gp);
                Rt[t * MP + ch] = (unsigned short)f2bf(rs[i] * gt);
                tb[i] = bb[i] * gi; tk[i] = km[i] * gi;
                Bh[t * MP + ch] = (unsigned short)f2bf(tb[i]);
                Kh[t * MP + ch] = (unsigned short)f2bf(tk[i]);
            }
            bt.x = pk2(tb[0], tb[1]); bt.y = pk2(tb[2], tb[3]); bt.z = pk2(tb[4], tb[5]); bt.w = pk2(tb[6], tb[7]);
            kt.x = pk2(tk[0], tk[1]); kt.y = pk2(tk[2], tk[3]); kt.z = pk2(tk[4], tk[5]); kt.w = pk2(tk[6], tk[7]);
            vt.x = pk2(vs[0], vs[1]); vt.y = pk2(vs[2], vs[3]); vt.z = pk2(vs[4], vs[5]); vt.w = pk2(vs[6], vs[7]);
            *(u32x4*)(BhT + ch * MP + 8 * tg) = bt; *(u32x4*)(KhT + ch * MP + 8 * tg) = kt; *(u32x4*)(VT + ch * MP + 8 * tg) = vt;
            if (tg == 7) gC[ch] = fexp(pre + csl[7]);
        }
        BSYNC();
        f32x16 treg[2];
        treg[0] = zero16(); treg[1] = zero16();
        {
            const int prod = w >> 1, tr = w & 1;
            const unsigned short* Lm = prod < 2 ? At : Rt; const unsigned short* Rm = (prod & 1) ? Kh : Bh;
            unsigned short* dst = prod == 0 ? Pm : (prod == 1 ? Aak : (prod == 2 ? Arb : Ark));
#pragma unroll
            for (int tc = 0; tc < 2; ++tc) {
                f32x16 acc = zero16();
                if (tc <= tr) acc = tile_mm(acc, Lm, Rm, tr, tc, lane);
                { const int dlt = 32 * tc + l31 - 32 * tr - 4 * hh - (prod < 2 ? 0 : 1);
#pragma unroll
                for (int r = 0; r < 16; ++r) acc[r] = (dlt < (r & 3) + 8 * (r >> 2)) ? acc[r] : 0.f; }
                store_rm(acc, dst, tr, tc, lane);
                if (prod == 0) {
                    store_tr(acc, PT, tr, tc, lane);
                    { const int dl2 = 32 * tc + l31 - 32 * tr - 4 * hh;
#pragma unroll
                    for (int r = 0; r < 16; ++r) acc[r] += (dl2 == (r & 3) + 8 * (r >> 2)) ? 1.f : 0.f; }
                    store_rm(acc, Tm, tr, tc, lane);
                    treg[tc] = acc;
                }
            }
        }
        BSYNC();
#pragma unroll 1
        for (int j = 1; j <= 6; ++j) {
            f32x16 pa[2];
            pa[0] = zero16(); pa[1] = zero16();
            const int tr = w & 1;
            if ((w == 2 || w == 3) && j <= 5) {
                pa[0] = tile_mm(pa[0], Pm, PT, tr, 0, lane);
                if (tr == 1) pa[1] = tile_mm(pa[1], Pm, PT, tr, 1, lane);
            }
            if (w < 2 && j >= 2) {
                treg[0] = tile_mm(treg[0], Tm, PT, tr, 0, lane);
                if (tr == 1) treg[1] = tile_mm(treg[1], Tm, PT, tr, 1, lane);
            }
            BSYNC();
            if ((w == 2 || w == 3) && j <= 5) {
                store_rm(pa[0], Pm, tr, 0, lane); store_tr(pa[0], PT, tr, 0, lane);
                if (tr == 1) { store_rm(pa[1], Pm, tr, 1, lane); store_tr(pa[1], PT, tr, 1, lane); }
            }
            if (w < 2 && j >= 2) {
                store_rm(treg[0], Tm, tr, 0, lane);
                if (tr == 1) store_rm(treg[1], Tm, tr, 1, lane);
            }
            BSYNC();
        }
        if (w < 4) { f32x16 acc = zero16(); acc = tile_mm(acc, At, Sb, qtr, qtc, lane); acc = tile_mm(acc, Aak, VT, qtr, qtc, lane); store_tr(acc, WT, qtr, qtc, lane); }
        BSYNC();
        if (w < 4) { f32x16 acc = zero16(); acc = tile_mm(acc, Tm, WT, qtr, qtc, lane); store_tr(acc, UT, qtr, qtc, lane); }
        BSYNC();
        f32x16 oacc = zero16();
        if (w < 4) { oacc = tile_mm(oacc, Rt, Sb, qtr, qtc, lane); oacc = tile_mm(oacc, Arb, UT, qtr, qtc, lane); oacc = tile_mm(oacc, Ark, VT, qtr, qtc, lane); }
        else {
            sreg = tile_mm(sreg, UT, BhT, qtr, qtc, lane); sreg = tile_mm(sreg, VT, KhT, qtr, qtc, lane);
            const float gc = gC[32 * qtc + l31];
#pragma unroll
            for (int r = 0; r < 16; ++r) sreg[r] *= gc;
        }
        BSYNC();
        if (w < 4) {
            { float* ob = Ol + (32 * qtr + 4 * hh) * 64 + 32 * qtc + l31;
#pragma unroll
            for (int r = 0; r < 16; ++r) ob[((r & 3) + 8 * (r >> 2)) * 64] = oacc[r]; }
        } else store_rm(sreg, Sb, qtr, qtc, lane);
        BSYNC();
#pragma unroll
        for (int i = 0; i < 8; ++i) {
            const int t = 8 * tg + i;
            const float o = Ol[t * 64 + ch];
            const float mean = wave_sum(o) * (1.f / 64.f);
            const float dv = o - mean;
            const float var = wave_sum(dv * dv) * (1.f / 64.f);
            float y = dv * (1.0f / sqrtf(var + LNX_EPS)) * c_lw + c_lb;
            y = (y + bon[t] * bfl(VT[ch * MP + t])) * bfl(Gm[t * MP + ch]);
            Y[(tbase + t) * D + h * 64 + ch] = (unsigned short)f2bf(y);
        }
        BSYNC();
    }
}

constexpr int KPITCH = 72, VPITCH = 260;
__device__ __forceinline__ void attn_unit(const Params& p, int b, int n, char* smem) {
    unsigned short* Kl = (unsigned short*)smem;
    unsigned short* Vt = Kl + 2 * 256 * KPITCH;
    float* ssl = (float*)(Vt + 2 * 64 * VPITCH);
    float* rstdl = ssl + 1024;
    float* wsf = rstdl + 128;
    const unsigned short* P = (const unsigned short*)(p.ws + WS_P);
    unsigned short* Y = (unsigned short*)(p.ws + WS_Y);
    const int tid = TID, lane = tid & 63, w = tid >> 6, q = lane & 31, hh = lane >> 5, g = w >> 2;
    const long tb = (long)b * SEQ + (long)(n - 1) * 128;
    for (int i = tid; i < 4096; i += NTHR) {
        const int c = i & 7, kj = (i >> 3) & 255, gg = i >> 11;
        const bool valid = (n > 0) || (kj >= 128);
        u32x4 kv = (u32x4){0u, 0u, 0u, 0u}, vv = (u32x4){0u, 0u, 0u, 0u};
        if (valid) { const unsigned short* row = P + (size_t)(tb + kj) * PCOLS; kv = *(const u32x4*)(row + PC_AK + gg * 64 + c * 8); vv = *(const u32x4*)(row + PC_AV + gg * 64 + c * 8); }
        *(u32x4*)(Kl + (gg * 256 + kj) * KPITCH + c * 8) = kv;
        unsigned short* vd = Vt + (gg * 64 + c * 8) * VPITCH + kj;
        vd[0 * VPITCH] = (unsigned short)(vv.x & 0xffff); vd[1 * VPITCH] = (unsigned short)(vv.x >> 16);
        vd[2 * VPITCH] = (unsigned short)(vv.y & 0xffff); vd[3 * VPITCH] = (unsigned short)(vv.y >> 16);
        vd[4 * VPITCH] = (unsigned short)(vv.z & 0xffff); vd[5 * VPITCH] = (unsigned short)(vv.z >> 16);
        vd[6 * VPITCH] = (unsigned short)(vv.w & 0xffff); vd[7 * VPITCH] = (unsigned short)(vv.w >> 16);
    }
    BSYNC();
    const float sink = p.attn_sinks[w];
    const long tq_blk = (long)b * SEQ + (long)n * 128;
    for (int it = 0; it < 4; ++it) {
        bf16x8 qf[4];
#pragma unroll
        for (int ks = 0; ks < 4; ++ks) qf[ks] = *(const bf16x8*)(P + (size_t)(tq_blk + 32 * it + q) * PCOLS + PC_Q + w * 64 + 16 * ks + 8 * hh);
        f32x16 pb[5];
        float mloc = sink;
        const int iq = 32 * it + q;
#pragma unroll
        for (int bi = 0; bi < 5; ++bi) {
            const int jb = it + bi;
            const bool active = (n > 0) || (jb >= 4);
#pragma unroll
            for (int r = 0; r < 16; ++r) pb[bi][r] = 0.f;
            if (active) {
#pragma unroll
                for (int ks = 0; ks < 4; ++ks) { const bf16x8 kf = *(const bf16x8*)(Kl + (g * 256 + 32 * jb + q) * KPITCH + 16 * ks + 8 * hh); pb[bi] = mfma32(kf, qf[ks], pb[bi]); }
            }
#pragma unroll
            for (int r = 0; r < 16; ++r) {
                const int kj = 32 * jb + crow(r, hh);
                const bool ok = active && (kj >= iq + 1) && (kj <= iq + 128);
                const float s = ok ? pb[bi][r] * 0.125f : -1e30f;
                pb[bi][r] = s; mloc = fmaxf(mloc, s);
            }
        }
        mloc = fmaxf(mloc, shfl_xor_f(mloc, 32));
        float lsum = 0.f;
#pragma unroll
        for (int bi = 0; bi < 5; ++bi)
#pragma unroll
            for (int r = 0; r < 16; ++r) { const float e = expf(pb[bi][r] - mloc); pb[bi][r] = e; lsum += e; }
        lsum += shfl_xor_f(lsum, 32);
        lsum += expf(sink - mloc);
        f32x16 o[2];
#pragma unroll
        for (int r = 0; r < 16; ++r) { o[0][r] = 0.f; o[1][r] = 0.f; }
#pragma unroll
        for (int bi = 0; bi < 5; ++bi) {
            const int jb = it + bi;
            const bool active = (n > 0) || (jb >= 4);
            if (active) {
#pragma unroll
                for (int s2 = 0; s2 < 2; ++s2) {
                    bf16x8 pa;
#pragma unroll
                    for (int j = 0; j < 8; ++j) pa[j] = (short)f2bf(pb[bi][8 * s2 + j]);
#pragma unroll
                    for (int dt = 0; dt < 2; ++dt) {
                        const unsigned short* vp = Vt + (g * 64 + 32 * dt + q) * VPITCH + 32 * jb + 16 * s2 + 4 * hh;
                        const bf16x4 lo = *(const bf16x4*)vp, hi = *(const bf16x4*)(vp + 8);
                        const bf16x8 vf = (bf16x8){lo[0], lo[1], lo[2], lo[3], hi[0], hi[1], hi[2], hi[3]};
                        o[dt] = mfma32(pa, vf, o[dt]);
                    }
                }
            }
        }
        if (hh == 0) wsf[w * 32 + q] = 1.f / lsum;
        WSYNC();
        float ss[16];
#pragma unroll
        for (int r = 0; r < 16; ++r) { const float il = wsf[w * 32 + crow(r, hh)]; o[0][r] *= il; o[1][r] *= il; ss[r] = o[0][r] * o[0][r] + o[1][r] * o[1][r]; }
        WSYNC();
#pragma unroll
        for (int r = 0; r < 16; ++r) {
            float s = ss[r];
            s += shfl_xor_f(s, 1); s += shfl_xor_f(s, 2); s += shfl_xor_f(s, 4); s += shfl_xor_f(s, 8); s += shfl_xor_f(s, 16);
            if (q == 0) ssl[(32 * it + crow(r, hh)) * 8 + w] = s;
            const size_t trow = (size_t)(tq_blk + 32 * it + crow(r, hh));
            Y[trow * D + 512 + w * 64 + q] = (unsigned short)f2bf(o[0][r]);
            Y[trow * D + 512 + w * 64 + 32 + q] = (unsigned short)f2bf(o[1][r]);
        }
    }
    BSYNC();
    if (tid < 128) { float s = 0.f;
#pragma unroll
        for (int j = 0; j < 8; ++j) s += ssl[tid * 8 + j];
        rstdl[tid] = 1.0f / sqrtf(s * (1.f / 512.f) + RMS_EPS); }
    BSYNC();
    const float g0 = p.attn_norm_g[w * 64 + q], g1 = p.attn_norm_g[w * 64 + 32 + q];
    for (int it = 0; it < 4; ++it)
#pragma unroll
        for (int r = 0; r < 16; ++r) {
            const int qi = 32 * it + crow(r, hh); const float rs = rstdl[qi];
            unsigned short* yp = Y + (size_t)(tq_blk + qi) * D + 512 + w * 64 + q;
            yp[0] = (unsigned short)f2bf(bfl(yp[0]) * rs * g0); yp[32] = (unsigned short)f2bf(bfl(yp[32]) * rs * g1);
        }
    BSYNC();
}

__device__ __forceinline__ void ins16(float (&l)[16], float x) {
#pragma unroll
    for (int i = 0; i < 16; ++i) { const float t = fmaxf(l[i], x); x = fminf(l[i], x); l[i] = t; }
}
__device__ __forceinline__ void topk_half(float* S, float* lists, int trow0, int hd, int* IDX, float* GATE) {
    const int tid = TID, row = tid & 127, grp = (tid >> 7) & 1, half = tid >> 8;
    float l[16];
#pragma unroll
    for (int i = 0; i < 16; ++i) l[i] = -3.0e38f;
    const float* src = S + row * 260 + grp * 128 + half * 64;
    for (int c = 0; c < 64; c += 4) {
        const f32x4 v = *(const f32x4*)(src + c);
#pragma unroll
        for (int i = 0; i < 4; ++i) { const unsigned nidx = (unsigned)(half * 64 + c + i); const float sv = v[i]; const float key = __builtin_bit_cast(float, (__builtin_bit_cast(unsigned, sv) & ~127u) | (127u - nidx)); ins16(l, key); }
    }
    float* slot = lists + (row * 2 + grp) * 16;
    if (half == 1) {
#pragma unroll
        for (int i = 0; i < 16; ++i) slot[i] = l[i];
    }
    BSYNC();
    if (half == 0) {
#pragma unroll
        for (int i = 0; i < 16; ++i) ins16(l, slot[i]);
        if (grp == 1) {
#pragma unroll
            for (int i = 0; i < 16; ++i) slot[i] = l[i];
        }
    }
    BSYNC();
    if (tid < 128) {
        const float* bl = lists + (row * 2 + 1) * 16;
        float bs[16];
#pragma unroll
        for (int i = 0; i < 16; ++i) bs[i] = bl[i];
        float c16[16];
#pragma unroll
        for (int i = 0; i < 16; ++i) c16[i] = -3.0e38f;
#pragma unroll
        for (int i = 0; i < 16; ++i) {
            const int jmax = 16 / (i + 1);
            const float ai = __builtin_bit_cast(float, __builtin_bit_cast(unsigned, l[i]) & ~127u);
#pragma unroll
            for (int j = 0; j < 16; ++j) if (j < jmax) {
                const float bj = __builtin_bit_cast(float, __builtin_bit_cast(unsigned, bs[j]) & ~127u);
                const float sm = ai + bj;
                ins16(c16, __builtin_bit_cast(float, (__builtin_bit_cast(unsigned, sm) & ~255u) | (unsigned)(i * 16 + j)));
            }
        }
        float ev[16]; float den = 0.f;
        const float mx = __builtin_bit_cast(float, __builtin_bit_cast(unsigned, c16[0]) & ~255u);
#pragma unroll
        for (int k = 0; k < 16; ++k) { const float sv = __builtin_bit_cast(float, __builtin_bit_cast(unsigned, c16[k]) & ~255u); ev[k] = expf(sv - mx); den += ev[k]; }
        const float inv = 1.f / den;
        int* ip = IDX + (size_t)(trow0 + row) * 128 + hd * 16; float* gp = GATE + (size_t)(trow0 + row) * 128 + hd * 16;
#pragma unroll
        for (int k = 0; k < 16; ++k) {
            const unsigned code = __builtin_bit_cast(unsigned, c16[k]) & 255u; const int ci = (int)(code >> 4), cj = (int)(code & 15u);
            unsigned abits = 0u, bbits = 0u;
#pragma unroll
            for (int i = 0; i < 16; ++i) { abits = (ci == i) ? __builtin_bit_cast(unsigned, l[i]) : abits; bbits = (cj == i) ? __builtin_bit_cast(unsigned, bs[i]) : bbits; }
            const int ia = 127 - (int)(abits & 127u), ib = 127 - (int)(bbits & 127u);
            ip[k] = ia * 128 + ib; gp[k] = ev[k] * inv;
        }
    }
    BSYNC();
}

__device__ __forceinline__ float gelu_erf(float v) { return 0.5f * v * (1.f + erff(v * 0.70710678118654752f)); }
__device__ __forceinline__ void cvt16_fp8(const u32x4 w, float (&f)[16]) {
#pragma unroll
    for (int q = 0; q < 4; ++q) { const unsigned ww = w[q]; const f32x2 a = cvt_pk_f32_fp8(ww, false), b = cvt_pk_f32_fp8(ww, true); f[4 * q] = a.x; f[4 * q + 1] = a.y; f[4 * q + 2] = b.x; f[4 * q + 3] = b.y; }
}
__device__ __forceinline__ float reduce4(const float (&d)[4], int lane) {
    const bool b5 = (lane & 32) != 0, b4 = (lane & 16) != 0;
    float r[2];
#pragma unroll
    for (int i = 0; i < 2; ++i) { const float x = b5 ? d[2 + i] : d[i], y = b5 ? d[i] : d[2 + i]; r[i] = x + shfl_xor_f(y, 32); }
    float t = (b4 ? r[1] : r[0]) + shfl_xor_f(b4 ? r[0] : r[1], 16);
    t += shfl_xor_f(t, 8); t += shfl_xor_f(t, 4); t += shfl_xor_f(t, 2); t += shfl_xor_f(t, 1);
    return t;
}
__device__ __forceinline__ void peer_phase(const Params& p, int gw, int ngw, float* OUT) {
    const int lane = TID & 63;
    const unsigned short* H = (const unsigned short*)(p.ws + WS_H);
    const unsigned char* U8 = p.ws + WS_U8; const unsigned char* V8 = p.ws + WS_V8;
    const float* USC = (const float*)(p.ws + WS_USC); const float* VSC = (const float*)(p.ws + WS_VSC);
    const int* IDX = (const int*)(p.ws + WS_IDX); const float* GATE = (const float*)(p.ws + WS_GATE);
    float* X1 = p.out;
#define PEER_LOAD(UA, VA, bb) do { _Pragma("unroll") for (int u = 0; u < 4; ++u) { const int k = 4 * (bb) + u; const int e = rdlane_i(k < 64 ? myi0 : myi1, k & 63); \
        UA[u] = *(const u32x4*)(U8 + (size_t)e * D + 16 * lane); VA[u] = *(const u32x4*)(V8 + (size_t)e * D + 16 * lane); } } while (0)
#define PEER_COMPUTE(UA, VA, bb) do { float dd[4]; \
        _Pragma("unroll") for (int u = 0; u < 4; ++u) { float uf[16]; cvt16_fp8(UA[u], uf); float d = 0.f; _Pragma("unroll") for (int i = 0; i < 16; ++i) d += hf[i] * uf[i]; dd[u] = d; } \
        const float dsum = reduce4(dd, lane); const int kk = 4 * (bb) + (lane >> 4); \
        const float usc = shfl_f(kk < 64 ? myu0 : myu1, kk & 63), cf = shfl_f(kk < 64 ? myc0 : myc1, kk & 63); \
        const float av = gelu_erf(dsum * usc) * cf; \
        _Pragma("unroll") for (int u = 0; u < 4; ++u) { const float au = rdlane_f(av, 16 * u); float vf[16]; cvt16_fp8(VA[u], vf); _Pragma("unroll") for (int i = 0; i < 16; ++i) acc[i] += au * vf[i]; } } while (0)
    for (int t = gw; t < T; t += ngw) {
        const u32x4 hv0 = *(const u32x4*)(H + (size_t)t * D + 16 * lane), hv1 = *(const u32x4*)(H + (size_t)t * D + 16 * lane + 8);
        float hf[16];
        hf[0] = bf_lo(hv0.x); hf[1] = bf_hi(hv0.x); hf[2] = bf_lo(hv0.y); hf[3] = bf_hi(hv0.y); hf[4] = bf_lo(hv0.z); hf[5] = bf_hi(hv0.z); hf[6] = bf_lo(hv0.w); hf[7] = bf_hi(hv0.w);
        hf[8] = bf_lo(hv1.x); hf[9] = bf_hi(hv1.x); hf[10] = bf_lo(hv1.y); hf[11] = bf_hi(hv1.y); hf[12] = bf_lo(hv1.z); hf[13] = bf_hi(hv1.z); hf[14] = bf_lo(hv1.w); hf[15] = bf_hi(hv1.w);
        const int myi0 = IDX[(size_t)t * 128 + lane], myi1 = IDX[(size_t)t * 128 + 64 + lane];
        const float myu0 = USC[myi0], myu1 = USC[myi1];
        const float myc0 = GATE[(size_t)t * 128 + lane] * VSC[myi0], myc1 = GATE[(size_t)t * 128 + 64 + lane] * VSC[myi1];
        float acc[16];
#pragma unroll
        for (int i = 0; i < 16; ++i) acc[i] = 0.f;
        u32x4 ua[4], va[4], ub[4], vb[4];
        PEER_LOAD(ua, va, 0);
#pragma unroll 1
        for (int b = 0; b < 32; b += 2) {
            PEER_LOAD(ub, vb, b + 1);
            PEER_COMPUTE(ua, va, b);
            if (b + 2 < 32) PEER_LOAD(ua, va, b + 2);
            PEER_COMPUTE(ub, vb, b + 1);
        }
        float* xr = X1 + (size_t)t * D + 16 * lane;
        float ssq = 0.f; f32x4 xv[4];
#pragma unroll
        for (int j = 0; j < 4; ++j) { xv[j] = *(const f32x4*)(xr + 4 * j);
#pragma unroll
            for (int i = 0; i < 4; ++i) { xv[j][i] += acc[4 * j + i]; ssq += xv[j][i] * xv[j][i]; } }
        const float rstd = 1.0f / sqrtf(wave_sum(ssq) * (1.f / D) + RMS_EPS);
#pragma unroll
        for (int j = 0; j < 4; ++j) { const f32x4 gg = *(const f32x4*)(p.lnf_g + 16 * lane + 4 * j); f32x4 o;
#pragma unroll
            for (int i = 0; i < 4; ++i) o[i] = xv[j][i] * rstd * gg[i];
            *(f32x4*)(OUT + (size_t)t * D + 16 * lane + 4 * j) = o; }
    }
#undef PEER_LOAD
#undef PEER_COMPUTE
}

#ifndef EMU
namespace pg8 {
#define PG8_LAS __attribute__((address_space(3)))
typedef unsigned short bf16_t;
typedef short bf16x8 __attribute__((ext_vector_type(8)));
typedef float f32x4 __attribute__((ext_vector_type(4)));
typedef unsigned u32x4 __attribute__((ext_vector_type(4)));
constexpr int BM = 256, BK = 64, HALF = 128, HTB = HALF * BK * 2  , STAGE_BYTES = 8 * HTB, NXCD = 8, WGM = 8;

__host__ __device__ __forceinline__ int lds_byte(int r, int c) { const int st = (r >> 4) * 2 + (c >> 5), rr = r & 15, cc = c & 31, ob = rr * 64 + cc * 2; return st * 1024 + (ob ^ (((ob >> 9) & 1) << 5)); }
__host__ __device__ __forceinline__ void stage_rc(int b, int& R, int& C) { const int st = b / 1024, sb = b % 1024, swz = sb ^ (((sb >> 9) & 1) << 5); R = (st >> 1) * 16 + swz / 64; C = (st & 1) * 32 + (swz % 64) / 2; }
__host__ __device__ __forceinline__ int perm32(int rho) { const int n = rho >> 4, i = rho & 15; return 8 * (i >> 2) + 4 * n + (i & 3); }

struct Unit { int pm, pn; };
struct Gemm { const bf16_t* A; const bf16_t* Bt; int M, N, K; };

struct StaticOrder {
    int nM, nN, nwg, G, c;
    __host__ __device__ void init(int M, int N, int G_, int c_) { nM = M / BM; nN = N / BM; nwg = nM * nN; G = G_; c = c_; }
    __host__ __device__ bool next(int i, Unit& u) const {
        const long L = (long)i * G + c; if (L >= nwg) return false;
        int wgid = (int)L; { const int q = nwg / NXCD, r = nwg % NXCD, xcd = wgid % NXCD, off = wgid / NXCD; wgid = (xcd < r ? xcd * (q + 1) : r * (q + 1) + (xcd - r) * q) + off; }
        const int nig = WGM * nN, gid = wgid / nig, fm = gid * WGM, gsz = (nM - fm) < WGM ? (nM - fm) : WGM;
        u.pm = fm + ((wgid % nig) % gsz); u.pn = (wgid % nig) / gsz; return true;
    }
    __device__ __forceinline__ void a_ready(const Unit&) const {}
    __device__ __forceinline__ void done(const Unit&) const {}
};

__device__ __forceinline__ unsigned cvt_pk_bf16(float lo, float hi) { unsigned r; asm volatile("v_cvt_pk_bf16_f32 %0, %1, %2" : "=v"(r) : "v"(lo), "v"(hi)); return r; }
typedef float f32x2 __attribute__((ext_vector_type(2)));
__device__ __forceinline__ f32x2 gelu_pk(f32x2 v) {
    const f32x2 av = __builtin_elementwise_abs(v), d = av * 0.2316418882f + 1.0f;
    f32x2 t; t.x = __builtin_amdgcn_rcpf(d.x); t.y = __builtin_amdgcn_rcpf(d.y);
    f32x2 q = t * 0.5307027145f + (-0.7265760135f); q = q * t + 0.7107068705f; q = q * t + (-0.142248368f); q = q * t + 0.127414796f; q = q * t;
    const f32x2 s = (v * v) * (-0.72134752044f);
    f32x2 e; e.x = __builtin_amdgcn_exp2f(s.x); e.y = __builtin_amdgcn_exp2f(s.y);
    const f32x2 m = v * (q * e), r = v - m;
    f32x2 o; o.x = v.x < 0.f ? m.x : r.x; o.y = v.y < 0.f ? m.y : r.y; return o;
}

template <int ACT  > struct EpiBf16 {
    static constexpr bool PERM = true, AFTER_DRAIN = false; static_assert(ACT == 0 || ACT == 1, "EpiBf16: ACT is 0 (none) or 1 (gelu_pk)");
    bf16_t* O; int ldc; const float* bias; int split_cols; size_t split_stride; float scale0;
    __device__ __forceinline__ void operator()(const f32x4 (&acc)[2][2][4][2], const Unit& u, int wr, int wc, int fr, int fq) const {
        const int row0 = u.pm * BM + wr * 64 + fr; int colt = u.pn * BM; bf16_t* base = O;
        float sc = 1.f; if (split_cols) { const int t = colt / split_cols; base += (size_t)t * split_stride; colt -= t * split_cols; if (t == 0) sc = scale0; }
        const int col0 = colt + wc * 32 + 8 * fq, bcol0 = u.pn * BM + wc * 32 + 8 * fq;
        f32x4 bv[2][2];
#pragma unroll
        for (int bj = 0; bj < 2; ++bj)
#pragma unroll
            for (int n = 0; n < 2; ++n) bv[bj][n] = bias ? *(const f32x4*)(bias + bcol0 + bj * HALF + 4 * n) : (f32x4){0.f, 0.f, 0.f, 0.f};
#pragma unroll
        for (int ai = 0; ai < 2; ++ai)
#pragma unroll
            for (int m = 0; m < 4; ++m) { bf16_t* rowp = base + (size_t)(row0 + ai * HALF + m * 16) * ldc + col0;
#pragma unroll
                for (int bj = 0; bj < 2; ++bj) { f32x4 v0 = acc[ai][bj][m][0] + bv[bj][0], v1 = acc[ai][bj][m][1] + bv[bj][1];
                    if (ACT == 1) { f32x2 a = gelu_pk((f32x2){v0[0], v0[1]}), b = gelu_pk((f32x2){v0[2], v0[3]}), c = gelu_pk((f32x2){v1[0], v1[1]}), d = gelu_pk((f32x2){v1[2], v1[3]});
                        v0 = (f32x4){a.x, a.y, b.x, b.y}; v1 = (f32x4){c.x, c.y, d.x, d.y}; }
                    v0 = v0 * sc; v1 = v1 * sc; u32x4 w; w.x = cvt_pk_bf16(v0[0], v0[1]); w.y = cvt_pk_bf16(v0[2], v0[3]); w.z = cvt_pk_bf16(v1[0], v1[1]); w.w = cvt_pk_bf16(v1[2], v1[3]);
                    *(u32x4*)(rowp + bj * HALF) = w; } }
    }
};
template <class Epi, class Sched, bool ALIGN_EPI = false, bool SP2 = false>
__device__ __forceinline__ void gemm_phase(PG8_LAS unsigned char* lds, const Gemm g, const Sched& S, const Epi& E) {
    int tid = threadIdx.x; asm volatile("" : "+v"(tid));
    const int wid = __builtin_amdgcn_readfirstlane(tid >> 6), lane = tid & 63, wr = wid >> 2, wc = wid & 3, fr = lane & 15, fq = lane >> 4;
    const int K = g.K, nt = K / BK;
    unsigned voffA[2], voffB[2];
#pragma unroll
    for (int i = 0; i < 2; ++i) { int R, C; stage_rc(tid * 16 + i * 8192, R, C); const int Rb = Epi::PERM ? ((R & ~31) + perm32(R & 31)) : R;
        voffA[i] = (unsigned)(R * K + C) * 2u; voffB[i] = (unsigned)(Rb * K + C) * 2u; }
    const size_t kstep = (size_t)(BK * 2);
    const size_t hstep = (size_t)HALF * K * 2;
    const size_t tstep = 2 * hstep;
    const unsigned ldsw = (unsigned)wid * 1024u;
    const int aoff = lds_byte(wr * 64 + fr, fq * 8), boff = lds_byte(wc * 32 + fr, fq * 8);
#define PG8_SA(b, h) (((b) * 2 + (h)) * HTB)
#define PG8_SB(b, h) ((4 + (b) * 2 + (h)) * HTB)
#define PG8_STAGE(bufoff, gbase, voff) do { _Pragma("unroll") for (int _i = 0; _i < 2; ++_i) \
        __builtin_amdgcn_global_load_lds((const unsigned*)((const char*)(gbase) + (voff)[_i]), (PG8_LAS unsigned*)(lds + (bufoff) + ldsw + _i * 8192), 16, 0, 0); } while (0)
#define PG8_LDA(dst, b, h) do { _Pragma("unroll") for (int m = 0; m < 4; ++m) _Pragma("unroll") for (int k = 0; k < 2; ++k) dst[m][k] = *(const PG8_LAS bf16x8*)(lds + PG8_SA(b, h) + aoff + m * 2048 + k * 1024); } while (0)
#define PG8_LDB(dst, b, h) do { _Pragma("unroll") for (int n = 0; n < 2; ++n) _Pragma("unroll") for (int k = 0; k < 2; ++k) dst[n][k] = *(const PG8_LAS bf16x8*)(lds + PG8_SB(b, h) + boff + n * 2048 + k * 1024); } while (0)
#define PG8_MMA(ai, bj, At, Bt) do { __builtin_amdgcn_s_setprio(1); _Pragma("unroll") for (int m = 0; m < 4; ++m) _Pragma("unroll") for (int n = 0; n < 2; ++n) _Pragma("unroll") for (int k = 0; k < 2; ++k) \
        acc[ai][bj][m][n] = __builtin_amdgcn_mfma_f32_16x16x32_bf16(Bt[n][k], At[m][k], acc[ai][bj][m][n], 0, 0, 0); __builtin_amdgcn_s_setprio(0); } while (0)
#define PG8_WAIT_V(n) asm volatile("s_waitcnt vmcnt(" #n ")" ::: "memory")
#define PG8_WAIT_L(n) asm volatile("s_waitcnt lgkmcnt(" #n ")" ::: "memory")
#define PG8_BAR __builtin_amdgcn_s_barrier()
#define PG8_SCHED __builtin_amdgcn_sched_barrier(0)
    Unit cur, nxt; int ui = 0;
    if (!S.next(0, cur)) return;
    f32x4 acc[2][2][4][2];
#pragma unroll
    for (int a = 0; a < 2; ++a)
#pragma unroll
        for (int b = 0; b < 2; ++b)
#pragma unroll
            for (int m = 0; m < 4; ++m)
#pragma unroll
                for (int n = 0; n < 2; ++n) acc[a][b][m][n] = (f32x4){0.f, 0.f, 0.f, 0.f};
    bf16x8 At[4][2], B0[2][2], B1[2][2];
    const char* cA = (const char*)g.A + (size_t)cur.pm * tstep; const char* cB = (const char*)g.Bt + (size_t)cur.pn * tstep;
    S.a_ready(cur);
    if constexpr (SP2) {
        PG8_STAGE(PG8_SB(0, 0), cB, voffB); PG8_STAGE(PG8_SB(0, 1), cB + hstep, voffB); PG8_STAGE(PG8_SA(0, 0), cA, voffA); PG8_STAGE(PG8_SA(0, 1), cA + hstep, voffA);
        if (wr == 1) PG8_BAR;
        PG8_WAIT_V(2); PG8_BAR;
        PG8_STAGE(PG8_SB(1, 0), cB + kstep, voffB); PG8_STAGE(PG8_SA(1, 0), cA + kstep, voffA); PG8_STAGE(PG8_SB(1, 1), cB + hstep + kstep, voffB);
        PG8_WAIT_V(6); PG8_BAR;
    } else {
        PG8_STAGE(PG8_SB(0, 0), cB, voffB); PG8_STAGE(PG8_SA(0, 0), cA, voffA); PG8_STAGE(PG8_SB(0, 1), cB + hstep, voffB); PG8_STAGE(PG8_SA(0, 1), cA + hstep, voffA);
        if (wr == 1) PG8_BAR;
        PG8_WAIT_V(4); PG8_BAR;
        PG8_STAGE(PG8_SB(1, 0), cB + kstep, voffB); PG8_STAGE(PG8_SA(1, 0), cA + kstep, voffA); PG8_STAGE(PG8_SB(1, 1), cB + hstep + kstep, voffB);
        PG8_WAIT_V(6); PG8_BAR;
    }
    for (;;) {
        const bool has_next = S.next(ui + 1, nxt);
        const char* nA = has_next ? (const char*)g.A + (size_t)nxt.pm * tstep : cA; const char* nB = has_next ? (const char*)g.Bt + (size_t)nxt.pn * tstep : cB;
        for (int t = 0; t < nt; t += 2) {
            const bool last = (t == nt - 2);
            const char* a1 = cA + (size_t)(t + 1) * kstep;
            const char* a2 = last ? nA : cA + (size_t)(t + 2) * kstep; const char* b2 = last ? nB : cB + (size_t)(t + 2) * kstep;
            const char* a3 = a2 + kstep; const char* b3 = b2 + kstep;
            if (last && has_next) S.a_ready(nxt);
            if constexpr (SP2) {
            PG8_LDB(B0, 0, 0); PG8_LDB(B1, 0, 1); PG8_SCHED; PG8_LDA(At, 0, 0); PG8_STAGE(PG8_SA(1, 1), a1 + hstep, voffA);
            PG8_WAIT_V(8); PG8_WAIT_L(0); PG8_BAR; PG8_MMA(0, 0, At, B0); PG8_MMA(0, 1, At, B1); PG8_BAR; PG8_SCHED;
            PG8_LDA(At, 0, 1); PG8_STAGE(PG8_SB(0, 0), b2, voffB); PG8_STAGE(PG8_SB(0, 1), b2 + hstep, voffB); PG8_STAGE(PG8_SA(0, 0), a2, voffA);
            PG8_WAIT_V(8); PG8_WAIT_L(0); PG8_BAR; PG8_MMA(1, 0, At, B0); PG8_MMA(1, 1, At, B1); PG8_BAR; PG8_SCHED;
            PG8_LDB(B0, 1, 0); PG8_LDB(B1, 1, 1); PG8_SCHED; PG8_LDA(At, 1, 0); PG8_STAGE(PG8_SA(0, 1), a2 + hstep, voffA);
            PG8_WAIT_V(8); PG8_WAIT_L(0); PG8_BAR; PG8_MMA(0, 0, At, B0); PG8_MMA(0, 1, At, B1); PG8_BAR; PG8_SCHED;
            PG8_LDA(At, 1, 1); PG8_STAGE(PG8_SB(1, 0), b3, voffB); PG8_STAGE(PG8_SB(1, 1), b3 + hstep, voffB); PG8_STAGE(PG8_SA(1, 0), a3, voffA);
            PG8_WAIT_V(8); PG8_WAIT_L(0); PG8_BAR; PG8_MMA(1, 0, At, B0); PG8_MMA(1, 1, At, B1); PG8_BAR; PG8_SCHED;
            } else {
            PG8_LDB(B0, 0, 0); PG8_SCHED; PG8_LDA(At, 0, 0); PG8_STAGE(PG8_SA(1, 1), a1 + hstep, voffA);
            PG8_WAIT_L(8); PG8_BAR; PG8_WAIT_L(0); PG8_MMA(0, 0, At, B0); PG8_BAR; PG8_SCHED;
            PG8_LDB(B1, 0, 1); PG8_STAGE(PG8_SB(0, 0), b2, voffB);
            PG8_BAR; PG8_WAIT_L(0); PG8_MMA(0, 1, At, B1); PG8_BAR;
            PG8_LDA(At, 0, 1); PG8_STAGE(PG8_SA(0, 0), a2, voffA);
            PG8_BAR; PG8_WAIT_L(0); PG8_MMA(1, 0, At, B0); PG8_BAR; PG8_SCHED;
            PG8_STAGE(PG8_SB(0, 1), b2 + hstep, voffB);
            PG8_WAIT_V(6); PG8_BAR; PG8_MMA(1, 1, At, B1); PG8_BAR;
            PG8_LDB(B0, 1, 0); PG8_SCHED; PG8_LDA(At, 1, 0); PG8_STAGE(PG8_SA(0, 1), a2 + hstep, voffA);
            PG8_WAIT_L(8); PG8_BAR; PG8_WAIT_L(0); PG8_MMA(0, 0, At, B0); PG8_BAR; PG8_SCHED;
            PG8_LDB(B1, 1, 1); PG8_STAGE(PG8_SB(1, 0), b3, voffB);
            PG8_BAR; PG8_WAIT_L(0); PG8_MMA(0, 1, At, B1); PG8_BAR;
            PG8_LDA(At, 1, 1); PG8_STAGE(PG8_SA(1, 0), a3, voffA);
            PG8_BAR; PG8_WAIT_L(0); PG8_MMA(1, 0, At, B0); PG8_BAR; PG8_SCHED;
            PG8_STAGE(PG8_SB(1, 1), b3 + hstep, voffB);
            PG8_WAIT_V(6); PG8_BAR; PG8_MMA(1, 1, At, B1); PG8_BAR;
            }
        }
        if constexpr (ALIGN_EPI) { if (wr == 0) PG8_BAR; }
        if constexpr (!Epi::AFTER_DRAIN) { E(acc, cur, wr, wc, fr, fq); S.done(cur); }
        if (!has_next) break;
#pragma unroll
        for (int a = 0; a < 2; ++a)
#pragma unroll
            for (int b = 0; b < 2; ++b)
#pragma unroll
                for (int m = 0; m < 4; ++m)
#pragma unroll
                    for (int n = 0; n < 2; ++n) acc[a][b][m][n] = (f32x4){0.f, 0.f, 0.f, 0.f};
        cur = nxt; cA = nA; cB = nB; ++ui;
        if constexpr (ALIGN_EPI) { if (wr == 1) PG8_BAR; }
    }
    PG8_WAIT_V(0);
    if constexpr (!ALIGN_EPI) { if (wr == 0) PG8_BAR; }
    PG8_BAR;
    if constexpr (Epi::AFTER_DRAIN) { E.fused(acc, cur, wr, wc, fr, fq, lds, wid, lane); S.done(cur); }
#undef PG8_SA
#undef PG8_SB
#undef PG8_STAGE
#undef PG8_LDA
#undef PG8_LDB
#undef PG8_MMA
#undef PG8_WAIT_V
#undef PG8_WAIT_L
#undef PG8_BAR
#undef PG8_SCHED
}
}

struct OneUnit {
    pg8::Unit u;
    __device__ __forceinline__ bool next(int i, pg8::Unit& o) const { if (i) return false; o = u; return true; }
    __device__ __forceinline__ void a_ready(const pg8::Unit&) const {}
    __device__ __forceinline__ void done(const pg8::Unit&) const {}
};
struct EpiResF32 {
    static constexpr bool PERM = false, AFTER_DRAIN = false;
    const float* base; float* out;
    __device__ __forceinline__ void operator()(const pg8::f32x4 (&acc)[2][2][4][2], const pg8::Unit& u, int wr, int wc, int fr, int fq) const {
#pragma unroll
        for (int ai = 0; ai < 2; ++ai)
#pragma unroll
            for (int m = 0; m < 4; ++m) {
                const size_t row = (size_t)u.pm * 256 + ai * 128 + wr * 64 + m * 16 + fr;
#pragma unroll
                for (int bj = 0; bj < 2; ++bj)
#pragma unroll
                    for (int n = 0; n < 2; ++n) {
                        const size_t off = row * D + u.pn * 256 + bj * 128 + wc * 32 + n * 16 + 4 * fq;
                        const pg8::f32x4 b = *(const pg8::f32x4*)(base + off);
                        *(pg8::f32x4*)(out + off) = b + acc[ai][bj][m][n];
                    }
            }
    }
};
struct EpiTopK {
    static constexpr bool PERM = false, AFTER_DRAIN = true;
    int* IDX; float* GATE;
    __device__ __forceinline__ void fused(pg8::f32x4 (&acc)[2][2][4][2], const pg8::Unit& u, int wr, int wc, int fr, int fq, PG8_LAS unsigned char* lds, int wid, int lane) const {
        float* S = (float*)lds; float* lists = S + 128 * 260;
#pragma unroll
        for (int ai = 0; ai < 2; ++ai) {
#pragma unroll
            for (int bj = 0; bj < 2; ++bj)
#pragma unroll
                for (int m = 0; m < 4; ++m)
#pragma unroll
                    for (int n = 0; n < 2; ++n) *(pg8::f32x4*)(S + (wr * 64 + m * 16 + fr) * 260 + bj * 128 + wc * 32 + n * 16 + 4 * fq) = acc[ai][bj][m][n];
            __syncthreads();
            topk_half(S, lists, u.pm * 256 + ai * 128, u.pn, IDX, GATE);
        }
    }
};

#ifndef PHM
#define PHM 255
#endif
#ifndef DUP
#define DUP 0
#endif
constexpr int LDS_BYTES = 155648;
__global__ void __launch_bounds__(NTHR, 2) fwd_kernel(Params p) {
    extern __shared__ __attribute__((aligned(16))) unsigned char lds[];
    cg::grid_group grid = cg::this_grid();
    const int bid = blockIdx.x, nblk = gridDim.x;
    unsigned char* ws = p.ws;
#if PHM & 1
    p0_prologue(p, bid, nblk, (char*)lds);
#endif
    grid.sync();
#if PHM & 2
    {
        pg8::Gemm g{(const pg8::bf16_t*)(ws + WS_H), (const pg8::bf16_t*)(ws + WS_WINT), T, PCOLS, D};
        pg8::StaticOrder S; S.init(T, PCOLS, nblk, bid);
        pg8::EpiBf16<0> E{(pg8::bf16_t*)(ws + WS_P), PCOLS, (const float*)(ws + WS_BIASP), 0, 0, 1.f};
        pg8::gemm_phase<pg8::EpiBf16<0>, pg8::StaticOrder, true, true>((PG8_LAS unsigned char*)lds, g, S, E);
    }
#endif
    grid.sync();
#if PHM & 4
#if DUP & 4
    for (int u = bid; u < BATCH * 8; u += nblk) rwkv_unit(p, u >> 3, u & 7, (char*)lds);
#endif
    for (int u = bid; u < BATCH * 8; u += nblk) rwkv_unit(p, u >> 3, u & 7, (char*)lds);
#endif
#if PHM & 8
    for (int u = bid; u < BATCH * (SEQ / 128); u += nblk) attn_unit(p, u / (SEQ / 128), u % (SEQ / 128), (char*)lds);
#endif
    grid.sync();
#if PHM & 16
    {
        pg8::Gemm g{(const pg8::bf16_t*)(ws + WS_Y), (const pg8::bf16_t*)(ws + WS_WOUTT), T, D, D};
        pg8::StaticOrder S; S.init(T, D, nblk, bid);
        EpiResF32 E{p.x, p.out};
        pg8::gemm_phase<EpiResF32, pg8::StaticOrder, true, true>((PG8_LAS unsigned char*)lds, g, S, E);
    }
#endif
    grid.sync();
#if PHM & 32
    rms_rows(p.out, p.ln2_g, (unsigned short*)(ws + WS_H), bid * (NTHR / 64) + (TID >> 6), nblk * (NTHR / 64));
#endif
    grid.sync();
#if PHM & 64
    {
        pg8::Gemm g{(const pg8::bf16_t*)(ws + WS_H), (const pg8::bf16_t*)(ws + WS_WFT), T, 2048, D};
        pg8::StaticOrder S; S.init(T, 2048, nblk, bid);
        EpiTopK E{(int*)(ws + WS_IDX), (float*)(ws + WS_GATE)};
        OneUnit one;
        for (int i = 0; S.next(i, one.u); ++i) pg8::gemm_phase<EpiTopK, OneUnit, false, true>((PG8_LAS unsigned char*)lds, g, one, E);
    }
#endif
    grid.sync();
#if PHM & 128
#if DUP & 128
    peer_phase(p, bid * (NTHR / 64) + (TID >> 6), nblk * (NTHR / 64), (float*)(ws + WS_P));
#endif
    peer_phase(p, bid * (NTHR / 64) + (TID >> 6), nblk * (NTHR / 64), p.out);
#endif
}

extern "C" void kernel_launch(void* const* d_in, const int* in_sizes, int n_in, void* d_out, int out_size, void* d_ws, size_t ws_size, hipStream_t stream) {
    static int grid = 0;
    if (grid == 0) {
        if (n_in != 24 || out_size != T * D || ws_size < WS_END) { fprintf(stderr, "kernel_launch: unexpected shapes (n_in %d, out %d, ws %zu < %zu)\n", n_in, out_size, ws_size, (size_t)WS_END); grid = -1; return; }
        int dev = 0, cus = 0, per_cu = 0;
        hipGetDevice(&dev);
        hipDeviceGetAttribute(&cus, hipDeviceAttributeMultiprocessorCount, dev);
        hipFuncSetAttribute((const void*)fwd_kernel, hipFuncAttributeMaxDynamicSharedMemorySize, LDS_BYTES);
        hipOccupancyMaxActiveBlocksPerMultiprocessor(&per_cu, (const void*)fwd_kernel, NTHR, LDS_BYTES);
        if (per_cu < 1) { fprintf(stderr, "kernel_launch: occupancy query says %d blocks per CU\n", per_cu); per_cu = 1; }
        if (per_cu > 1) per_cu = 1;
        grid = cus * per_cu;
        (void)hipGetLastError();
    }
    if (grid < 0) return;
    Params p{};
    const float** pp = (const float**)&p;
    for (int i = 0; i < 24; ++i) pp[i] = (const float*)d_in[i];
    p.out = (float*)d_out; p.ws = (unsigned char*)d_ws;
    void* args[] = {&p};
    hipError_t e = hipLaunchCooperativeKernel((const void*)fwd_kernel, dim3(grid), dim3(NTHR), args, LDS_BYTES, stream);
    if (e != hipSuccess) fprintf(stderr, "cooperative launch failed: %s (grid %d)\n", hipGetErrorString(e), grid);
}
#endif
```

```cpp
#ifndef EMU
#include <hip/hip_runtime.h>
#include <hip/hip_cooperative_groups.h>
#include <cstdio>
#include <cstdint>
namespace cg = cooperative_groups;
typedef short bf16x8 __attribute__((ext_vector_type(8)));
typedef short bf16x4 __attribute__((ext_vector_type(4)));
typedef float f32x16 __attribute__((ext_vector_type(16)));
typedef float f32x4 __attribute__((ext_vector_type(4)));
typedef float f32x2 __attribute__((ext_vector_type(2)));
typedef unsigned u32x4 __attribute__((ext_vector_type(4)));
typedef unsigned u32x2 __attribute__((ext_vector_type(2)));
#define TID ((int)threadIdx.x)
#define BSYNC() __syncthreads()
#define WSYNC() __builtin_amdgcn_wave_barrier()
#define OPAQUE(x) asm volatile("" : "+v"(x))
__device__ __forceinline__ float shfl_xor_f(float v, int m) { return __shfl_xor(v, m); }
__device__ __forceinline__ float shfl_f(float v, int s) { return __shfl(v, s); }
__device__ __forceinline__ int shfl_i(int v, int s) { return __shfl(v, s); }
__device__ __forceinline__ float rdlane_f(float v, int l) { return __builtin_bit_cast(float, __builtin_amdgcn_readlane(__builtin_bit_cast(int, v), l)); }
__device__ __forceinline__ int rdlane_i(int v, int l) { return __builtin_amdgcn_readlane(v, l); }
__device__ __forceinline__ f32x2 cvt_pk_f32_fp8(unsigned w, bool hi) { return hi ? __builtin_amdgcn_cvt_pk_f32_fp8((int)w, true) : __builtin_amdgcn_cvt_pk_f32_fp8((int)w, false); }
__device__ __forceinline__ unsigned cvt_pk_fp8_f32(float a, float b, unsigned old, bool hi) { return hi ? (unsigned)__builtin_amdgcn_cvt_pk_fp8_f32(a, b, (int)old, true) : (unsigned)__builtin_amdgcn_cvt_pk_fp8_f32(a, b, (int)old, false); }
template <int CTRL> __device__ __forceinline__ float dppf(float v) { return __builtin_bit_cast(float, __builtin_amdgcn_update_dpp(0, __builtin_bit_cast(int, v), CTRL, 0xF, 0xF, true)); }
__device__ __forceinline__ float row_sum(float v) { v += dppf<0xB1>(v); v += dppf<0x4E>(v); v += dppf<0x141>(v); v += dppf<0x140>(v); return v; }
__device__ __forceinline__ void swap16(float v, float& r0, float& r1) { unsigned a = __builtin_bit_cast(unsigned, v), b = a; asm volatile("" : "+v"(b)); auto rr = __builtin_amdgcn_permlane16_swap(a, b, false, false); const unsigned u0 = rr[0], u1 = rr[1]; r0 = __builtin_bit_cast(float, u0); r1 = __builtin_bit_cast(float, u1); }
__device__ __forceinline__ void swap32(float v, float& r0, float& r1) { unsigned a = __builtin_bit_cast(unsigned, v), b = a; asm volatile("" : "+v"(b)); auto rr = __builtin_amdgcn_permlane32_swap(a, b, false, false); const unsigned u0 = rr[0], u1 = rr[1]; r0 = __builtin_bit_cast(float, u0); r1 = __builtin_bit_cast(float, u1); }
__device__ __forceinline__ float xor16_f(float v, int lane) { float r0, r1; swap16(v, r0, r1); return (lane & 16) ? r0 : r1; }
__device__ __forceinline__ float xor32_f(float v, int lane) { float r0, r1; swap32(v, r0, r1); return (lane & 32) ? r0 : r1; }
__device__ __forceinline__ float half_sum(float v) { v = row_sum(v); float r0, r1; swap16(v, r0, r1); return r0 + r1; }
__device__ __forceinline__ float wave_sum(float v) { v = half_sum(v); float r0, r1; swap32(v, r0, r1); return r0 + r1; }
__device__ __forceinline__ float frcp(float x) { return __builtin_amdgcn_rcpf(x); }
__device__ __forceinline__ float frsq(float x) { return __builtin_amdgcn_rsqf(x); }
__device__ __forceinline__ f32x16 mfma32(bf16x8 a, bf16x8 b, f32x16 c) { return __builtin_amdgcn_mfma_f32_32x32x16_bf16(a, b, c, 0, 0, 0); }
__device__ __forceinline__ f32x4 mfma16(bf16x8 a, bf16x8 b, f32x4 c) { return __builtin_amdgcn_mfma_f32_16x16x32_bf16(a, b, c, 0, 0, 0); }
#else
#define WSYNC() emu_barrier(g_wave_bar[TID >> 6], 64)
#define OPAQUE(x)
#endif

#ifndef CFG_BATCH
#define CFG_BATCH 32
#endif
#ifndef CFG_SEQ
#define CFG_SEQ 2048
#endif
constexpr int D = 1024, BATCH = CFG_BATCH, SEQ = CFG_SEQ, T = BATCH * SEQ;
constexpr int NTHR = 512;
constexpr int PCOLS = 2560;
constexpr int PC_R = 0, PC_K = 512, PC_V = 1024, PC_Q = 1536, PC_AK = 2048, PC_AV = 2176, PC_LORA = 2304;
constexpr int NEXP = 16384;
constexpr float RMS_EPS = 1e-6f, LNX_EPS = 64e-5f;

constexpr size_t MiB = 1u << 20;
constexpr size_t al1m(size_t x) { return (x + MiB - 1) / MiB * MiB; }
constexpr size_t WS_CTL = 0;
constexpr size_t WS_BIASP = 1 * MiB;
constexpr size_t WS_WINT = 2 * MiB;
constexpr size_t WS_WOUTT = 7 * MiB;
constexpr size_t WS_WFT = 9 * MiB;
constexpr size_t WS_U8 = 16 * MiB;
constexpr size_t WS_V8 = 32 * MiB;
constexpr size_t WS_FRG = 50 * MiB;
constexpr size_t WS_SSQ = 52 * MiB;
constexpr size_t WS_USC = 48 * MiB;
constexpr size_t WS_VSC = 49 * MiB;
constexpr size_t WS_H = 80 * MiB;
constexpr size_t WS_Y = WS_H + al1m((size_t)T * D * 2);
constexpr size_t WS_P = WS_Y + al1m((size_t)T * D * 2);
constexpr size_t WS_IDX = WS_P + al1m((size_t)T * PCOLS * 2);
constexpr size_t WS_GATE = WS_IDX + al1m((size_t)T * 128 * 4);
constexpr size_t WS_END = WS_GATE + al1m((size_t)T * 128 * 4);

struct Params {
    const float* x; const float* ln1_g; const float* w_in; const float* b_attn; const float* mu_shift; const float* w0; const float* w_up; const float* a0;
    const float* a_up; const float* g_up; const float* k_k; const float* k_a; const float* r_k; const float* lnx_w; const float* lnx_b; const float* attn_sinks;
    const float* attn_norm_g; const float* w_out; const float* ln2_g; const float* peer_wq; const float* peer_subkeys; const float* peer_u; const float* peer_v; const float* lnf_g;
    float* out; unsigned char* ws;
};

#ifndef EMU
typedef __bf16 hwbf16x2 __attribute__((ext_vector_type(2)));
__device__ __forceinline__ unsigned f2bf(float f) { const __bf16 b = (__bf16)f; return (unsigned)__builtin_bit_cast(unsigned short, b); }
__device__ __forceinline__ unsigned pk2(float lo, float hi) { const f32x2 v = {lo, hi}; const hwbf16x2 b = __builtin_convertvector(v, hwbf16x2); return __builtin_bit_cast(unsigned, b); }
#else
__device__ __forceinline__ unsigned f2bf(float f) { unsigned u = __builtin_bit_cast(unsigned, f); return (u + 0x7fffu + ((u >> 16) & 1u)) >> 16; }
__device__ __forceinline__ unsigned pk2(float lo, float hi) { return f2bf(lo) | (f2bf(hi) << 16); }
#endif
__device__ __forceinline__ float bfl(unsigned short b) { return __builtin_bit_cast(float, (unsigned)b << 16); }
__device__ __forceinline__ float bf_lo(unsigned w) { return __builtin_bit_cast(float, w << 16); }
__device__ __forceinline__ float bf_hi(unsigned w) { return __builtin_bit_cast(float, w & 0xffff0000u); }
__device__ __forceinline__ int crow(int r, int hi) { return (r & 3) + 8 * (r >> 2) + 4 * hi; }
__device__ __forceinline__ int win_src_col(int n) { if (n < 1536) return n; if (n < 2304) return n + 160; if (n < 2464) return n - 768; return -1; }
__device__ __forceinline__ float sigmoidf_(float z) { return 1.f / (1.f + expf(-z)); }

__device__ __forceinline__ void p0_transpose_tile(const float* W, int K, int ldw, unsigned short* WT, int k0, int n0, int mode, float* tl) {
    const int t = TID, kk = t >> 6, nn = t & 63;
    const int sc = mode ? win_src_col(n0 + nn) : (n0 + nn);
#pragma unroll
    for (int i = 0; i < 8; ++i) { const int k = kk + 8 * i; tl[k * 65 + nn] = sc >= 0 ? W[(size_t)(k0 + k) * ldw + sc] : 0.f; }
    BSYNC();
    const int n = t >> 3, c = t & 7;
    u32x4 o;
    o.x = pk2(tl[(8 * c + 0) * 65 + n], tl[(8 * c + 1) * 65 + n]); o.y = pk2(tl[(8 * c + 2) * 65 + n], tl[(8 * c + 3) * 65 + n]);
    o.z = pk2(tl[(8 * c + 4) * 65 + n], tl[(8 * c + 5) * 65 + n]); o.w = pk2(tl[(8 * c + 6) * 65 + n], tl[(8 * c + 7) * 65 + n]);
    *(u32x4*)(WT + (size_t)(n0 + n) * K + k0 + 8 * c) = o;
    BSYNC();
}
__device__ __forceinline__ void p0_wfused_item(const float* wq, const float* sk, const float* g2, unsigned short* WfT, int hc, int kt, float* lds) {
    float* skl = lds;
    float* wql = lds + 128 * 129;
    for (int i = TID; i < 16384; i += NTHR) { const int n = i >> 7, d = i & 127; skl[n * 129 + d] = sk[(size_t)hc * 16384 + i]; }
    for (int i = TID; i < 64 * 128; i += NTHR) { const int k = i >> 7, d = i & 127; wql[d * 64 + k] = wq[(size_t)(kt * 64 + k) * 2048 + hc * 128 + d]; }
    BSYNC();
    const int n = TID & 127, kg = TID >> 7;
    float acc[16];
#pragma unroll
    for (int j = 0; j < 16; ++j) acc[j] = 0.f;
    for (int d = 0; d < 128; ++d) {
        const float a = skl[n * 129 + d]; const float* bp = wql + d * 64 + kg * 16;
#pragma unroll
        for (int j = 0; j < 16; ++j) acc[j] += a * bp[j];
    }
#pragma unroll
    for (int j = 0; j < 16; ++j) acc[j] *= g2[kt * 64 + kg * 16 + j];
    unsigned short* dst = WfT + (size_t)(hc * 128 + n) * D + kt * 64 + kg * 16;
    u32x4 o0, o1;
    o0.x = pk2(acc[0], acc[1]); o0.y = pk2(acc[2], acc[3]); o0.z = pk2(acc[4], acc[5]); o0.w = pk2(acc[6], acc[7]);
    o1.x = pk2(acc[8], acc[9]); o1.y = pk2(acc[10], acc[11]); o1.z = pk2(acc[12], acc[13]); o1.w = pk2(acc[14], acc[15]);
    *(u32x4*)dst = o0; *(u32x4*)(dst + 8) = o1;
    BSYNC();
}
__device__ __forceinline__ void rms_rows(const float* X, const float* g, unsigned short* H, int gw, int ngw) {
    const int lane = TID & 63;
    for (int m = gw; m < T; m += ngw) {
        const f32x4* xr = (const f32x4*)(X + (size_t)m * D) + lane; f32x4 v[4]; float s = 0.f;
#pragma unroll
        for (int j = 0; j < 4; ++j) { v[j] = xr[64 * j]; s += (v[j].x * v[j].x + v[j].y * v[j].y) + (v[j].z * v[j].z + v[j].w * v[j].w); }
        const float rstd = 1.0f / sqrtf(wave_sum(s) * (1.f / D) + RMS_EPS);
        u32x2* o8 = (u32x2*)(H + (size_t)m * D) + lane;
#pragma unroll
        for (int j = 0; j < 4; ++j) { const f32x4 gg = ((const f32x4*)g)[lane + 64 * j]; u32x2 w; w.x = pk2(v[j].x * rstd * gg.x, v[j].y * rstd * gg.y); w.y = pk2(v[j].z * rstd * gg.z, v[j].w * rstd * gg.w); o8[64 * j] = w; }
    }
}
__device__ __forceinline__ void p0_prologue(const Params& p, int bid, int nblk, char* smem) {
    float* lds = (float*)smem;
    unsigned char* ws = p.ws;
    unsigned short* WinT = (unsigned short*)(ws + WS_WINT); unsigned short* WoutT = (unsigned short*)(ws + WS_WOUTT); unsigned short* WfT = (unsigned short*)(ws + WS_WFT);
    constexpr int I_IN = 640, I_OUT = 256, I_WF = 256;
    for (int it = bid; it < I_IN + I_OUT + I_WF; it += nblk) {
        int r = it;
        if (r < I_IN) { p0_transpose_tile(p.w_in, D, 2464, WinT, (r / 40) * 64, (r % 40) * 64, 1, lds); continue; } r -= I_IN;
        if (r < I_OUT) { p0_transpose_tile(p.w_out, D, D, WoutT, (r / 16) * 64, (r % 16) * 64, 0, lds); continue; } r -= I_OUT;
        p0_wfused_item(p.peer_wq, p.peer_subkeys, p.ln2_g, WfT, r / 16, r % 16, lds);
    }
    const size_t gt = (size_t)bid * NTHR + TID, ngt = (size_t)nblk * NTHR;
    float* biasP = (float*)(ws + WS_BIASP);
    for (size_t i = gt; i < (size_t)PCOLS; i += ngt) biasP[i] = (i >= 1536 && i < 2304) ? p.b_attn[i - 1536] : 0.f;
    {
        const int lane = TID & 63; const int gw = bid * (NTHR / 64) + (TID >> 6), ngw = nblk * (NTHR / 64);
        for (int rr = gw; rr < 2 * NEXP; rr += ngw) {
            const int tab = rr >= NEXP, row = rr - tab * NEXP;
            const float* src = (tab ? p.peer_v : p.peer_u) + (size_t)row * D;
            unsigned* dst = (unsigned*)(ws + (tab ? WS_V8 : WS_U8) + (size_t)row * D);
            f32x4 v[4]; float mx = 0.f;
#pragma unroll
            for (int j = 0; j < 4; ++j) { v[j] = ((const f32x4*)src)[lane + 64 * j]; mx = fmaxf(mx, fmaxf(fmaxf(fabsf(v[j].x), fabsf(v[j].y)), fmaxf(fabsf(v[j].z), fabsf(v[j].w)))); }
#pragma unroll
            for (int o = 1; o < 64; o <<= 1) mx = fmaxf(mx, shfl_xor_f(mx, o));
            int ex = 0; if (mx > 0.f) ex = ilogbf(mx);
            const float sc = ldexpf(1.f, 7 - ex), inv = ldexpf(1.f, ex - 7);
#pragma unroll
            for (int j = 0; j < 4; ++j) { unsigned w = 0u; w = cvt_pk_fp8_f32(v[j].x * sc, v[j].y * sc, w, false); w = cvt_pk_fp8_f32(v[j].z * sc, v[j].w * sc, w, true); dst[lane + 64 * j] = w; }
            if (lane == 0) ((float*)(ws + (tab ? WS_VSC : WS_USC)))[row] = inv;
        }
    }
    for (size_t i = gt; i < (size_t)8 * 10 * 2 * 64; i += ngt) {
        const int ln = (int)(i & 63), tc = (int)((i >> 6) & 1), f = (int)((i >> 7) % 10), hd = (int)((i >> 7) / 10);
        const float* src = f < 2 ? p.w_up : (f < 4 ? p.a_up : p.g_up); const int ks = f < 2 ? f : (f < 4 ? f - 2 : f - 4);
        const int cg = hd * 64 + 32 * tc + (ln & 31);
        float v8[8];
#pragma unroll
        for (int j = 0; j < 8; ++j) v8[j] = src[(16 * ks + 8 * (ln >> 5) + j) * 512 + cg];
        u32x4 o; o.x = pk2(v8[0], v8[1]); o.y = pk2(v8[2], v8[3]); o.z = pk2(v8[4], v8[5]); o.w = pk2(v8[6], v8[7]);
        ((u32x4*)(ws + WS_FRG))[i] = o;
    }
    rms_rows(p.x, p.ln1_g, (unsigned short*)(ws + WS_H), bid * (NTHR / 64) + (TID >> 6), nblk * (NTHR / 64));
}

constexpr int MP = 72;
constexpr int SLOTB = 64 * MP * 2;
constexpr int LP = 168;
constexpr int RW_PAR = 0;
constexpr int RW_SB = 4096;
constexpr int RW_AT = RW_SB + SLOTB, RW_RT = RW_AT + SLOTB, RW_BHT = RW_RT + SLOTB, RW_KHT = RW_BHT + SLOTB, RW_VT = RW_KHT + SLOTB, RW_GM = RW_VT + SLOTB;
constexpr int RW_RA = RW_GM + SLOTB;
constexpr int RW_P = RW_RA, RW_PT = RW_P + SLOTB, RW_TM = RW_PT + SLOTB, RW_AAK = RW_TM + SLOTB, RW_ARB = RW_AAK + SLOTB, RW_ARK = RW_ARB + SLOTB;
constexpr int RW_RB = RW_RA + 6 * SLOTB;
constexpr int RW_BH = RW_RB, RW_KH = RW_RB + SLOTB, RW_WT = RW_RB, RW_UT = RW_RB + SLOTB;
constexpr int RW_TOT = RW_RB + 3 * SLOTB;
constexpr int RW_BON = RW_TOT + 2048;
constexpr int RW_GC = RW_BON + 256;
constexpr int RW_END = RW_GC + 256;
static_assert(RW_END <= 155648, "rwkv LDS map");

__device__ __forceinline__ f32x16 zero16() { f32x16 z;
#pragma unroll
    for (int i = 0; i < 16; ++i) z[i] = 0.f; return z; }
__device__ __forceinline__ f32x16 tile_mm(f32x16 acc, const unsigned short* A, const unsigned short* B, int tr, int tc, int lane) {
    const unsigned short* ap = A + (32 * tr + (lane & 31)) * MP + 8 * (lane >> 5);
    const unsigned short* bp = B + (32 * tc + (lane & 31)) * MP + 8 * (lane >> 5);
#pragma unroll
    for (int ks = 0; ks < 4; ++ks) acc = mfma32(*(const bf16x8*)(ap + 16 * ks), *(const bf16x8*)(bp + 16 * ks), acc);
    return acc;
}
__device__ __forceinline__ void store_rm(const f32x16& acc, unsigned short* M, int tr, int tc, int lane) {
    unsigned short* base = M + (32 * tr + 4 * (lane >> 5)) * MP + 32 * tc + (lane & 31);
#pragma unroll
    for (int r = 0; r < 16; ++r) base[((r & 3) + 8 * (r >> 2)) * MP] = (unsigned short)f2bf(acc[r]);
}
__device__ __forceinline__ void store_tr(const f32x16& acc, unsigned short* MT, int tr, int tc, int lane) {
    unsigned short* base = MT + (32 * tc + (lane & 31)) * MP + 32 * tr + 4 * (lane >> 5);
#pragma unroll
    for (int g4 = 0; g4 < 4; ++g4) { u32x2 w; w.x = pk2(acc[4 * g4], acc[4 * g4 + 1]); w.y = pk2(acc[4 * g4 + 2], acc[4 * g4 + 3]); *(u32x2*)(base + 8 * g4) = w; }
}
__device__ __forceinline__ float fexp(float x) { return __expf(x); }

__device__ __forceinline__ void rwkv_unit(const Params& p, int b, int h, char* smem) {
    float* par = (float*)(smem + RW_PAR);
    unsigned short* Sb = (unsigned short*)(smem + RW_SB);
    unsigned short* At = (unsigned short*)(smem + RW_AT); unsigned short* Rt = (unsigned short*)(smem + RW_RT);
    unsigned short* BhT = (unsigned short*)(smem + RW_BHT); unsigned short* KhT = (unsigned short*)(smem + RW_KHT);
    unsigned short* VT = (unsigned short*)(smem + RW_VT); unsigned short* Gm = (unsigned short*)(smem + RW_GM);
    float* lres = (float*)(smem + RW_RA); float* Ol = (float*)(smem + RW_RA);
    unsigned short* Pm = (unsigned short*)(smem + RW_P); unsigned short* PT = (unsigned short*)(smem + RW_PT); unsigned short* Tm = (unsigned short*)(smem + RW_TM);
    unsigned short* Aak = (unsigned short*)(smem + RW_AAK); unsigned short* Arb = (unsigned short*)(smem + RW_ARB); unsigned short* Ark = (unsigned short*)(smem + RW_ARK);
    unsigned short* lora = (unsigned short*)(smem + RW_RB); unsigned short* Bh = (unsigned short*)(smem + RW_BH); unsigned short* Kh = (unsigned short*)(smem + RW_KH);
    unsigned short* WT = (unsigned short*)(smem + RW_WT); unsigned short* UT = (unsigned short*)(smem + RW_UT);
    float* tot = (float*)(smem + RW_TOT); float* bon = (float*)(smem + RW_BON); float* gC = (float*)(smem + RW_GC);
    const unsigned short* P = (const unsigned short*)(p.ws + WS_P);
    unsigned short* Y = (unsigned short*)(p.ws + WS_Y);
    int tid = TID; OPAQUE(tid);
    const int w = tid >> 6; int lane = tid & 63;
    const int ch = tid & 63, tg = w;
    const int q4 = w & 3, qtr = q4 >> 1, qtc = q4 & 1;
    if (tid < 64) {
        const int c = h * 64 + tid;
        par[tid] = p.mu_shift[c]; par[64 + tid] = p.mu_shift[512 + c]; par[128 + tid] = p.mu_shift[1024 + c];
        par[352 + tid] = p.w0[c]; par[416 + tid] = p.a0[c]; par[480 + tid] = p.k_k[c]; par[544 + tid] = p.k_a[c]; par[608 + tid] = p.r_k[c]; par[672 + tid] = p.lnx_w[c]; par[736 + tid] = p.lnx_b[c];
    }
    if (tid < 160) par[192 + tid] = p.mu_shift[1536 + tid];
    for (int i = tid; i < 64 * MP; i += NTHR) Sb[i] = 0;
    const bf16x8* frg = (const bf16x8*)(p.ws + WS_FRG) + ((size_t)(h * 10 + (w < 4 ? 0 : 4)) * 2 + qtc) * 64 + (tid & 63);
    f32x16 sreg = zero16();
    const float mu_r = p.mu_shift[h * 64 + ch], mu_k = p.mu_shift[512 + h * 64 + ch], mu_v = p.mu_shift[1024 + h * 64 + ch];
    const float c_w0 = p.w0[h * 64 + ch], c_a0 = p.a0[h * 64 + ch], c_kk = p.k_k[h * 64 + ch], c_ka = p.k_a[h * 64 + ch], c_rk = p.r_k[h * 64 + ch], c_lw = p.lnx_w[h * 64 + ch], c_lb = p.lnx_b[h * 64 + ch];
    BSYNC();
#pragma unroll 1
    for (int s0 = 0; s0 < SEQ; s0 += 64) {
        const size_t tbase = (size_t)b * SEQ + s0;
        OPAQUE(lane);
        const int hh = lane >> 5, l31 = lane & 31;
        bf16x8 fr[6];
#pragma unroll
        for (int f = 0; f < 6; ++f) fr[f] = frg[128 * (w < 4 ? (f & 3) : f)];
        float rr[9], kr[9], vr[9];
        {
            const int tfirst = s0 + 8 * tg - 1;
#pragma unroll
            for (int i = 0; i < 9; ++i) {
                const int sp = tfirst + i;
                if (sp >= 0) { const unsigned short* row = P + ((size_t)b * SEQ + sp) * PCOLS + h * 64 + ch; rr[i] = bfl(row[PC_R]); kr[i] = bfl(row[PC_K]); vr[i] = bfl(row[PC_V]); }
                else { rr[i] = 0.f; kr[i] = 0.f; vr[i] = 0.f; }
            }
        }
        for (int it = tid; it < 64 * 20; it += NTHR) {
            const int tok = it / 20, c = it - tok * 20;
            const unsigned short* row = P + (tbase + tok) * PCOLS + PC_LORA + 8 * c;
            const u32x4 cu = *(const u32x4*)row;
            u32x4 pv = (u32x4){0u, 0u, 0u, 0u};
            if (s0 + tok > 0) pv = *(const u32x4*)(row - PCOLS);
            float o8[8];
#pragma unroll
            for (int j = 0; j < 4; ++j) {
                const unsigned cw = cu[j], pw = pv[j];
                const float c0 = bf_lo(cw), c1 = bf_hi(cw), p0 = bf_lo(pw), p1 = bf_hi(pw);
                const float m0 = par[192 + 8 * c + 2 * j], m1 = par[192 + 8 * c + 2 * j + 1];
                o8[2 * j] = c0 + m0 * (p0 - c0); o8[2 * j + 1] = c1 + m1 * (p1 - c1);
            }
            if (c < 4) {
#pragma unroll
                for (int j = 0; j < 8; ++j) { const float e2 = fexp(2.f * o8[j]); o8[j] = 1.f - 2.f * frcp(e2 + 1.f); }
            } else if (c >= 8) {
#pragma unroll
                for (int j = 0; j < 8; ++j) o8[j] = frcp(1.f + fexp(-o8[j]));
            }
            u32x4 ow; ow.x = pk2(o8[0], o8[1]); ow.y = pk2(o8[2], o8[3]); ow.z = pk2(o8[4], o8[5]); ow.w = pk2(o8[6], o8[7]);
            *(u32x4*)(lora + tok * LP + 8 * c) = ow;
        }
        BSYNC();
        {
            const unsigned short* ap = lora + (32 * qtr + l31) * LP + 8 * hh;
            if (w < 4) {
                f32x16 aw = zero16(), aa = zero16();
#pragma unroll
                for (int ks = 0; ks < 2; ++ks) { aw = mfma32(*(const bf16x8*)(ap + 16 * ks), fr[ks], aw); aa = mfma32(*(const bf16x8*)(ap + 32 + 16 * ks), fr[2 + ks], aa); }
                { float* lb = lres + (32 * qtr + 4 * hh) * 64 + 32 * qtc + l31;
#pragma unroll
                for (int r = 0; r < 16; ++r) { lb[((r & 3) + 8 * (r >> 2)) * 64] = aw[r]; lb[4096 + ((r & 3) + 8 * (r >> 2)) * 64] = aa[r]; } }
            } else {
                f32x16 ag = zero16();
#pragma unroll
                for (int ks = 0; ks < 6; ++ks) ag = mfma32(*(const bf16x8*)(ap + 64 + 16 * ks), fr[ks], ag);
                store_rm(ag, Gm, qtr, qtc, lane);
            }
        }
        BSYNC();
        {
            float lw[8], kkv[8], bb[8], km[8], rs[8], vs[8], csl[8];
            float cs = 0.f;
#pragma unroll
            for (int i = 0; i < 8; ++i) {
                const int t = 8 * tg + i;
                rs[i] = rr[i + 1] + mu_r * (rr[i] - rr[i + 1]);
                const float ksh = kr[i + 1] + mu_k * (kr[i] - kr[i + 1]);
                vs[i] = vr[i + 1] + mu_v * (vr[i] - vr[i + 1]);
                const float z = -(c_w0 + lres[t * 64 + ch]);
                const float sp = fmaxf(z, 0.f) + __logf(1.f + fexp(-fabsf(z)));
                lw[i] = -fexp(-sp - 0.5f);
                const float alpha = frcp(1.f + fexp(-(c_a0 + lres[4096 + t * 64 + ch])));
                const float kx = ksh * c_kk;
                kkv[i] = kx * frsq(fmaxf(wave_sum(kx * kx), 1e-24f));
                bb[i] = kkv[i] * alpha;
                km[i] = ksh * (1.f + (alpha - 1.f) * c_ka);
                const float bo = wave_sum(rs[i] * km[i] * c_rk);
                if (ch == 0) bon[t] = bo;
                cs += lw[i]; csl[i] = cs;
            }
            tot[tg * 64 + ch] = cs;
            BSYNC();
            float pre = 0.f;
            for (int g = 0; g < tg; ++g) pre += tot[g * 64 + ch];
            u32x4 bt, kt, vt; float tb[8], tk[8];
#pragma unroll
            for (int i = 0; i < 8; ++i) {
                const int t = 8 * tg + i;
                const float c = pre + csl[i];
                const float gt = fexp(c), gp = fexp(c - lw[i]), gi = fexp(-c);
                At[t * MP + ch] = (unsigned short)f2bf(-kkv[i] * gp);
                Rt[t * MP + ch] = (unsigned short)f2bf(rs[i] * gt);
                tb[i] = bb[i] * gi; tk[i] = km[i] * gi;
                Bh[t * MP + ch] = (unsigned short)f2bf(tb[i]);
                Kh[t * MP + ch] = (unsigned short)f2bf(tk[i]);
            }
            bt.x = pk2(tb[0], tb[1]); bt.y = pk2(tb[2], tb[3]); bt.z = pk2(tb[4], tb[5]); bt.w = pk2(tb[6], tb[7]);
            kt.x = pk2(tk[0], tk[1]); kt.y = pk2(tk[2], tk[3]); kt.z = pk2(tk[4], tk[5]); kt.w = pk2(tk[6], tk[7]);
            vt.x = pk2(vs[0], vs[1]); vt.y = pk2(vs[2], vs[3]); vt.z = pk2(vs[4], vs[5]); vt.w = pk2(vs[6], vs[7]);
            *(u32x4*)(BhT + ch * MP + 8 * tg) = bt; *(u32x4*)(KhT + ch * MP + 8 * tg) = kt; *(u32x4*)(VT + ch * MP + 8 * tg) = vt;
            if (tg == 7) gC[ch] = fexp(pre + csl[7]);
        }
        BSYNC();
        f32x16 treg[2];
        treg[0] = zero16(); treg[1] = zero16();
        {
            const int prod = w >> 1, tr = w & 1;
            const unsigned short* Lm = prod < 2 ? At : Rt; const unsigned short* Rm = (prod & 1) ? Kh : Bh;
            unsigned short* dst = prod == 0 ? Pm : (prod == 1 ? Aak : (prod == 2 ? Arb : Ark));
#pragma unroll
            for (int tc = 0; tc < 2; ++tc) {
                f32x16 acc = zero16();
                if (tc <= tr) acc = tile_mm(acc, Lm, Rm, tr, tc, lane);
                { const int dlt = 32 * tc + l31 - 32 * tr - 4 * hh - (prod < 2 ? 0 : 1);
#pragma unroll
                for (int r = 0; r < 16; ++r) acc[r] = (dlt < (r & 3) + 8 * (r >> 2)) ? acc[r] : 0.f; }
                store_rm(acc, dst, tr, tc, lane);
                if (prod == 0) {
                    store_tr(acc, PT, tr, tc, lane);
                    { const int dl2 = 32 * tc + l31 - 32 * tr - 4 * hh;
#pragma unroll
                    for (int r = 0; r < 16; ++r) acc[r] += (dl2 == (r & 3) + 8 * (r >> 2)) ? 1.f : 0.f; }
                    store_rm(acc, Tm, tr, tc, lane);
                    treg[tc] = acc;
                }
            }
        }
        BSYNC();
#pragma unroll 1
        for (int j = 1; j <= 6; ++j) {
            f32x16 pa[2];
            pa[0] = zero16(); pa[1] = zero16();
            const int tr = w & 1;
            if ((w == 2 || w == 3) && j <= 5) {
                pa[0] = tile_mm(pa[0], Pm, PT, tr, 0, lane);
                if (tr == 1) pa[1] = tile_mm(pa[1], Pm, PT, tr, 1, lane);
            }
            if (w < 2 && j >= 2) {
                treg[0] = tile_mm(treg[0], Tm, PT, tr, 0, lane);
                if (tr == 1) treg[1] = tile_mm(treg[1], Tm, PT, tr, 1, lane);
            }
            BSYNC();
            if ((w == 2 || w == 3) && j <= 5) {
                store_rm(pa[0], Pm, tr, 0, lane); store_tr(pa[0], PT, tr, 0, lane);
                if (tr == 1) { store_rm(pa[1], Pm, tr, 1, lane); store_tr(pa[1], PT, tr, 1, lane); }
            }
            if (w < 2 && j >= 2) {
                store_rm(treg[0], Tm, tr, 0, lane);
                if (tr == 1) store_rm(treg[1], Tm, tr, 1, lane);
            }
            BSYNC();
        }
        if (w < 4) { f32x16 acc = zero16(); acc = tile_mm(acc, At, Sb, qtr, qtc, lane); acc = tile_mm(acc, Aak, VT, qtr, qtc, lane); store_tr(acc, WT, qtr, qtc, lane); }
        BSYNC();
        if (w < 4) { f32x16 acc = zero16(); acc = tile_mm(acc, Tm, WT, qtr, qtc, lane); store_tr(acc, UT, qtr, qtc, lane); }
        BSYNC();
        f32x16 oacc = zero16();
        if (w < 4) { oacc = tile_mm(oacc, Rt, Sb, qtr, qtc, lane); oacc = tile_mm(oacc, Arb, UT, qtr, qtc, lane); oacc = tile_mm(oacc, Ark, VT, qtr, qtc, lane); }
        else {
            sreg = tile_mm(sreg, UT, BhT, qtr, qtc, lane); sreg = tile_mm(sreg, VT, KhT, qtr, qtc, lane);
            const float gc = gC[32 * qtc + l31];
#pragma unroll
            for (int r = 0; r < 16; ++r) sreg[r] *= gc;
        }
        BSYNC();
        if (w < 4) {
            { float* ob = Ol + (32 * qtr + 4 * hh) * 64 + 32 * qtc + l31;
#pragma unroll
            for (int r = 0; r < 16; ++r) ob[((r & 3) + 8 * (r >> 2)) * 64] = oacc[r]; }
        } else store_rm(sreg, Sb, qtr, qtc, lane);
        BSYNC();
#pragma unroll
        for (int i = 0; i < 8; ++i) {
            const int t = 8 * tg + i;
            const float o = Ol[t * 64 + ch];
            const float mean = wave_sum(o) * (1.f / 64.f);
            const float dv = o - mean;
            const float var = wave_sum(dv * dv) * (1.f / 64.f);
            float y = dv * frsq(var + LNX_EPS) * c_lw + c_lb;
            y = (y + bon[t] * bfl(VT[ch * MP + t])) * bfl(Gm[t * MP + ch]);
            Y[(tbase + t) * D + h * 64 + ch] = (unsigned short)f2bf(y);
        }
        BSYNC();
    }
}

constexpr int KPITCH = 72, VPITCH = 260;
__device__ __forceinline__ void attn_unit(const Params& p, int b, int n, char* smem) {
    unsigned short* Kl = (unsigned short*)smem;
    unsigned short* Vt = Kl + 2 * 256 * KPITCH;
    float* ssl = (float*)(Vt + 2 * 64 * VPITCH);
    float* rstdl = ssl + 1024;
    float* wsf = rstdl + 128;
    const unsigned short* P = (const unsigned short*)(p.ws + WS_P);
    unsigned short* Y = (unsigned short*)(p.ws + WS_Y);
    const int tid = TID, lane = tid & 63, w = tid >> 6, q = lane & 31, hh = lane >> 5, g = w >> 2;
    const long tb = (long)b * SEQ + (long)(n - 1) * 128;
    for (int i = tid; i < 4096; i += NTHR) {
        const int c = i & 7, kj = (i >> 3) & 255, gg = i >> 11;
        const bool valid = (n > 0) || (kj >= 128);
        u32x4 kv = (u32x4){0u, 0u, 0u, 0u}, vv = (u32x4){0u, 0u, 0u, 0u};
        if (valid) { const unsigned short* row = P + (size_t)(tb + kj) * PCOLS; kv = *(const u32x4*)(row + PC_AK + gg * 64 + c * 8); vv = *(const u32x4*)(row + PC_AV + gg * 64 + c * 8); }
        *(u32x4*)(Kl + (gg * 256 + kj) * KPITCH + c * 8) = kv;
        unsigned short* vd = Vt + (gg * 64 + c * 8) * VPITCH + kj;
        vd[0 * VPITCH] = (unsigned short)(vv.x & 0xffff); vd[1 * VPITCH] = (unsigned short)(vv.x >> 16);
        vd[2 * VPITCH] = (unsigned short)(vv.y & 0xffff); vd[3 * VPITCH] = (unsigned short)(vv.y >> 16);
        vd[4 * VPITCH] = (unsigned short)(vv.z & 0xffff); vd[5 * VPITCH] = (unsigned short)(vv.z >> 16);
        vd[6 * VPITCH] = (unsigned short)(vv.w & 0xffff); vd[7 * VPITCH] = (unsigned short)(vv.w >> 16);
    }
    BSYNC();
    const float sink = p.attn_sinks[w];
    const long tq_blk = (long)b * SEQ + (long)n * 128;
    for (int it = 0; it < 4; ++it) {
        bf16x8 qf[4];
#pragma unroll
        for (int ks = 0; ks < 4; ++ks) qf[ks] = *(const bf16x8*)(P + (size_t)(tq_blk + 32 * it + q) * PCOLS + PC_Q + w * 64 + 16 * ks + 8 * hh);
        f32x16 pb[5];
        float mloc = sink;
        const int iq = 32 * it + q;
#pragma unroll
        for (int bi = 0; bi < 5; ++bi) {
            const int jb = it + bi;
            const bool active = (n > 0) || (jb >= 4);
#pragma unroll
            for (int r = 0; r < 16; ++r) pb[bi][r] = 0.f;
            if (active) {
#pragma unroll
                for (int ks = 0; ks < 4; ++ks) { const bf16x8 kf = *(const bf16x8*)(Kl + (g * 256 + 32 * jb + q) * KPITCH + 16 * ks + 8 * hh); pb[bi] = mfma32(kf, qf[ks], pb[bi]); }
            }
#pragma unroll
            for (int r = 0; r < 16; ++r) {
                const int kj = 32 * jb + crow(r, hh);
                const bool ok = active && (kj >= iq + 1) && (kj <= iq + 128);
                const float s = ok ? pb[bi][r] * 0.125f : -1e30f;
                pb[bi][r] = s; mloc = fmaxf(mloc, s);
            }
        }
        mloc = fmaxf(mloc, xor32_f(mloc, lane));
        float lsum = 0.f;
#pragma unroll
        for (int bi = 0; bi < 5; ++bi)
#pragma unroll
            for (int r = 0; r < 16; ++r) { const float e = expf(pb[bi][r] - mloc); pb[bi][r] = e; lsum += e; }
        lsum += xor32_f(lsum, lane);
        lsum += expf(sink - mloc);
        f32x16 o[2];
#pragma unroll
        for (int r = 0; r < 16; ++r) { o[0][r] = 0.f; o[1][r] = 0.f; }
#pragma unroll
        for (int bi = 0; bi < 5; ++bi) {
            const int jb = it + bi;
            const bool active = (n > 0) || (jb >= 4);
            if (active) {
#pragma unroll
                for (int s2 = 0; s2 < 2; ++s2) {
                    bf16x8 pa;
#pragma unroll
                    for (int j = 0; j < 8; ++j) pa[j] = (short)f2bf(pb[bi][8 * s2 + j]);
#pragma unroll
                    for (int dt = 0; dt < 2; ++dt) {
                        const unsigned short* vp = Vt + (g * 64 + 32 * dt + q) * VPITCH + 32 * jb + 16 * s2 + 4 * hh;
                        const bf16x4 lo = *(const bf16x4*)vp, hi = *(const bf16x4*)(vp + 8);
                        const bf16x8 vf = (bf16x8){lo[0], lo[1], lo[2], lo[3], hi[0], hi[1], hi[2], hi[3]};
                        o[dt] = mfma32(pa, vf, o[dt]);
                    }
                }
            }
        }
        if (hh == 0) wsf[w * 32 + q] = 1.f / lsum;
        WSYNC();
        float ss[16];
#pragma unroll
        for (int r = 0; r < 16; ++r) { const float il = wsf[w * 32 + crow(r, hh)]; o[0][r] *= il; o[1][r] *= il; ss[r] = o[0][r] * o[0][r] + o[1][r] * o[1][r]; }
        WSYNC();
#pragma unroll
        for (int r = 0; r < 16; ++r) {
            const float s = half_sum(ss[r]);
            if (q == 0) ssl[(32 * it + crow(r, hh)) * 8 + w] = s;
            const size_t trow = (size_t)(tq_blk + 32 * it + crow(r, hh));
            Y[trow * D + 512 + w * 64 + q] = (unsigned short)f2bf(o[0][r]);
            Y[trow * D + 512 + w * 64 + 32 + q] = (unsigned short)f2bf(o[1][r]);
        }
    }
    BSYNC();
    if (tid < 128) { float s = 0.f;
#pragma unroll
        for (int j = 0; j < 8; ++j) s += ssl[tid * 8 + j];
        rstdl[tid] = 1.0f / sqrtf(s * (1.f / 512.f) + RMS_EPS); }
    BSYNC();
    const float g0 = p.attn_norm_g[w * 64 + q], g1 = p.attn_norm_g[w * 64 + 32 + q];
    for (int it = 0; it < 4; ++it)
#pragma unroll
        for (int r = 0; r < 16; ++r) {
            const int qi = 32 * it + crow(r, hh); const float rs = rstdl[qi];
            unsigned short* yp = Y + (size_t)(tq_blk + qi) * D + 512 + w * 64 + q;
            yp[0] = (unsigned short)f2bf(bfl(yp[0]) * rs * g0); yp[32] = (unsigned short)f2bf(bfl(yp[32]) * rs * g1);
        }
    BSYNC();
}

__device__ __forceinline__ void ins16(float (&l)[16], float x) {
#pragma unroll
    for (int i = 0; i < 16; ++i) { const float t = fmaxf(l[i], x); x = fminf(l[i], x); l[i] = t; }
}
__device__ __forceinline__ void topk_half(float* S, float* lists, int trow0, int hd, int* IDX, float* GATE) {
    const int tid = TID, row = tid & 127, grp = (tid >> 7) & 1, half = tid >> 8;
    float l[16];
#pragma unroll
    for (int i = 0; i < 16; ++i) l[i] = -3.0e38f;
    const float* src = S + row * 260 + grp * 128 + half * 64;
    for (int c = 0; c < 64; c += 4) {
        const f32x4 v = *(const f32x4*)(src + c);
#pragma unroll
        for (int i = 0; i < 4; ++i) { const unsigned nidx = (unsigned)(half * 64 + c + i); const float sv = v[i]; const float key = __builtin_bit_cast(float, (__builtin_bit_cast(unsigned, sv) & ~127u) | (127u - nidx)); ins16(l, key); }
    }
    float* slot = lists + (row * 2 + grp) * 16;
    if (half == 1) {
#pragma unroll
        for (int i = 0; i < 16; ++i) slot[i] = l[i];
    }
    BSYNC();
    if (half == 0) {
#pragma unroll
        for (int i = 0; i < 16; ++i) ins16(l, slot[i]);
        if (grp == 1) {
#pragma unroll
            for (int i = 0; i < 16; ++i) slot[i] = l[i];
        }
    }
    BSYNC();
    if (tid < 128) {
        const float* bl = lists + (row * 2 + 1) * 16;
        float bs[16];
#pragma unroll
        for (int i = 0; i < 16; ++i) bs[i] = bl[i];
        float c16[16];
#pragma unroll
        for (int i = 0; i < 16; ++i) c16[i] = -3.0e38f;
#pragma unroll
        for (int i = 0; i < 16; ++i) {
            const int jmax = 16 / (i + 1);
            const float ai = __builtin_bit_cast(float, __builtin_bit_cast(unsigned, l[i]) & ~127u);
#pragma unroll
            for (int j = 0; j < 16; ++j) if (j < jmax) {
                const float bj = __builtin_bit_cast(float, __builtin_bit_cast(unsigned, bs[j]) & ~127u);
                const float sm = ai + bj;
                ins16(c16, __builtin_bit_cast(float, (__builtin_bit_cast(unsigned, sm) & ~255u) | (unsigned)(i * 16 + j)));
            }
        }
        float ev[16]; float den = 0.f;
        const float mx = __builtin_bit_cast(float, __builtin_bit_cast(unsigned, c16[0]) & ~255u);
#pragma unroll
        for (int k = 0; k < 16; ++k) { const float sv = __builtin_bit_cast(float, __builtin_bit_cast(unsigned, c16[k]) & ~255u); ev[k] = expf(sv - mx); den += ev[k]; }
        const float inv = 1.f / den;
        int* ip = IDX + (size_t)(trow0 + row) * 128 + hd * 16; float* gp = GATE + (size_t)(trow0 + row) * 128 + hd * 16;
#pragma unroll
        for (int k = 0; k < 16; ++k) {
            const unsigned code = __builtin_bit_cast(unsigned, c16[k]) & 255u; const int ci = (int)(code >> 4), cj = (int)(code & 15u);
            unsigned abits = 0u, bbits = 0u;
#pragma unroll
            for (int i = 0; i < 16; ++i) { abits = (ci == i) ? __builtin_bit_cast(unsigned, l[i]) : abits; bbits = (cj == i) ? __builtin_bit_cast(unsigned, bs[i]) : bbits; }
            const int ia = 127 - (int)(abits & 127u), ib = 127 - (int)(bbits & 127u);
            ip[k] = ia * 128 + ib; gp[k] = ev[k] * inv;
        }
    }
    BSYNC();
}

__device__ __forceinline__ float gelu_erf(float v) { return 0.5f * v * (1.f + erff(v * 0.70710678118654752f)); }
__device__ __forceinline__ void cvt16_fp8(const u32x4 w, float (&f)[16]) {
#pragma unroll
    for (int q = 0; q < 4; ++q) { const unsigned ww = w[q]; const f32x2 a = cvt_pk_f32_fp8(ww, false), b = cvt_pk_f32_fp8(ww, true); f[4 * q] = a.x; f[4 * q + 1] = a.y; f[4 * q + 2] = b.x; f[4 * q + 3] = b.y; }
}
__device__ __forceinline__ float reduce4(const float (&d)[4], int lane) {
    const bool b5 = (lane & 32) != 0, b4 = (lane & 16) != 0;
    float r[2];
#pragma unroll
    for (int i = 0; i < 2; ++i) { const float x = b5 ? d[2 + i] : d[i], y = b5 ? d[i] : d[2 + i]; r[i] = x + xor32_f(y, lane); }
    const float t = (b4 ? r[1] : r[0]) + xor16_f(b4 ? r[0] : r[1], lane);
    return row_sum(t);
}
__device__ __forceinline__ void peer_phase(const Params& p, int gw, int ngw, float* OUT) {
    const int lane = TID & 63;
    const unsigned char* U8 = p.ws + WS_U8; const unsigned char* V8 = p.ws + WS_V8;
    const float* USC = (const float*)(p.ws + WS_USC); const float* VSC = (const float*)(p.ws + WS_VSC);
    const int* IDX = (const int*)(p.ws + WS_IDX); const float* GATE = (const float*)(p.ws + WS_GATE);
    float* X1 = p.out;
    float g2f[16];
#pragma unroll
    for (int j = 0; j < 4; ++j) { const f32x4 gv = *(const f32x4*)(p.ln2_g + 16 * lane + 4 * j); g2f[4 * j] = gv[0]; g2f[4 * j + 1] = gv[1]; g2f[4 * j + 2] = gv[2]; g2f[4 * j + 3] = gv[3]; }
#define PEER_LOAD(UA, VA, bb) do { _Pragma("unroll") for (int u = 0; u < 4; ++u) { const int k = 4 * (bb) + u; const int e = rdlane_i(k < 64 ? myi0 : myi1, k & 63); \
        UA[u] = *(const u32x4*)(U8 + (size_t)e * D + 16 * lane); VA[u] = *(const u32x4*)(V8 + (size_t)e * D + 16 * lane); } } while (0)
#define PEER_COMPUTE(UA, VA, bb) do { float dd[4]; \
        _Pragma("unroll") for (int u = 0; u < 4; ++u) { float uf[16]; cvt16_fp8(UA[u], uf); float d = 0.f; _Pragma("unroll") for (int i = 0; i < 16; ++i) d += hf[i] * uf[i]; dd[u] = d; } \
        const float dsum = reduce4(dd, lane); \
        float usc, cf; { const int k0 = 4 * (bb); const float su = k0 < 64 ? myu0 : myu1, sc = k0 < 64 ? myc0 : myc1; const int l0 = k0 & 63, sel = lane >> 4; \
            const float u0 = rdlane_f(su, l0), u1 = rdlane_f(su, l0 + 1), u2 = rdlane_f(su, l0 + 2), u3 = rdlane_f(su, l0 + 3); const float c0 = rdlane_f(sc, l0), c1 = rdlane_f(sc, l0 + 1), c2 = rdlane_f(sc, l0 + 2), c3 = rdlane_f(sc, l0 + 3); \
            usc = sel == 0 ? u0 : (sel == 1 ? u1 : (sel == 2 ? u2 : u3)); cf = sel == 0 ? c0 : (sel == 1 ? c1 : (sel == 2 ? c2 : c3)); } \
        const float av = gelu_erf(dsum * usc) * cf; \
        _Pragma("unroll") for (int u = 0; u < 4; ++u) { const float au = rdlane_f(av, 16 * u); float vf[16]; cvt16_fp8(VA[u], vf); _Pragma("unroll") for (int i = 0; i < 16; ++i) acc[i] += au * vf[i]; } } while (0)
    for (int t = gw; t < T; t += ngw) {
        float hf[16];
        {
            const float* xr0 = X1 + (size_t)t * D + 16 * lane; float sq = 0.f;
#pragma unroll
            for (int j = 0; j < 4; ++j) { const f32x4 xv = *(const f32x4*)(xr0 + 4 * j);
#pragma unroll
                for (int i = 0; i < 4; ++i) { hf[4 * j + i] = xv[i]; sq += xv[i] * xv[i]; } }
            const float rs2 = 1.0f / sqrtf(wave_sum(sq) * (1.f / D) + RMS_EPS);
#pragma unroll
            for (int i = 0; i < 16; ++i) hf[i] *= rs2 * g2f[i];
        }
        const int myi0 = IDX[(size_t)t * 128 + lane], myi1 = IDX[(size_t)t * 128 + 64 + lane];
        const float myu0 = USC[myi0], myu1 = USC[myi1];
        const float myc0 = GATE[(size_t)t * 128 + lane] * VSC[myi0], myc1 = GATE[(size_t)t * 128 + 64 + lane] * VSC[myi1];
        float acc[16];
#pragma unroll
        for (int i = 0; i < 16; ++i) acc[i] = 0.f;
        u32x4 ua[4], va[4], ub[4], vb[4];
        PEER_LOAD(ua, va, 0);
#pragma unroll 1
        for (int b = 0; b < 32; b += 2) {
            PEER_LOAD(ub, vb, b + 1);
            PEER_COMPUTE(ua, va, b);
            if (b + 2 < 32) PEER_LOAD(ua, va, b + 2);
            PEER_COMPUTE(ub, vb, b + 1);
        }
        float* xr = X1 + (size_t)t * D + 16 * lane;
        float ssq = 0.f; f32x4 xv[4];
#pragma unroll
        for (int j = 0; j < 4; ++j) { xv[j] = *(const f32x4*)(xr + 4 * j);
#pragma unroll
            for (int i = 0; i < 4; ++i) { xv[j][i] += acc[4 * j + i]; ssq += xv[j][i] * xv[j][i]; } }
        const float rstd = 1.0f / sqrtf(wave_sum(ssq) * (1.f / D) + RMS_EPS);
#pragma unroll
        for (int j = 0; j < 4; ++j) { const f32x4 gg = *(const f32x4*)(p.lnf_g + 16 * lane + 4 * j); f32x4 o;
#pragma unroll
            for (int i = 0; i < 4; ++i) o[i] = xv[j][i] * rstd * gg[i];
            *(f32x4*)(OUT + (size_t)t * D + 16 * lane + 4 * j) = o; }
    }
#undef PEER_LOAD
#undef PEER_COMPUTE
}

#ifndef EMU
namespace pg8 {
#define PG8_LAS __attribute__((address_space(3)))
typedef unsigned short bf16_t;
typedef short bf16x8 __attribute__((ext_vector_type(8)));
typedef float f32x4 __attribute__((ext_vector_type(4)));
typedef unsigned u32x4 __attribute__((ext_vector_type(4)));
constexpr int BM = 256, BK = 64, HALF = 128, HTB = HALF * BK * 2  , STAGE_BYTES = 8 * HTB, NXCD = 8, WGM = 8;

__host__ __device__ __forceinline__ int lds_byte(int r, int c) { const int st = (r >> 4) * 2 + (c >> 5), rr = r & 15, cc = c & 31, ob = rr * 64 + cc * 2; return st * 1024 + (ob ^ (((ob >> 9) & 1) << 5)); }
__host__ __device__ __forceinline__ void stage_rc(int b, int& R, int& C) { const int st = b / 1024, sb = b % 1024, swz = sb ^ (((sb >> 9) & 1) << 5); R = (st >> 1) * 16 + swz / 64; C = (st & 1) * 32 + (swz % 64) / 2; }
__host__ __device__ __forceinline__ int perm32(int rho) { const int n = rho >> 4, i = rho & 15; return 8 * (i >> 2) + 4 * n + (i & 3); }

struct Unit { int pm, pn; };
struct Gemm { const bf16_t* A; const bf16_t* Bt; int M, N, K; };

struct StaticOrder {
    int nM, nN, nwg, G, c;
    __host__ __device__ void init(int M, int N, int G_, int c_) { nM = M / BM; nN = N / BM; nwg = nM * nN; G = G_; c = c_; }
    __host__ __device__ bool next(int i, Unit& u) const {
        const long L = (long)i * G + c; if (L >= nwg) return false;
        int wgid = (int)L; { const int q = nwg / NXCD, r = nwg % NXCD, xcd = wgid % NXCD, off = wgid / NXCD; wgid = (xcd < r ? xcd * (q + 1) : r * (q + 1) + (xcd - r) * q) + off; }
        const int nig = WGM * nN, gid = wgid / nig, fm = gid * WGM, gsz = (nM - fm) < WGM ? (nM - fm) : WGM;
        u.pm = fm + ((wgid % nig) % gsz); u.pn = (wgid % nig) / gsz; return true;
    }
    __device__ __forceinline__ void a_ready(const Unit&) const {}
    __device__ __forceinline__ void done(const Unit&) const {}
};

__device__ __forceinline__ unsigned cvt_pk_bf16(float lo, float hi) { unsigned r; asm volatile("v_cvt_pk_bf16_f32 %0, %1, %2" : "=v"(r) : "v"(lo), "v"(hi)); return r; }
typedef float f32x2 __attribute__((ext_vector_type(2)));
__device__ __forceinline__ f32x2 gelu_pk(f32x2 v) {
    const f32x2 av = __builtin_elementwise_abs(v), d = av * 0.2316418882f + 1.0f;
    f32x2 t; t.x = __builtin_amdgcn_rcpf(d.x); t.y = __builtin_amdgcn_rcpf(d.y);
    f32x2 q = t * 0.5307027145f + (-0.7265760135f); q = q * t + 0.7107068705f; q = q * t + (-0.142248368f); q = q * t + 0.127414796f; q = q * t;
    const f32x2 s = (v * v) * (-0.72134752044f);
    f32x2 e; e.x = __builtin_amdgcn_exp2f(s.x); e.y = __builtin_amdgcn_exp2f(s.y);
    const f32x2 m = v * (q * e), r = v - m;
    f32x2 o; o.x = v.x < 0.f ? m.x : r.x; o.y = v.y < 0.f ? m.y : r.y; return o;
}

template <int ACT  > struct EpiBf16 {
    static constexpr bool PERM = true, AFTER_DRAIN = false; static_assert(ACT == 0 || ACT == 1, "EpiBf16: ACT is 0 (none) or 1 (gelu_pk)");
    bf16_t* O; int ldc; const float* bias; int split_cols; size_t split_stride; float scale0;
    __device__ __forceinline__ void operator()(const f32x4 (&acc)[2][2][4][2], const Unit& u, int wr, int wc, int fr, int fq) const {
        const int row0 = u.pm * BM + wr * 64 + fr; int colt = u.pn * BM; bf16_t* base = O;
        float sc = 1.f; if (split_cols) { const int t = colt / split_cols; base += (size_t)t * split_stride; colt -= t * split_cols; if (t == 0) sc = scale0; }
        const int col0 = colt + wc * 32 + 8 * fq, bcol0 = u.pn * BM + wc * 32 + 8 * fq;
        f32x4 bv[2][2];
#pragma unroll
        for (int bj = 0; bj < 2; ++bj)
#pragma unroll
            for (int n = 0; n < 2; ++n) bv[bj][n] = bias ? *(const f32x4*)(bias + bcol0 + bj * HALF + 4 * n) : (f32x4){0.f, 0.f, 0.f, 0.f};
#pragma unroll
        for (int ai = 0; ai < 2; ++ai)
#pragma unroll
            for (int m = 0; m < 4; ++m) { bf16_t* rowp = base + (size_t)(row0 + ai * HALF + m * 16) * ldc + col0;
#pragma unroll
                for (int bj = 0; bj < 2; ++bj) { f32x4 v0 = acc[ai][bj][m][0] + bv[bj][0], v1 = acc[ai][bj][m][1] + bv[bj][1];
                    if (ACT == 1) { f32x2 a = gelu_pk((f32x2){v0[0], v0[1]}), b = gelu_pk((f32x2){v0[2], v0[3]}), c = gelu_pk((f32x2){v1[0], v1[1]}), d = gelu_pk((f32x2){v1[2], v1[3]});
                        v0 = (f32x4){a.x, a.y, b.x, b.y}; v1 = (f32x4){c.x, c.y, d.x, d.y}; }
                    v0 = v0 * sc; v1 = v1 * sc; u32x4 w; w.x = cvt_pk_bf16(v0[0], v0[1]); w.y = cvt_pk_bf16(v0[2], v0[3]); w.z = cvt_pk_bf16(v1[0], v1[1]); w.w = cvt_pk_bf16(v1[2], v1[3]);
                    *(u32x4*)(rowp + bj * HALF) = w; } }
    }
};
template <class Epi, class Sched, bool ALIGN_EPI = false, bool SP2 = false>
__device__ __forceinline__ void gemm_phase(PG8_LAS unsigned char* lds, const Gemm g, const Sched& S, const Epi& E) {
    int tid = threadIdx.x; asm volatile("" : "+v"(tid));
    const int wid = __builtin_amdgcn_readfirstlane(tid >> 6), lane = tid & 63, wr = wid >> 2, wc = wid & 3, fr = lane & 15, fq = lane >> 4;
    const int K = g.K, nt = K / BK;
    unsigned voffA[2], voffB[2];
#pragma unroll
    for (int i = 0; i < 2; ++i) { int R, C; stage_rc(tid * 16 + i * 8192, R, C); const int Rb = Epi::PERM ? ((R & ~31) + perm32(R & 31)) : R;
        voffA[i] = (unsigned)(R * K + C) * 2u; voffB[i] = (unsigned)(Rb * K + C) * 2u; }
    const size_t kstep = (size_t)(BK * 2);
    const size_t hstep = (size_t)HALF * K * 2;
    const size_t tstep = 2 * hstep;
    const unsigned ldsw = (unsigned)wid * 1024u;
    const int aoff = lds_byte(wr * 64 + fr, fq * 8), boff = lds_byte(wc * 32 + fr, fq * 8);
#define PG8_SA(b, h) (((b) * 2 + (h)) * HTB)
#define PG8_SB(b, h) ((4 + (b) * 2 + (h)) * HTB)
#define PG8_STAGE(bufoff, gbase, voff) do { _Pragma("unroll") for (int _i = 0; _i < 2; ++_i) \
        __builtin_amdgcn_global_load_lds((const unsigned*)((const char*)(gbase) + (voff)[_i]), (PG8_LAS unsigned*)(lds + (bufoff) + ldsw + _i * 8192), 16, 0, 0); } while (0)
#define PG8_LDA(dst, b, h) do { _Pragma("unroll") for (int m = 0; m < 4; ++m) _Pragma("unroll") for (int k = 0; k < 2; ++k) dst[m][k] = *(const PG8_LAS bf16x8*)(lds + PG8_SA(b, h) + aoff + m * 2048 + k * 1024); } while (0)
#define PG8_LDB(dst, b, h) do { _Pragma("unroll") for (int n = 0; n < 2; ++n) _Pragma("unroll") for (int k = 0; k < 2; ++k) dst[n][k] = *(const PG8_LAS bf16x8*)(lds + PG8_SB(b, h) + boff + n * 2048 + k * 1024); } while (0)
#define PG8_MMA(ai, bj, At, Bt) do { __builtin_amdgcn_s_setprio(1); _Pragma("unroll") for (int m = 0; m < 4; ++m) _Pragma("unroll") for (int n = 0; n < 2; ++n) _Pragma("unroll") for (int k = 0; k < 2; ++k) \
        acc[ai][bj][m][n] = __builtin_amdgcn_mfma_f32_16x16x32_bf16(Bt[n][k], At[m][k], acc[ai][bj][m][n], 0, 0, 0); __builtin_amdgcn_s_setprio(0); } while (0)
#define PG8_WAIT_V(n) asm volatile("s_waitcnt vmcnt(" #n ")" ::: "memory")
#define PG8_WAIT_L(n) asm volatile("s_waitcnt lgkmcnt(" #n ")" ::: "memory")
#define PG8_BAR __builtin_amdgcn_s_barrier()
#define PG8_SCHED __builtin_amdgcn_sched_barrier(0)
    Unit cur, nxt; int ui = 0;
    if (!S.next(0, cur)) return;
    f32x4 acc[2][2][4][2];
#pragma unroll
    for (int a = 0; a < 2; ++a)
#pragma unroll
        for (int b = 0; b < 2; ++b)
#pragma unroll
            for (int m = 0; m < 4; ++m)
#pragma unroll
                for (int n = 0; n < 2; ++n) acc[a][b][m][n] = (f32x4){0.f, 0.f, 0.f, 0.f};
    bf16x8 At[4][2], B0[2][2], B1[2][2];
    const char* cA = (const char*)g.A + (size_t)cur.pm * tstep; const char* cB = (const char*)g.Bt + (size_t)cur.pn * tstep;
    S.a_ready(cur);
    if constexpr (SP2) {
        PG8_STAGE(PG8_SB(0, 0), cB, voffB); PG8_STAGE(PG8_SB(0, 1), cB + hstep, voffB); PG8_STAGE(PG8_SA(0, 0), cA, voffA); PG8_STAGE(PG8_SA(0, 1), cA + hstep, voffA);
        if (wr == 1) PG8_BAR;
        PG8_WAIT_V(2); PG8_BAR;
        PG8_STAGE(PG8_SB(1, 0), cB + kstep, voffB); PG8_STAGE(PG8_SA(1, 0), cA + kstep, voffA); PG8_STAGE(PG8_SB(1, 1), cB + hstep + kstep, voffB);
        PG8_WAIT_V(6); PG8_BAR;
    } else {
        PG8_STAGE(PG8_SB(0, 0), cB, voffB); PG8_STAGE(PG8_SA(0, 0), cA, voffA); PG8_STAGE(PG8_SB(0, 1), cB + hstep, voffB); PG8_STAGE(PG8_SA(0, 1), cA + hstep, voffA);
        if (wr == 1) PG8_BAR;
        PG8_WAIT_V(4); PG8_BAR;
        PG8_STAGE(PG8_SB(1, 0), cB + kstep, voffB); PG8_STAGE(PG8_SA(1, 0), cA + kstep, voffA); PG8_STAGE(PG8_SB(1, 1), cB + hstep + kstep, voffB);
        PG8_WAIT_V(6); PG8_BAR;
    }
    for (;;) {
        const bool has_next = S.next(ui + 1, nxt);
        const char* nA = has_next ? (const char*)g.A + (size_t)nxt.pm * tstep : cA; const char* nB = has_next ? (const char*)g.Bt + (size_t)nxt.pn * tstep : cB;
        for (int t = 0; t < nt; t += 2) {
            const bool last = (t == nt - 2);
            const char* a1 = cA + (size_t)(t + 1) * kstep;
            const char* a2 = last ? nA : cA + (size_t)(t + 2) * kstep; const char* b2 = last ? nB : cB + (size_t)(t + 2) * kstep;
            const char* a3 = a2 + kstep; const char* b3 = b2 + kstep;
            if (last && has_next) S.a_ready(nxt);
            if constexpr (SP2) {
            PG8_LDB(B0, 0, 0); PG8_LDB(B1, 0, 1); PG8_SCHED; PG8_LDA(At, 0, 0); PG8_STAGE(PG8_SA(1, 1), a1 + hstep, voffA);
            PG8_WAIT_V(8); PG8_WAIT_L(0); PG8_BAR; PG8_MMA(0, 0, At, B0); PG8_MMA(0, 1, At, B1); PG8_BAR; PG8_SCHED;
            PG8_LDA(At, 0, 1); PG8_STAGE(PG8_SB(0, 0), b2, voffB); PG8_STAGE(PG8_SB(0, 1), b2 + hstep, voffB); PG8_STAGE(PG8_SA(0, 0), a2, voffA);
            PG8_WAIT_V(8); PG8_WAIT_L(0); PG8_BAR; PG8_MMA(1, 0, At, B0); PG8_MMA(1, 1, At, B1); PG8_BAR; PG8_SCHED;
            PG8_LDB(B0, 1, 0); PG8_LDB(B1, 1, 1); PG8_SCHED; PG8_LDA(At, 1, 0); PG8_STAGE(PG8_SA(0, 1), a2 + hstep, voffA);
            PG8_WAIT_V(8); PG8_WAIT_L(0); PG8_BAR; PG8_MMA(0, 0, At, B0); PG8_MMA(0, 1, At, B1); PG8_BAR; PG8_SCHED;
            PG8_LDA(At, 1, 1); PG8_STAGE(PG8_SB(1, 0), b3, voffB); PG8_STAGE(PG8_SB(1, 1), b3 + hstep, voffB); PG8_STAGE(PG8_SA(1, 0), a3, voffA);
            PG8_WAIT_V(8); PG8_WAIT_L(0); PG8_BAR; PG8_MMA(1, 0, At, B0); PG8_MMA(1, 1, At, B1); PG8_BAR; PG8_SCHED;
            } else {
            PG8_LDB(B0, 0, 0); PG8_SCHED; PG8_LDA(At, 0, 0); PG8_STAGE(PG8_SA(1, 1), a1 + hstep, voffA);
            PG8_WAIT_L(8); PG8_BAR; PG8_WAIT_L(0); PG8_MMA(0, 0, At, B0); PG8_BAR; PG8_SCHED;
            PG8_LDB(B1, 0, 1); PG8_STAGE(PG8_SB(0, 0), b2, voffB);
            PG8_BAR; PG8_WAIT_L(0); PG8_MMA(0, 1, At, B1); PG8_BAR;
            PG8_LDA(At, 0, 1); PG8_STAGE(PG8_SA(0, 0), a2, voffA);
            PG8_BAR; PG8_WAIT_L(0); PG8_MMA(1, 0, At, B0); PG8_BAR; PG8_SCHED;
            PG8_STAGE(PG8_SB(0, 1), b2 + hstep, voffB);
            PG8_WAIT_V(6); PG8_BAR; PG8_MMA(1, 1, At, B1); PG8_BAR;
            PG8_LDB(B0, 1, 0); PG8_SCHED; PG8_LDA(At, 1, 0); PG8_STAGE(PG8_SA(0, 1), a2 + hstep, voffA);
            PG8_WAIT_L(8); PG8_BAR; PG8_WAIT_L(0); PG8_MMA(0, 0, At, B0); PG8_BAR; PG8_SCHED;
            PG8_LDB(B1, 1, 1); PG8_STAGE(PG8_SB(1, 0), b3, voffB);
            PG8_BAR; PG8_WAIT_L(0); PG8_MMA(0, 1, At, B1); PG8_BAR;
            PG8_LDA(At, 1, 1); PG8_STAGE(PG8_SA(1, 0), a3, voffA);
            PG8_BAR; PG8_WAIT_L(0); PG8_MMA(1, 0, At, B0); PG8_BAR; PG8_SCHED;
            PG8_STAGE(PG8_SB(1, 1), b3 + hstep, voffB);
            PG8_WAIT_V(6); PG8_BAR; PG8_MMA(1, 1, At, B1); PG8_BAR;
            }
        }
        if constexpr (ALIGN_EPI) { if (wr == 0) PG8_BAR; }
        if constexpr (!Epi::AFTER_DRAIN) { E(acc, cur, wr, wc, fr, fq); S.done(cur); }
        if (!has_next) break;
#pragma unroll
        for (int a = 0; a < 2; ++a)
#pragma unroll
            for (int b = 0; b < 2; ++b)
#pragma unroll
                for (int m = 0; m < 4; ++m)
#pragma unroll
                    for (int n = 0; n < 2; ++n) acc[a][b][m][n] = (f32x4){0.f, 0.f, 0.f, 0.f};
        cur = nxt; cA = nA; cB = nB; ++ui;
        if constexpr (ALIGN_EPI) { if (wr == 1) PG8_BAR; }
    }
    PG8_WAIT_V(0);
    if constexpr (!ALIGN_EPI) { if (wr == 0) PG8_BAR; }
    PG8_BAR;
    if constexpr (Epi::AFTER_DRAIN) { E.fused(acc, cur, wr, wc, fr, fq, lds, wid, lane); S.done(cur); }
#undef PG8_SA
#undef PG8_SB
#undef PG8_STAGE
#undef PG8_LDA
#undef PG8_LDB
#undef PG8_MMA
#undef PG8_WAIT_V
#undef PG8_WAIT_L
#undef PG8_BAR
#undef PG8_SCHED
}
}

struct OneUnit {
    pg8::Unit u;
    __device__ __forceinline__ bool next(int i, pg8::Unit& o) const { if (i) return false; o = u; return true; }
    __device__ __forceinline__ void a_ready(const pg8::Unit&) const {}
    __device__ __forceinline__ void done(const pg8::Unit&) const {}
};
struct EpiResF32 {
    static constexpr bool PERM = false, AFTER_DRAIN = false;
    const float* base; float* out; pg8::bf16_t* xb; float* ssq;
    __device__ __forceinline__ void operator()(const pg8::f32x4 (&acc)[2][2][4][2], const pg8::Unit& u, int wr, int wc, int fr, int fq) const {
#pragma unroll
        for (int ai = 0; ai < 2; ++ai)
#pragma unroll
            for (int m = 0; m < 4; ++m) {
                const size_t row = (size_t)u.pm * 256 + ai * 128 + wr * 64 + m * 16 + fr;
                float sq = 0.f;
#pragma unroll
                for (int bj = 0; bj < 2; ++bj)
#pragma unroll
                    for (int n = 0; n < 2; ++n) {
                        const size_t off = row * D + u.pn * 256 + bj * 128 + wc * 32 + n * 16 + 4 * fq;
                        const pg8::f32x4 b = *(const pg8::f32x4*)(base + off);
                        const pg8::f32x4 v = b + acc[ai][bj][m][n];
                        *(pg8::f32x4*)(out + off) = v;
                        u32x2 w; w.x = pk2(v[0], v[1]); w.y = pk2(v[2], v[3]); *(u32x2*)(xb + off) = w;
                        sq += (v[0] * v[0] + v[1] * v[1]) + (v[2] * v[2] + v[3] * v[3]);
                    }
                sq += __shfl_xor(sq, 16); sq += __shfl_xor(sq, 32);
                if (fq == 0) ssq[row * 16 + u.pn * 4 + wc] = sq;
            }
    }
};
struct EpiTopK {
    static constexpr bool PERM = false, AFTER_DRAIN = true;
    int* IDX; float* GATE; const float* ssq;
    __device__ __forceinline__ void fused(pg8::f32x4 (&acc)[2][2][4][2], const pg8::Unit& u, int wr, int wc, int fr, int fq, PG8_LAS unsigned char* lds, int wid, int lane) const {
        float* S = (float*)lds; float* lists = S + 128 * 260; float* rs = lists + 128 * 2 * 16;
        if (threadIdx.x < 256) {
            const pg8::f32x4* sp = (const pg8::f32x4*)(ssq + ((size_t)u.pm * 256 + threadIdx.x) * 16);
            const pg8::f32x4 a = sp[0], b = sp[1], c = sp[2], d = sp[3];
            const float tot = ((a[0] + a[1]) + (a[2] + a[3])) + ((b[0] + b[1]) + (b[2] + b[3])) + ((c[0] + c[1]) + (c[2] + c[3])) + ((d[0] + d[1]) + (d[2] + d[3]));
            rs[threadIdx.x] = 1.0f / sqrtf(tot * (1.f / D) + RMS_EPS);
        }
        __syncthreads();
#pragma unroll
        for (int ai = 0; ai < 2; ++ai) {
#pragma unroll
            for (int m = 0; m < 4; ++m) {
                const float r = rs[ai * 128 + wr * 64 + m * 16 + fr];
#pragma unroll
                for (int bj = 0; bj < 2; ++bj)
#pragma unroll
                    for (int n = 0; n < 2; ++n) *(pg8::f32x4*)(S + (wr * 64 + m * 16 + fr) * 260 + bj * 128 + wc * 32 + n * 16 + 4 * fq) = acc[ai][bj][m][n] * r;
            }
            __syncthreads();
            topk_half(S, lists, u.pm * 256 + ai * 128, u.pn, IDX, GATE);
        }
    }
};

#ifndef PHM
#define PHM 255
#endif
#ifndef DUP
#define DUP 0
#endif
constexpr int LDS_BYTES = 155648;
__global__ void __launch_bounds__(NTHR, 2) fwd_kernel(Params p) {
    extern __shared__ __attribute__((aligned(16))) unsigned char lds[];
    cg::grid_group grid = cg::this_grid();
    const int bid = blockIdx.x, nblk = gridDim.x;
    unsigned char* ws = p.ws;
#if PHM & 1
    p0_prologue(p, bid, nblk, (char*)lds);
#endif
    grid.sync();
#if PHM & 2
    {
        pg8::Gemm g{(const pg8::bf16_t*)(ws + WS_H), (const pg8::bf16_t*)(ws + WS_WINT), T, PCOLS, D};
        pg8::StaticOrder S; S.init(T, PCOLS, nblk, bid);
        pg8::EpiBf16<0> E{(pg8::bf16_t*)(ws + WS_P), PCOLS, (const float*)(ws + WS_BIASP), 0, 0, 1.f};
        pg8::gemm_phase<pg8::EpiBf16<0>, pg8::StaticOrder, true, true>((PG8_LAS unsigned char*)lds, g, S, E);
    }
#endif
    grid.sync();
#if PHM & 4
#if DUP & 4
    for (int u = bid; u < BATCH * 8; u += nblk) rwkv_unit(p, u >> 3, u & 7, (char*)lds);
#endif
    for (int u = bid; u < BATCH * 8; u += nblk) rwkv_unit(p, u >> 3, u & 7, (char*)lds);
#endif
#if PHM & 8
    for (int u = bid; u < BATCH * (SEQ / 128); u += nblk) attn_unit(p, u / (SEQ / 128), u % (SEQ / 128), (char*)lds);
#endif
    grid.sync();
#if PHM & 16
    {
        pg8::Gemm g{(const pg8::bf16_t*)(ws + WS_Y), (const pg8::bf16_t*)(ws + WS_WOUTT), T, D, D};
        pg8::StaticOrder S; S.init(T, D, nblk, bid);
        EpiResF32 E{p.x, p.out, (pg8::bf16_t*)(ws + WS_H), (float*)(ws + WS_SSQ)};
        pg8::gemm_phase<EpiResF32, pg8::StaticOrder, true, true>((PG8_LAS unsigned char*)lds, g, S, E);
    }
#endif
    grid.sync();
#if PHM & 64
    {
        pg8::Gemm g{(const pg8::bf16_t*)(ws + WS_H), (const pg8::bf16_t*)(ws + WS_WFT), T, 2048, D};
        pg8::StaticOrder S; S.init(T, 2048, nblk, bid);
        EpiTopK E{(int*)(ws + WS_IDX), (float*)(ws + WS_GATE), (const float*)(ws + WS_SSQ)};
        OneUnit one;
        for (int i = 0; S.next(i, one.u); ++i) pg8::gemm_phase<EpiTopK, OneUnit, false, true>((PG8_LAS unsigned char*)lds, g, one, E);
    }
#endif
    grid.sync();
#if PHM & 128
#if DUP & 128
    peer_phase(p, bid * (NTHR / 64) + (TID >> 6), nblk * (NTHR / 64), (float*)(ws + WS_P));
#endif
    peer_phase(p, bid * (NTHR / 64) + (TID >> 6), nblk * (NTHR / 64), p.out);
#endif
}

extern "C" void kernel_launch(void* const* d_in, const int* in_sizes, int n_in, void* d_out, int out_size, void* d_ws, size_t ws_size, hipStream_t stream) {
    static int grid = 0;
    if (grid == 0) {
        if (n_in != 24 || out_size != T * D || ws_size < WS_END) { fprintf(stderr, "kernel_launch: unexpected shapes (n_in %d, out %d, ws %zu < %zu)\n", n_in, out_size, ws_size, (size_t)WS_END); grid = -1; return; }
        int dev = 0, cus = 0, per_cu = 0;
        hipGetDevice(&dev);
        hipDeviceGetAttribute(&cus, hipDeviceAttributeMultiprocessorCount, dev);
        hipFuncSetAttribute((const void*)fwd_kernel, hipFuncAttributeMaxDynamicSharedMemorySize, LDS_BYTES);
        hipOccupancyMaxActiveBlocksPerMultiprocessor(&per_cu, (const void*)fwd_kernel, NTHR, LDS_BYTES);
        if (per_cu < 1) { fprintf(stderr, "kernel_launch: occupancy query says %d blocks per CU\n", per_cu); per_cu = 1; }
        if (per_cu > 1) per_cu = 1;
        grid = cus * per_cu;
        (void)hipGetLastError();
    }
    if (grid < 0) return;
    Params p{};
    const float** pp = (const float**)&p;
    for (int i = 0; i < 24; ++i) pp[i] = (const float*)d_in[i];
    p.out = (float*)d_out; p.ws = (unsigned char*)d_ws;
    void* args[] = {&p};
    hipError_t e = hipLaunchCooperativeKernel((const void*)fwd_kernel, dim3(grid), dim3(NTHR), args, LDS_BYTES, stream);
    if (e != hipSuccess) fprintf(stderr, "cooperative launch failed: %s (grid %d)\n", hipGetErrorString(e), grid);
}
#endif
```

```cpp
#ifndef EMU
#include <hip/hip_runtime.h>
#include <hip/hip_cooperative_groups.h>
#include <cstdio>
#include <cstdint>
namespace cg = cooperative_groups;
typedef short bf16x8 __attribute__((ext_vector_type(8)));
typedef short bf16x4 __attribute__((ext_vector_type(4)));
typedef float f32x16 __attribute__((ext_vector_type(16)));
typedef float f32x4 __attribute__((ext_vector_type(4)));
typedef float f32x2 __attribute__((ext_vector_type(2)));
typedef unsigned u32x4 __attribute__((ext_vector_type(4)));
typedef unsigned u32x2 __attribute__((ext_vector_type(2)));
#define TID ((int)threadIdx.x)
#define BSYNC() __syncthreads()
#define WSYNC() __builtin_amdgcn_wave_barrier()
#define OPAQUE(x) asm volatile("" : "+v"(x))
__device__ __forceinline__ float shfl_xor_f(float v, int m) { return __shfl_xor(v, m); }
__device__ __forceinline__ float shfl_f(float v, int s) { return __shfl(v, s); }
__device__ __forceinline__ int shfl_i(int v, int s) { return __shfl(v, s); }
__device__ __forceinline__ float rdlane_f(float v, int l) { return __builtin_bit_cast(float, __builtin_amdgcn_readlane(__builtin_bit_cast(int, v), l)); }
__device__ __forceinline__ int rdlane_i(int v, int l) { return __builtin_amdgcn_readlane(v, l); }
__device__ __forceinline__ f32x2 cvt_pk_f32_fp8(unsigned w, bool hi) { return hi ? __builtin_amdgcn_cvt_pk_f32_fp8((int)w, true) : __builtin_amdgcn_cvt_pk_f32_fp8((int)w, false); }
__device__ __forceinline__ unsigned cvt_pk_fp8_f32(float a, float b, unsigned old, bool hi) { return hi ? (unsigned)__builtin_amdgcn_cvt_pk_fp8_f32(a, b, (int)old, true) : (unsigned)__builtin_amdgcn_cvt_pk_fp8_f32(a, b, (int)old, false); }
template <int CTRL> __device__ __forceinline__ float dppf(float v) { return __builtin_bit_cast(float, __builtin_amdgcn_update_dpp(0, __builtin_bit_cast(int, v), CTRL, 0xF, 0xF, true)); }
__device__ __forceinline__ float row_sum(float v) { v += dppf<0xB1>(v); v += dppf<0x4E>(v); v += dppf<0x141>(v); v += dppf<0x140>(v); return v; }
__device__ __forceinline__ void swap16(float v, float& r0, float& r1) { unsigned a = __builtin_bit_cast(unsigned, v), b = a; asm volatile("" : "+v"(b)); auto rr = __builtin_amdgcn_permlane16_swap(a, b, false, false); const unsigned u0 = rr[0], u1 = rr[1]; r0 = __builtin_bit_cast(float, u0); r1 = __builtin_bit_cast(float, u1); }
__device__ __forceinline__ void swap32(float v, float& r0, float& r1) { unsigned a = __builtin_bit_cast(unsigned, v), b = a; asm volatile("" : "+v"(b)); auto rr = __builtin_amdgcn_permlane32_swap(a, b, false, false); const unsigned u0 = rr[0], u1 = rr[1]; r0 = __builtin_bit_cast(float, u0); r1 = __builtin_bit_cast(float, u1); }
__device__ __forceinline__ float xor16_f(float v, int lane) { float r0, r1; swap16(v, r0, r1); return (lane & 16) ? r0 : r1; }
__device__ __forceinline__ float xor32_f(float v, int lane) { float r0, r1; swap32(v, r0, r1); return (lane & 32) ? r0 : r1; }
__device__ __forceinline__ float half_sum(float v) { v = row_sum(v); float r0, r1; swap16(v, r0, r1); return r0 + r1; }
__device__ __forceinline__ float wave_sum(float v) { v = half_sum(v); float r0, r1; swap32(v, r0, r1); return r0 + r1; }
__device__ __forceinline__ float frcp(float x) { return __builtin_amdgcn_rcpf(x); }
__device__ __forceinline__ float frsq(float x) { return __builtin_amdgcn_rsqf(x); }
__device__ __forceinline__ f32x16 mfma32(bf16x8 a, bf16x8 b, f32x16 c) { return __builtin_amdgcn_mfma_f32_32x32x16_bf16(a, b, c, 0, 0, 0); }
__device__ __forceinline__ f32x4 mfma16(bf16x8 a, bf16x8 b, f32x4 c) { return __builtin_amdgcn_mfma_f32_16x16x32_bf16(a, b, c, 0, 0, 0); }
#else
#define WSYNC() emu_barrier(g_wave_bar[TID >> 6], 64)
#define OPAQUE(x)
#endif

#ifndef CFG_BATCH
#define CFG_BATCH 32
#endif
#ifndef CFG_SEQ
#define CFG_SEQ 2048
#endif
constexpr int D = 1024, BATCH = CFG_BATCH, SEQ = CFG_SEQ, T = BATCH * SEQ;
constexpr int NTHR = 512;
constexpr int PCOLS = 2560;
constexpr int PC_R = 0, PC_K = 512, PC_V = 1024, PC_Q = 1536, PC_AK = 2048, PC_AV = 2176, PC_LORA = 2304;
constexpr int NEXP = 16384;
constexpr float RMS_EPS = 1e-6f, LNX_EPS = 64e-5f;

constexpr size_t MiB = 1u << 20;
constexpr size_t al1m(size_t x) { return (x + MiB - 1) / MiB * MiB; }
constexpr size_t WS_CTL = 0;
constexpr size_t WS_BIASP = 1 * MiB;
constexpr size_t WS_WINT = 2 * MiB;
constexpr size_t WS_WOUTT = 7 * MiB;
constexpr size_t WS_WFT = 9 * MiB;
constexpr size_t WS_U8 = 16 * MiB;
constexpr size_t WS_V8 = 32 * MiB;
constexpr size_t WS_FRG = 50 * MiB;
constexpr size_t WS_SSQ = 52 * MiB;
constexpr size_t WS_USC = 48 * MiB;
constexpr size_t WS_VSC = 49 * MiB;
constexpr size_t WS_H = 80 * MiB;
constexpr size_t WS_Y = WS_H + al1m((size_t)T * D * 2);
constexpr size_t WS_P = WS_Y + al1m((size_t)T * D * 2);
constexpr size_t WS_IDX = WS_P + al1m((size_t)T * PCOLS * 2);
constexpr size_t WS_GATE = WS_IDX + al1m((size_t)T * 128 * 4);
constexpr size_t WS_END = WS_GATE + al1m((size_t)T * 128 * 4);

struct Params {
    const float* x; const float* ln1_g; const float* w_in; const float* b_attn; const float* mu_shift; const float* w0; const float* w_up; const float* a0;
    const float* a_up; const float* g_up; const float* k_k; const float* k_a; const float* r_k; const float* lnx_w; const float* lnx_b; const float* attn_sinks;
    const float* attn_norm_g; const float* w_out; const float* ln2_g; const float* peer_wq; const float* peer_subkeys; const float* peer_u; const float* peer_v; const float* lnf_g;
    float* out; unsigned char* ws;
};

#ifndef EMU
typedef __bf16 hwbf16x2 __attribute__((ext_vector_type(2)));
__device__ __forceinline__ unsigned f2bf(float f) { const __bf16 b = (__bf16)f; return (unsigned)__builtin_bit_cast(unsigned short, b); }
__device__ __forceinline__ unsigned pk2(float lo, float hi) { const f32x2 v = {lo, hi}; const hwbf16x2 b = __builtin_convertvector(v, hwbf16x2); return __builtin_bit_cast(unsigned, b); }
#else
__device__ __forceinline__ unsigned f2bf(float f) { unsigned u = __builtin_bit_cast(unsigned, f); return (u + 0x7fffu + ((u >> 16) & 1u)) >> 16; }
__device__ __forceinline__ unsigned pk2(float lo, float hi) { return f2bf(lo) | (f2bf(hi) << 16); }
#endif
__device__ __forceinline__ float bfl(unsigned short b) { return __builtin_bit_cast(float, (unsigned)b << 16); }
__device__ __forceinline__ float bf_lo(unsigned w) { return __builtin_bit_cast(float, w << 16); }
__device__ __forceinline__ float bf_hi(unsigned w) { return __builtin_bit_cast(float, w & 0xffff0000u); }
__device__ __forceinline__ int crow(int r, int hi) { return (r & 3) + 8 * (r >> 2) + 4 * hi; }
__device__ __forceinline__ int win_src_col(int n) { if (n < 1536) return n; if (n < 2304) return n + 160; if (n < 2464) return n - 768; return -1; }
__device__ __forceinline__ float sigmoidf_(float z) { return 1.f / (1.f + expf(-z)); }

__device__ __forceinline__ void p0_transpose_tile(const float* W, int K, int ldw, unsigned short* WT, int k0, int n0, int mode, float* tl) {
    const int t = TID, kk = t >> 6, nn = t & 63;
    const int sc = mode ? win_src_col(n0 + nn) : (n0 + nn);
#pragma unroll
    for (int i = 0; i < 8; ++i) { const int k = kk + 8 * i; tl[k * 65 + nn] = sc >= 0 ? W[(size_t)(k0 + k) * ldw + sc] : 0.f; }
    BSYNC();
    const int n = t >> 3, c = t & 7;
    u32x4 o;
    o.x = pk2(tl[(8 * c + 0) * 65 + n], tl[(8 * c + 1) * 65 + n]); o.y = pk2(tl[(8 * c + 2) * 65 + n], tl[(8 * c + 3) * 65 + n]);
    o.z = pk2(tl[(8 * c + 4) * 65 + n], tl[(8 * c + 5) * 65 + n]); o.w = pk2(tl[(8 * c + 6) * 65 + n], tl[(8 * c + 7) * 65 + n]);
    *(u32x4*)(WT + (size_t)(n0 + n) * K + k0 + 8 * c) = o;
    BSYNC();
}
__device__ __forceinline__ void p0_wfused_item(const float* wq, const float* sk, const float* g2, unsigned short* WfT, int hc, int kt, float* lds) {
    float* skl = lds;
    float* wql = lds + 128 * 129;
    for (int i = TID; i < 16384; i += NTHR) { const int n = i >> 7, d = i & 127; skl[n * 129 + d] = sk[(size_t)hc * 16384 + i]; }
    for (int i = TID; i < 64 * 128; i += NTHR) { const int k = i >> 7, d = i & 127; wql[d * 64 + k] = wq[(size_t)(kt * 64 + k) * 2048 + hc * 128 + d]; }
    BSYNC();
    const int n = TID & 127, kg = TID >> 7;
    float acc[16];
#pragma unroll
    for (int j = 0; j < 16; ++j) acc[j] = 0.f;
    for (int d = 0; d < 128; ++d) {
        const float a = skl[n * 129 + d]; const float* bp = wql + d * 64 + kg * 16;
#pragma unroll
        for (int j = 0; j < 16; ++j) acc[j] += a * bp[j];
    }
#pragma unroll
    for (int j = 0; j < 16; ++j) acc[j] *= g2[kt * 64 + kg * 16 + j];
    unsigned short* dst = WfT + (size_t)(hc * 128 + n) * D + kt * 64 + kg * 16;
    u32x4 o0, o1;
    o0.x = pk2(acc[0], acc[1]); o0.y = pk2(acc[2], acc[3]); o0.z = pk2(acc[4], acc[5]); o0.w = pk2(acc[6], acc[7]);
    o1.x = pk2(acc[8], acc[9]); o1.y = pk2(acc[10], acc[11]); o1.z = pk2(acc[12], acc[13]); o1.w = pk2(acc[14], acc[15]);
    *(u32x4*)dst = o0; *(u32x4*)(dst + 8) = o1;
    BSYNC();
}
__device__ __forceinline__ void rms_rows(const float* X, const float* g, unsigned short* H, int gw, int ngw) {
    const int lane = TID & 63;
    for (int m = gw; m < T; m += ngw) {
        const f32x4* xr = (const f32x4*)(X + (size_t)m * D) + lane; f32x4 v[4]; float s = 0.f;
#pragma unroll
        for (int j = 0; j < 4; ++j) { v[j] = xr[64 * j]; s += (v[j].x * v[j].x + v[j].y * v[j].y) + (v[j].z * v[j].z + v[j].w * v[j].w); }
        const float rstd = 1.0f / sqrtf(wave_sum(s) * (1.f / D) + RMS_EPS);
        u32x2* o8 = (u32x2*)(H + (size_t)m * D) + lane;
#pragma unroll
        for (int j = 0; j < 4; ++j) { const f32x4 gg = ((const f32x4*)g)[lane + 64 * j]; u32x2 w; w.x = pk2(v[j].x * rstd * gg.x, v[j].y * rstd * gg.y); w.y = pk2(v[j].z * rstd * gg.z, v[j].w * rstd * gg.w); o8[64 * j] = w; }
    }
}
__device__ __forceinline__ void p0_prologue(const Params& p, int bid, int nblk, char* smem) {
    float* lds = (float*)smem;
    unsigned char* ws = p.ws;
    unsigned short* WinT = (unsigned short*)(ws + WS_WINT); unsigned short* WoutT = (unsigned short*)(ws + WS_WOUTT); unsigned short* WfT = (unsigned short*)(ws + WS_WFT);
    constexpr int I_IN = 640, I_OUT = 256, I_WF = 256;
    for (int it = bid; it < I_IN + I_OUT + I_WF; it += nblk) {
        int r = it;
        if (r < I_IN) { p0_transpose_tile(p.w_in, D, 2464, WinT, (r / 40) * 64, (r % 40) * 64, 1, lds); continue; } r -= I_IN;
        if (r < I_OUT) { p0_transpose_tile(p.w_out, D, D, WoutT, (r / 16) * 64, (r % 16) * 64, 0, lds); continue; } r -= I_OUT;
        p0_wfused_item(p.peer_wq, p.peer_subkeys, p.ln2_g, WfT, r / 16, r % 16, lds);
    }
    const size_t gt = (size_t)bid * NTHR + TID, ngt = (size_t)nblk * NTHR;
    if (bid == 0 && TID < 8) ((unsigned*)(ws + WS_CTL))[64 * TID] = 0u;
    float* biasP = (float*)(ws + WS_BIASP);
    for (size_t i = gt; i < (size_t)PCOLS; i += ngt) biasP[i] = (i >= 1536 && i < 2304) ? p.b_attn[i - 1536] : 0.f;
    {
        const int lane = TID & 63; const int gw = bid * (NTHR / 64) + (TID >> 6), ngw = nblk * (NTHR / 64);
        for (int rr = gw; rr < 2 * NEXP; rr += ngw) {
            const int tab = rr >= NEXP, row = rr - tab * NEXP;
            const float* src = (tab ? p.peer_v : p.peer_u) + (size_t)row * D;
            unsigned* dst = (unsigned*)(ws + (tab ? WS_V8 : WS_U8) + (size_t)row * D);
            f32x4 v[4]; float mx = 0.f;
#pragma unroll
            for (int j = 0; j < 4; ++j) { v[j] = ((const f32x4*)src)[lane + 64 * j]; mx = fmaxf(mx, fmaxf(fmaxf(fabsf(v[j].x), fabsf(v[j].y)), fmaxf(fabsf(v[j].z), fabsf(v[j].w)))); }
#pragma unroll
            for (int o = 1; o < 64; o <<= 1) mx = fmaxf(mx, shfl_xor_f(mx, o));
            int ex = 0; if (mx > 0.f) ex = ilogbf(mx);
            const float sc = ldexpf(1.f, 7 - ex), inv = ldexpf(1.f, ex - 7);
#pragma unroll
            for (int j = 0; j < 4; ++j) { unsigned w = 0u; w = cvt_pk_fp8_f32(v[j].x * sc, v[j].y * sc, w, false); w = cvt_pk_fp8_f32(v[j].z * sc, v[j].w * sc, w, true); dst[lane + 64 * j] = w; }
            if (lane == 0) ((float*)(ws + (tab ? WS_VSC : WS_USC)))[row] = inv;
        }
    }
    for (size_t i = gt; i < (size_t)8 * 10 * 2 * 64; i += ngt) {
        const int ln = (int)(i & 63), tc = (int)((i >> 6) & 1), f = (int)((i >> 7) % 10), hd = (int)((i >> 7) / 10);
        const float* src = f < 2 ? p.w_up : (f < 4 ? p.a_up : p.g_up); const int ks = f < 2 ? f : (f < 4 ? f - 2 : f - 4);
        const int cg = hd * 64 + 32 * tc + (ln & 31);
        float v8[8];
#pragma unroll
        for (int j = 0; j < 8; ++j) v8[j] = src[(16 * ks + 8 * (ln >> 5) + j) * 512 + cg];
        u32x4 o; o.x = pk2(v8[0], v8[1]); o.y = pk2(v8[2], v8[3]); o.z = pk2(v8[4], v8[5]); o.w = pk2(v8[6], v8[7]);
        ((u32x4*)(ws + WS_FRG))[i] = o;
    }
    rms_rows(p.x, p.ln1_g, (unsigned short*)(ws + WS_H), bid * (NTHR / 64) + (TID >> 6), nblk * (NTHR / 64));
}

constexpr int MP = 72;
constexpr int SLOTB = 64 * MP * 2;
constexpr int LP = 168;
constexpr int RW_PAR = 0;
constexpr int RW_SB = 4096;
constexpr int RW_AT = RW_SB + SLOTB, RW_RT = RW_AT + SLOTB, RW_BHT = RW_RT + SLOTB, RW_KHT = RW_BHT + SLOTB, RW_VT = RW_KHT + SLOTB, RW_GM = RW_VT + SLOTB;
constexpr int RW_RA = RW_GM + SLOTB;
constexpr int RW_P = RW_RA, RW_PT = RW_P + SLOTB, RW_TM = RW_PT + SLOTB, RW_AAK = RW_TM + SLOTB, RW_ARB = RW_AAK + SLOTB, RW_ARK = RW_ARB + SLOTB;
constexpr int RW_RB = RW_RA + 6 * SLOTB;
constexpr int RW_BH = RW_RB, RW_KH = RW_RB + SLOTB, RW_WT = RW_RB, RW_UT = RW_RB + SLOTB;
constexpr int RW_TOT = RW_RB + 3 * SLOTB;
constexpr int RW_BON = RW_TOT + 2048;
constexpr int RW_GC = RW_BON + 256;
constexpr int RW_END = RW_GC + 256;
static_assert(RW_END <= 155648, "rwkv LDS map");

__device__ __forceinline__ f32x16 zero16() { f32x16 z;
#pragma unroll
    for (int i = 0; i < 16; ++i) z[i] = 0.f; return z; }
__device__ __forceinline__ f32x16 tile_mm(f32x16 acc, const unsigned short* A, const unsigned short* B, int tr, int tc, int lane) {
    const unsigned short* ap = A + (32 * tr + (lane & 31)) * MP + 8 * (lane >> 5);
    const unsigned short* bp = B + (32 * tc + (lane & 31)) * MP + 8 * (lane >> 5);
#pragma unroll
    for (int ks = 0; ks < 4; ++ks) acc = mfma32(*(const bf16x8*)(ap + 16 * ks), *(const bf16x8*)(bp + 16 * ks), acc);
    return acc;
}
__device__ __forceinline__ void store_rm(const f32x16& acc, unsigned short* M, int tr, int tc, int lane) {
    unsigned short* base = M + (32 * tr + 4 * (lane >> 5)) * MP + 32 * tc + (lane & 31);
#pragma unroll
    for (int r = 0; r < 16; ++r) base[((r & 3) + 8 * (r >> 2)) * MP] = (unsigned short)f2bf(acc[r]);
}
__device__ __forceinline__ void store_tr(const f32x16& acc, unsigned short* MT, int tr, int tc, int lane) {
    unsigned short* base = MT + (32 * tc + (lane & 31)) * MP + 32 * tr + 4 * (lane >> 5);
#pragma unroll
    for (int g4 = 0; g4 < 4; ++g4) { u32x2 w; w.x = pk2(acc[4 * g4], acc[4 * g4 + 1]); w.y = pk2(acc[4 * g4 + 2], acc[4 * g4 + 3]); *(u32x2*)(base + 8 * g4) = w; }
}
__device__ __forceinline__ float fexp(float x) { return __expf(x); }

__device__ __forceinline__ void rwkv_unit(const Params& p, int b, int h, char* smem) {
    float* par = (float*)(smem + RW_PAR);
    unsigned short* Sb = (unsigned short*)(smem + RW_SB);
    unsigned short* At = (unsigned short*)(smem + RW_AT); unsigned short* Rt = (unsigned short*)(smem + RW_RT);
    unsigned short* BhT = (unsigned short*)(smem + RW_BHT); unsigned short* KhT = (unsigned short*)(smem + RW_KHT);
    unsigned short* VT = (unsigned short*)(smem + RW_VT); unsigned short* Gm = (unsigned short*)(smem + RW_GM);
    float* lres = (float*)(smem + RW_RA); float* Ol = (float*)(smem + RW_RA);
    unsigned short* Pm = (unsigned short*)(smem + RW_P); unsigned short* PT = (unsigned short*)(smem + RW_PT); unsigned short* Tm = (unsigned short*)(smem + RW_TM);
    unsigned short* Aak = (unsigned short*)(smem + RW_AAK); unsigned short* Arb = (unsigned short*)(smem + RW_ARB); unsigned short* Ark = (unsigned short*)(smem + RW_ARK);
    unsigned short* lora = (unsigned short*)(smem + RW_RB); unsigned short* Bh = (unsigned short*)(smem + RW_BH); unsigned short* Kh = (unsigned short*)(smem + RW_KH);
    unsigned short* WT = (unsigned short*)(smem + RW_WT); unsigned short* UT = (unsigned short*)(smem + RW_UT);
    float* tot = (float*)(smem + RW_TOT); float* bon = (float*)(smem + RW_BON); float* gC = (float*)(smem + RW_GC);
    const unsigned short* P = (const unsigned short*)(p.ws + WS_P);
    unsigned short* Y = (unsigned short*)(p.ws + WS_Y);
    int tid = TID; OPAQUE(tid);
    const int w = tid >> 6; int lane = tid & 63;
    const int ch = tid & 63, tg = w;
    const int q4 = w & 3, qtr = q4 >> 1, qtc = q4 & 1;
    if (tid < 64) {
        const int c = h * 64 + tid;
        par[tid] = p.mu_shift[c]; par[64 + tid] = p.mu_shift[512 + c]; par[128 + tid] = p.mu_shift[1024 + c];
        par[352 + tid] = p.w0[c]; par[416 + tid] = p.a0[c]; par[480 + tid] = p.k_k[c]; par[544 + tid] = p.k_a[c]; par[608 + tid] = p.r_k[c]; par[672 + tid] = p.lnx_w[c]; par[736 + tid] = p.lnx_b[c];
    }
    if (tid < 160) par[192 + tid] = p.mu_shift[1536 + tid];
    for (int i = tid; i < 64 * MP; i += NTHR) Sb[i] = 0;
    const bf16x8* frg = (const bf16x8*)(p.ws + WS_FRG) + ((size_t)(h * 10 + (w < 4 ? 0 : 4)) * 2 + qtc) * 64 + (tid & 63);
    f32x16 sreg = zero16();
    const float mu_r = p.mu_shift[h * 64 + ch], mu_k = p.mu_shift[512 + h * 64 + ch], mu_v = p.mu_shift[1024 + h * 64 + ch];
    const float c_w0 = p.w0[h * 64 + ch], c_a0 = p.a0[h * 64 + ch], c_kk = p.k_k[h * 64 + ch], c_ka = p.k_a[h * 64 + ch], c_rk = p.r_k[h * 64 + ch], c_lw = p.lnx_w[h * 64 + ch], c_lb = p.lnx_b[h * 64 + ch];
    u32x4 lcu[3], lpv[3];
#define RW_LOAD_LORA(SS) do { _Pragma("unroll") for (int qi = 0; qi < 3; ++qi) { int it_ = tid + NTHR * qi; it_ = it_ < 64 * 20 ? it_ : 64 * 20 - 1; const int tok_ = it_ / 20, c_ = it_ - tok_ * 20; \
        const unsigned short* row_ = P + ((size_t)b * SEQ + (SS) + tok_) * PCOLS + PC_LORA + 8 * c_; lcu[qi] = *(const u32x4*)row_; lpv[qi] = *(const u32x4*)(row_ - (((SS) + tok_) > 0 ? PCOLS : 0)); } } while (0)
#define RW_LOAD_RKV(SS) do { _Pragma("unroll") for (int i_ = 0; i_ < 9; ++i_) { int sp_ = (SS) + 8 * tg - 1 + i_; sp_ = sp_ < 0 ? 0 : sp_; const unsigned short* row_ = P + ((size_t)b * SEQ + sp_) * PCOLS + h * 64 + ch; \
        rr[i_] = bfl(row_[PC_R]); kr[i_] = bfl(row_[PC_K]); vr[i_] = bfl(row_[PC_V]); } } while (0)
    RW_LOAD_LORA(0);
    BSYNC();
#pragma unroll 1
    for (int s0 = 0; s0 < SEQ; s0 += 64) {
        const size_t tbase = (size_t)b * SEQ + s0;
        OPAQUE(lane);
        const int hh = lane >> 5, l31 = lane & 31;
        float rr[9], kr[9], vr[9];
        RW_LOAD_RKV(s0);
        bf16x8 fr[6];
#pragma unroll
        for (int f = 0; f < 6; ++f) fr[f] = frg[128 * (w < 4 ? (f & 3) : f)];
#pragma unroll
        for (int qi = 0; qi < 3; ++qi) {
            const int it = tid + NTHR * qi;
            if (it < 64 * 20) {
                const int tok = it / 20, c = it - tok * 20;
                const u32x4 cu = lcu[qi]; u32x4 pv = lpv[qi];
                if (s0 + tok == 0) pv = (u32x4){0u, 0u, 0u, 0u};
                float o8[8];
#pragma unroll
                for (int j = 0; j < 4; ++j) {
                    const unsigned cw = cu[j], pw = pv[j];
                    const float c0 = bf_lo(cw), c1 = bf_hi(cw), p0 = bf_lo(pw), p1 = bf_hi(pw);
                    const float m0 = par[192 + 8 * c + 2 * j], m1 = par[192 + 8 * c + 2 * j + 1];
                    o8[2 * j] = c0 + m0 * (p0 - c0); o8[2 * j + 1] = c1 + m1 * (p1 - c1);
                }
                if (c < 4) {
#pragma unroll
                    for (int j = 0; j < 8; ++j) { const float e2 = fexp(2.f * o8[j]); o8[j] = 1.f - 2.f * frcp(e2 + 1.f); }
                } else if (c >= 8) {
#pragma unroll
                    for (int j = 0; j < 8; ++j) o8[j] = frcp(1.f + fexp(-o8[j]));
                }
                u32x4 ow; ow.x = pk2(o8[0], o8[1]); ow.y = pk2(o8[2], o8[3]); ow.z = pk2(o8[4], o8[5]); ow.w = pk2(o8[6], o8[7]);
                *(u32x4*)(lora + tok * LP + 8 * c) = ow;
            }
        }
        { const int sn = (s0 + 64 < SEQ) ? s0 + 64 : s0; RW_LOAD_LORA(sn); }
        BSYNC();
        {
            const unsigned short* ap = lora + (32 * qtr + l31) * LP + 8 * hh;
            if (w < 4) {
                f32x16 aw = zero16(), aa = zero16();
#pragma unroll
                for (int ks = 0; ks < 2; ++ks) { aw = mfma32(*(const bf16x8*)(ap + 16 * ks), fr[ks], aw); aa = mfma32(*(const bf16x8*)(ap + 32 + 16 * ks), fr[2 + ks], aa); }
                { float* lb = lres + (32 * qtr + 4 * hh) * 64 + 32 * qtc + l31;
#pragma unroll
                for (int r = 0; r < 16; ++r) { lb[((r & 3) + 8 * (r >> 2)) * 64] = aw[r]; lb[4096 + ((r & 3) + 8 * (r >> 2)) * 64] = aa[r]; } }
            } else {
                f32x16 ag = zero16();
#pragma unroll
                for (int ks = 0; ks < 6; ++ks) ag = mfma32(*(const bf16x8*)(ap + 64 + 16 * ks), fr[ks], ag);
                store_rm(ag, Gm, qtr, qtc, lane);
            }
        }
        BSYNC();
        {
            float lw[8], kkv[8], bb[8], km[8], rs[8], vs[8], csl[8];
            float cs = 0.f;
            if (s0 + 8 * tg == 0) { rr[0] = 0.f; kr[0] = 0.f; vr[0] = 0.f; }
#pragma unroll
            for (int i = 0; i < 8; ++i) {
                const int t = 8 * tg + i;
                rs[i] = rr[i + 1] + mu_r * (rr[i] - rr[i + 1]);
                const float ksh = kr[i + 1] + mu_k * (kr[i] - kr[i + 1]);
                vs[i] = vr[i + 1] + mu_v * (vr[i] - vr[i + 1]);
                const float z = -(c_w0 + lres[t * 64 + ch]);
                const float sp = fmaxf(z, 0.f) + __logf(1.f + fexp(-fabsf(z)));
                lw[i] = -fexp(-sp - 0.5f);
                const float alpha = frcp(1.f + fexp(-(c_a0 + lres[4096 + t * 64 + ch])));
                const float kx = ksh * c_kk;
                kkv[i] = kx * frsq(fmaxf(wave_sum(kx * kx), 1e-24f));
                bb[i] = kkv[i] * alpha;
                km[i] = ksh * (1.f + (alpha - 1.f) * c_ka);
                const float bo = wave_sum(rs[i] * km[i] * c_rk);
                if (ch == 0) bon[t] = bo;
                cs += lw[i]; csl[i] = cs;
            }
            tot[tg * 64 + ch] = cs;
            BSYNC();
            float pre = 0.f;
#pragma unroll
            for (int g = 0; g < 8; ++g) { const float tv = tot[g * 64 + ch]; pre += (g < tg) ? tv : 0.f; }
            u32x4 bt, kt, vt; float tb[8], tk[8];
#pragma unroll
            for (int i = 0; i < 8; ++i) {
                const int t = 8 * tg + i;
                const float c = pre + csl[i];
                const float gt = fexp(c), gp = fexp(c - lw[i]), gi = fexp(-c);
                At[t * MP + ch] = (unsigned short)f2bf(-kkv[i] * gp);
                Rt[t * MP + ch] = (unsigned short)f2bf(rs[i] * gt);
                tb[i] = bb[i] * gi; tk[i] = km[i] * gi;
                Bh[t * MP + ch] = (unsigned short)f2bf(tb[i]);
                Kh[t * MP + ch] = (unsigned short)f2bf(tk[i]);
            }
            bt.x = pk2(tb[0], tb[1]); bt.y = pk2(tb[2], tb[3]); bt.z = pk2(tb[4], tb[5]); bt.w = pk2(tb[6], tb[7]);
            kt.x = pk2(tk[0], tk[1]); kt.y = pk2(tk[2], tk[3]); kt.z = pk2(tk[4], tk[5]); kt.w = pk2(tk[6], tk[7]);
            vt.x = pk2(vs[0], vs[1]); vt.y = pk2(vs[2], vs[3]); vt.z = pk2(vs[4], vs[5]); vt.w = pk2(vs[6], vs[7]);
            *(u32x4*)(BhT + ch * MP + 8 * tg) = bt; *(u32x4*)(KhT + ch * MP + 8 * tg) = kt; *(u32x4*)(VT + ch * MP + 8 * tg) = vt;
            if (tg == 7) gC[ch] = fexp(pre + csl[7]);
        }
        BSYNC();
        f32x16 treg[2];
        treg[0] = zero16(); treg[1] = zero16();
        {
            const int prod = w >> 1, tr = w & 1;
            const unsigned short* Lm = prod < 2 ? At : Rt; const unsigned short* Rm = (prod & 1) ? Kh : Bh;
            unsigned short* dst = prod == 0 ? Pm : (prod == 1 ? Aak : (prod == 2 ? Arb : Ark));
#pragma unroll
            for (int tc = 0; tc < 2; ++tc) {
                f32x16 acc = zero16();
                if (tc <= tr) acc = tile_mm(acc, Lm, Rm, tr, tc, lane);
                { const int dlt = 32 * tc + l31 - 32 * tr - 4 * hh - (prod < 2 ? 0 : 1);
#pragma unroll
                for (int r = 0; r < 16; ++r) acc[r] = (dlt < (r & 3) + 8 * (r >> 2)) ? acc[r] : 0.f; }
                store_rm(acc, dst, tr, tc, lane);
                if (prod == 0) {
                    store_tr(acc, PT, tr, tc, lane);
                    { const int dl2 = 32 * tc + l31 - 32 * tr - 4 * hh;
#pragma unroll
                    for (int r = 0; r < 16; ++r) acc[r] += (dl2 == (r & 3) + 8 * (r >> 2)) ? 1.f : 0.f; }
                    store_rm(acc, Tm, tr, tc, lane);
                    treg[tc] = acc;
                }
            }
        }
        BSYNC();
#pragma unroll 1
        for (int j = 1; j <= 6; ++j) {
            const int tr = w & 1;
            const bool sq = (w == 2 || w == 3) && j <= 5, tu = w < 2 && j >= 2;
            if (sq) {
                treg[0] = tile_mm(zero16(), Pm, PT, tr, 0, lane);
                if (tr == 1) treg[1] = tile_mm(zero16(), Pm, PT, tr, 1, lane);
            }
            if (tu) {
                treg[0] = tile_mm(treg[0], Tm, PT, tr, 0, lane);
                if (tr == 1) treg[1] = tile_mm(treg[1], Tm, PT, tr, 1, lane);
            }
            BSYNC();
            if (sq) {
                store_rm(treg[0], Pm, tr, 0, lane); store_tr(treg[0], PT, tr, 0, lane);
                if (tr == 1) { store_rm(treg[1], Pm, tr, 1, lane); store_tr(treg[1], PT, tr, 1, lane); }
            }
            if (tu) {
                store_rm(treg[0], Tm, tr, 0, lane);
                if (tr == 1) store_rm(treg[1], Tm, tr, 1, lane);
            }
            BSYNC();
        }
        if (w < 4) { f32x16 acc = zero16(); acc = tile_mm(acc, At, Sb, qtr, qtc, lane); acc = tile_mm(acc, Aak, VT, qtr, qtc, lane); store_tr(acc, WT, qtr, qtc, lane); }
        BSYNC();
        if (w < 4) { f32x16 acc = zero16(); acc = tile_mm(acc, Tm, WT, qtr, qtc, lane); store_tr(acc, UT, qtr, qtc, lane); }
        BSYNC();
        f32x16 oacc = zero16();
        if (w < 4) { oacc = tile_mm(oacc, Rt, Sb, qtr, qtc, lane); oacc = tile_mm(oacc, Arb, UT, qtr, qtc, lane); oacc = tile_mm(oacc, Ark, VT, qtr, qtc, lane); }
        else {
            sreg = tile_mm(sreg, UT, BhT, qtr, qtc, lane); sreg = tile_mm(sreg, VT, KhT, qtr, qtc, lane);
            const float gc = gC[32 * qtc + l31];
#pragma unroll
            for (int r = 0; r < 16; ++r) sreg[r] *= gc;
        }
        BSYNC();
        if (w < 4) {
            { float* ob = Ol + (32 * qtr + 4 * hh) * 64 + 32 * qtc + l31;
#pragma unroll
            for (int r = 0; r < 16; ++r) ob[((r & 3) + 8 * (r >> 2)) * 64] = oacc[r]; }
        } else store_rm(sreg, Sb, qtr, qtc, lane);
        BSYNC();
#pragma unroll
        for (int i = 0; i < 8; ++i) {
            const int t = 8 * tg + i;
            const float o = Ol[t * 64 + ch];
            const float mean = wave_sum(o) * (1.f / 64.f);
            const float dv = o - mean;
            const float var = wave_sum(dv * dv) * (1.f / 64.f);
            float y = dv * frsq(var + LNX_EPS) * c_lw + c_lb;
            y = (y + bon[t] * bfl(VT[ch * MP + t])) * bfl(Gm[t * MP + ch]);
            Y[(tbase + t) * D + h * 64 + ch] = (unsigned short)f2bf(y);
        }
        BSYNC();
    }
}

constexpr int KPITCH = 72, VPITCH = 260;
__device__ __forceinline__ void attn_unit(const Params& p, int b, int n, char* smem) {
    unsigned short* Kl = (unsigned short*)smem;
    unsigned short* Vt = Kl + 2 * 256 * KPITCH;
    float* ssl = (float*)(Vt + 2 * 64 * VPITCH);
    float* rstdl = ssl + 1024;
    float* wsf = rstdl + 128;
    const unsigned short* P = (const unsigned short*)(p.ws + WS_P);
    unsigned short* Y = (unsigned short*)(p.ws + WS_Y);
    const int tid = TID, lane = tid & 63, w = tid >> 6, q = lane & 31, hh = lane >> 5, g = w >> 2;
    const long tb = (long)b * SEQ + (long)(n - 1) * 128;
    for (int i = tid; i < 4096; i += NTHR) {
        const int c = i & 7, kj = (i >> 3) & 255, gg = i >> 11;
        const bool valid = (n > 0) || (kj >= 128);
        u32x4 kv = (u32x4){0u, 0u, 0u, 0u}, vv = (u32x4){0u, 0u, 0u, 0u};
        if (valid) { const unsigned short* row = P + (size_t)(tb + kj) * PCOLS; kv = *(const u32x4*)(row + PC_AK + gg * 64 + c * 8); vv = *(const u32x4*)(row + PC_AV + gg * 64 + c * 8); }
        *(u32x4*)(Kl + (gg * 256 + kj) * KPITCH + c * 8) = kv;
        unsigned short* vd = Vt + (gg * 64 + c * 8) * VPITCH + kj;
        vd[0 * VPITCH] = (unsigned short)(vv.x & 0xffff); vd[1 * VPITCH] = (unsigned short)(vv.x >> 16);
        vd[2 * VPITCH] = (unsigned short)(vv.y & 0xffff); vd[3 * VPITCH] = (unsigned short)(vv.y >> 16);
        vd[4 * VPITCH] = (unsigned short)(vv.z & 0xffff); vd[5 * VPITCH] = (unsigned short)(vv.z >> 16);
        vd[6 * VPITCH] = (unsigned short)(vv.w & 0xffff); vd[7 * VPITCH] = (unsigned short)(vv.w >> 16);
    }
    BSYNC();
    const float sink = p.attn_sinks[w];
    const long tq_blk = (long)b * SEQ + (long)n * 128;
    for (int it = 0; it < 4; ++it) {
        bf16x8 qf[4];
#pragma unroll
        for (int ks = 0; ks < 4; ++ks) qf[ks] = *(const bf16x8*)(P + (size_t)(tq_blk + 32 * it + q) * PCOLS + PC_Q + w * 64 + 16 * ks + 8 * hh);
        f32x16 pb[5];
        float mloc = sink;
        const int iq = 32 * it + q;
#pragma unroll
        for (int bi = 0; bi < 5; ++bi) {
            const int jb = it + bi;
            const bool active = (n > 0) || (jb >= 4);
#pragma unroll
            for (int r = 0; r < 16; ++r) pb[bi][r] = 0.f;
            if (active) {
#pragma unroll
                for (int ks = 0; ks < 4; ++ks) { const bf16x8 kf = *(const bf16x8*)(Kl + (g * 256 + 32 * jb + q) * KPITCH + 16 * ks + 8 * hh); pb[bi] = mfma32(kf, qf[ks], pb[bi]); }
            }
#pragma unroll
            for (int r = 0; r < 16; ++r) {
                const int kj = 32 * jb + crow(r, hh);
                const bool ok = active && (kj >= iq + 1) && (kj <= iq + 128);
                const float s = ok ? pb[bi][r] * 0.125f : -1e30f;
                pb[bi][r] = s; mloc = fmaxf(mloc, s);
            }
        }
        mloc = fmaxf(mloc, xor32_f(mloc, lane));
        float lsum = 0.f;
#pragma unroll
        for (int bi = 0; bi < 5; ++bi)
#pragma unroll
            for (int r = 0; r < 16; ++r) { const float e = expf(pb[bi][r] - mloc); pb[bi][r] = e; lsum += e; }
        lsum += xor32_f(lsum, lane);
        lsum += expf(sink - mloc);
        f32x16 o[2];
#pragma unroll
        for (int r = 0; r < 16; ++r) { o[0][r] = 0.f; o[1][r] = 0.f; }
#pragma unroll
        for (int bi = 0; bi < 5; ++bi) {
            const int jb = it + bi;
            const bool active = (n > 0) || (jb >= 4);
            if (active) {
#pragma unroll
                for (int s2 = 0; s2 < 2; ++s2) {
                    bf16x8 pa;
#pragma unroll
                    for (int j = 0; j < 8; ++j) pa[j] = (short)f2bf(pb[bi][8 * s2 + j]);
#pragma unroll
                    for (int dt = 0; dt < 2; ++dt) {
                        const unsigned short* vp = Vt + (g * 64 + 32 * dt + q) * VPITCH + 32 * jb + 16 * s2 + 4 * hh;
                        const bf16x4 lo = *(const bf16x4*)vp, hi = *(const bf16x4*)(vp + 8);
                        const bf16x8 vf = (bf16x8){lo[0], lo[1], lo[2], lo[3], hi[0], hi[1], hi[2], hi[3]};
                        o[dt] = mfma32(pa, vf, o[dt]);
                    }
                }
            }
        }
        if (hh == 0) wsf[w * 32 + q] = 1.f / lsum;
        WSYNC();
        float ss[16];
#pragma unroll
        for (int r = 0; r < 16; ++r) { const float il = wsf[w * 32 + crow(r, hh)]; o[0][r] *= il; o[1][r] *= il; ss[r] = o[0][r] * o[0][r] + o[1][r] * o[1][r]; }
        WSYNC();
#pragma unroll
        for (int r = 0; r < 16; ++r) {
            const float s = half_sum(ss[r]);
            if (q == 0) ssl[(32 * it + crow(r, hh)) * 8 + w] = s;
            const size_t trow = (size_t)(tq_blk + 32 * it + crow(r, hh));
            Y[trow * D + 512 + w * 64 + q] = (unsigned short)f2bf(o[0][r]);
            Y[trow * D + 512 + w * 64 + 32 + q] = (unsigned short)f2bf(o[1][r]);
        }
    }
    BSYNC();
    if (tid < 128) { float s = 0.f;
#pragma unroll
        for (int j = 0; j < 8; ++j) s += ssl[tid * 8 + j];
        rstdl[tid] = 1.0f / sqrtf(s * (1.f / 512.f) + RMS_EPS); }
    BSYNC();
    const float g0 = p.attn_norm_g[w * 64 + q], g1 = p.attn_norm_g[w * 64 + 32 + q];
    for (int it = 0; it < 4; ++it)
#pragma unroll
        for (int r = 0; r < 16; ++r) {
            const int qi = 32 * it + crow(r, hh); const float rs = rstdl[qi];
            unsigned short* yp = Y + (size_t)(tq_blk + qi) * D + 512 + w * 64 + q;
            yp[0] = (unsigned short)f2bf(bfl(yp[0]) * rs * g0); yp[32] = (unsigned short)f2bf(bfl(yp[32]) * rs * g1);
        }
    BSYNC();
}

__device__ __forceinline__ void ins16(float (&l)[16], float x) {
#pragma unroll
    for (int i = 0; i < 16; ++i) { const float t = fmaxf(l[i], x); x = fminf(l[i], x); l[i] = t; }
}
__device__ __forceinline__ void topk_half(float* S, float* lists, int trow0, int hd, int* IDX, float* GATE) {
    const int tid = TID, row = tid & 127, grp = (tid >> 7) & 1, half = tid >> 8;
    float l[16];
#pragma unroll
    for (int i = 0; i < 16; ++i) l[i] = -3.0e38f;
    const float* src = S + row * 260 + grp * 128 + half * 64;
    for (int c = 0; c < 64; c += 4) {
        const f32x4 v = *(const f32x4*)(src + c);
#pragma unroll
        for (int i = 0; i < 4; ++i) { const unsigned nidx = (unsigned)(half * 64 + c + i); const float sv = v[i]; const float key = __builtin_bit_cast(float, (__builtin_bit_cast(unsigned, sv) & ~127u) | (127u - nidx)); ins16(l, key); }
    }
    float* slot = lists + (row * 2 + grp) * 16;
    if (half == 1) {
#pragma unroll
        for (int i = 0; i < 16; ++i) slot[i] = l[i];
    }
    BSYNC();
    if (half == 0) {
#pragma unroll
        for (int i = 0; i < 16; ++i) ins16(l, slot[i]);
        if (grp == 1) {
#pragma unroll
            for (int i = 0; i < 16; ++i) slot[i] = l[i];
        }
    }
    BSYNC();
    if (tid < 128) {
        const float* bl = lists + (row * 2 + 1) * 16;
        float bs[16];
#pragma unroll
        for (int i = 0; i < 16; ++i) bs[i] = bl[i];
        float c16[16];
#pragma unroll
        for (int i = 0; i < 16; ++i) c16[i] = -3.0e38f;
#pragma unroll
        for (int i = 0; i < 16; ++i) {
            const int jmax = 16 / (i + 1);
            const float ai = __builtin_bit_cast(float, __builtin_bit_cast(unsigned, l[i]) & ~127u);
#pragma unroll
            for (int j = 0; j < 16; ++j) if (j < jmax) {
                const float bj = __builtin_bit_cast(float, __builtin_bit_cast(unsigned, bs[j]) & ~127u);
                const float sm = ai + bj;
                ins16(c16, __builtin_bit_cast(float, (__builtin_bit_cast(unsigned, sm) & ~255u) | (unsigned)(i * 16 + j)));
            }
        }
        float ev[16]; float den = 0.f;
        const float mx = __builtin_bit_cast(float, __builtin_bit_cast(unsigned, c16[0]) & ~255u);
#pragma unroll
        for (int k = 0; k < 16; ++k) { const float sv = __builtin_bit_cast(float, __builtin_bit_cast(unsigned, c16[k]) & ~255u); ev[k] = expf(sv - mx); den += ev[k]; }
        const float inv = 1.f / den;
        int* ip = IDX + (size_t)(trow0 + row) * 128 + hd * 16; float* gp = GATE + (size_t)(trow0 + row) * 128 + hd * 16;
#pragma unroll
        for (int k = 0; k < 16; ++k) {
            const unsigned code = __builtin_bit_cast(unsigned, c16[k]) & 255u; const int ci = (int)(code >> 4), cj = (int)(code & 15u);
            unsigned abits = 0u, bbits = 0u;
#pragma unroll
            for (int i = 0; i < 16; ++i) { abits = (ci == i) ? __builtin_bit_cast(unsigned, l[i]) : abits; bbits = (cj == i) ? __builtin_bit_cast(unsigned, bs[i]) : bbits; }
            const int ia = 127 - (int)(abits & 127u), ib = 127 - (int)(bbits & 127u);
            ip[k] = ia * 128 + ib; gp[k] = ev[k] * inv;
        }
    }
    BSYNC();
}

__device__ __forceinline__ float gelu_erf(float v) { return 0.5f * v * (1.f + erff(v * 0.70710678118654752f)); }
__device__ __forceinline__ void cvt16_fp8(const u32x4 w, float (&f)[16]) {
#pragma unroll
    for (int q = 0; q < 4; ++q) { const unsigned ww = w[q]; const f32x2 a = cvt_pk_f32_fp8(ww, false), b = cvt_pk_f32_fp8(ww, true); f[4 * q] = a.x; f[4 * q + 1] = a.y; f[4 * q + 2] = b.x; f[4 * q + 3] = b.y; }
}
__device__ __forceinline__ float reduce4(const float (&d)[4], int lane) {
    const bool b5 = (lane & 32) != 0, b4 = (lane & 16) != 0;
    float r[2];
#pragma unroll
    for (int i = 0; i < 2; ++i) { const float x = b5 ? d[2 + i] : d[i], y = b5 ? d[i] : d[2 + i]; r[i] = x + xor32_f(y, lane); }
    const float t = (b4 ? r[1] : r[0]) + xor16_f(b4 ? r[0] : r[1], lane);
    return row_sum(t);
}
__device__ __forceinline__ void peer_phase(const Params& p, int bid, int nblk, float* OUT, char* smem, int epoch0) {
    const int lane = TID & 63, wv = TID >> 6;
    const int gw = bid * (NTHR / 64) + wv, ngw = nblk * (NTHR / 64);
    unsigned* skeys = (unsigned*)smem + wv * 256;
    unsigned* rcnt = (unsigned*)(p.ws + WS_CTL) + 64 * (bid & 7);
    const int grp_blocks = (nblk - (bid & 7) + 7) / 8;
    const unsigned char* U8 = p.ws + WS_U8; const unsigned char* V8 = p.ws + WS_V8;
    const float* USC = (const float*)(p.ws + WS_USC); const float* VSC = (const float*)(p.ws + WS_VSC);
    const int* IDX = (const int*)(p.ws + WS_IDX); const float* GATE = (const float*)(p.ws + WS_GATE);
    float* X1 = p.out;
    float g2f[16];
#pragma unroll
    for (int j = 0; j < 4; ++j) { const f32x4 gv = *(const f32x4*)(p.ln2_g + 16 * lane + 4 * j); g2f[4 * j] = gv[0]; g2f[4 * j + 1] = gv[1]; g2f[4 * j + 2] = gv[2]; g2f[4 * j + 3] = gv[3]; }
#define PEER_LOAD(UA, VA, bb) do { _Pragma("unroll") for (int u = 0; u < 4; ++u) { const int k = 4 * (bb) + u; const int e = rdlane_i(k < 64 ? myi0 : myi1, k & 63); \
        UA[u] = *(const u32x4*)(U8 + (size_t)e * D + 16 * lane); VA[u] = *(const u32x4*)(V8 + (size_t)e * D + 16 * lane); } } while (0)
#define PEER_COMPUTE(UA, VA, bb) do { float dd[4]; \
        _Pragma("unroll") for (int u = 0; u < 4; ++u) { float uf[16]; cvt16_fp8(UA[u], uf); float d = 0.f; _Pragma("unroll") for (int i = 0; i < 16; ++i) d += hf[i] * uf[i]; dd[u] = d; } \
        const float dsum = reduce4(dd, lane); \
        float usc, cf; { const int k0 = 4 * (bb); const float su = k0 < 64 ? myu0 : myu1, sc = k0 < 64 ? myc0 : myc1; const int l0 = k0 & 63, sel = lane >> 4; \
            const float u0 = rdlane_f(su, l0), u1 = rdlane_f(su, l0 + 1), u2 = rdlane_f(su, l0 + 2), u3 = rdlane_f(su, l0 + 3); const float c0 = rdlane_f(sc, l0), c1 = rdlane_f(sc, l0 + 1), c2 = rdlane_f(sc, l0 + 2), c3 = rdlane_f(sc, l0 + 3); \
            usc = sel == 0 ? u0 : (sel == 1 ? u1 : (sel == 2 ? u2 : u3)); cf = sel == 0 ? c0 : (sel == 1 ? c1 : (sel == 2 ? c2 : c3)); } \
        const float av = gelu_erf(dsum * usc) * cf; \
        _Pragma("unroll") for (int u = 0; u < 4; ++u) { const float au = rdlane_f(av, 16 * u); float vf[16]; cvt16_fp8(VA[u], vf); _Pragma("unroll") for (int i = 0; i < 16; ++i) acc[i] += au * vf[i]; } } while (0)
    const int nround = (T + ngw - 1) / ngw;
#pragma unroll 1
    for (int rnd = 0; rnd < nround; ++rnd) {
      const int t = rnd * ngw + gw;
      if (t < T) {
        float hf[16];
        {
            const float* xr0 = X1 + (size_t)t * D + 16 * lane; float sq = 0.f;
#pragma unroll
            for (int j = 0; j < 4; ++j) { const f32x4 xv = *(const f32x4*)(xr0 + 4 * j);
#pragma unroll
                for (int i = 0; i < 4; ++i) { hf[4 * j + i] = xv[i]; sq += xv[i] * xv[i]; } }
            const float rs2 = 1.0f / sqrtf(wave_sum(sq) * (1.f / D) + RMS_EPS);
#pragma unroll
            for (int i = 0; i < 16; ++i) hf[i] *= rs2 * g2f[i];
        }
        int myi0, myi1; float myu0, myu1, myc0, myc1;
        {
            const unsigned k0 = ((unsigned)IDX[(size_t)t * 128 + lane] << 7) | (unsigned)lane, k1 = ((unsigned)IDX[(size_t)t * 128 + 64 + lane] << 7) | (unsigned)(64 + lane);
            skeys[lane] = k0; skeys[64 + lane] = k1;
            WSYNC();
            int r0 = 0, r1 = 0;
#pragma unroll 4
            for (int j = 0; j < 32; ++j) { const u32x4 kv = *(const u32x4*)(skeys + 4 * j);
                r0 += (kv.x < k0) + (kv.y < k0) + (kv.z < k0) + (kv.w < k0); r1 += (kv.x < k1) + (kv.y < k1) + (kv.z < k1) + (kv.w < k1); }
            skeys[128 + r0] = k0; skeys[128 + r1] = k1;
            WSYNC();
            const unsigned s0 = skeys[128 + lane], s1 = skeys[192 + lane];
            WSYNC();
            myi0 = (int)(s0 >> 7); myi1 = (int)(s1 >> 7);
            myu0 = USC[myi0]; myu1 = USC[myi1];
            myc0 = GATE[(size_t)t * 128 + (s0 & 127u)] * VSC[myi0]; myc1 = GATE[(size_t)t * 128 + (s1 & 127u)] * VSC[myi1];
        }
        float acc[16];
#pragma unroll
        for (int i = 0; i < 16; ++i) acc[i] = 0.f;
        u32x4 ua[4], va[4], ub[4], vb[4];
        PEER_LOAD(ua, va, 0);
#pragma unroll 1
        for (int b = 0; b < 32; b += 2) {
            PEER_LOAD(ub, vb, b + 1);
            PEER_COMPUTE(ua, va, b);
            if (b + 2 < 32) PEER_LOAD(ua, va, b + 2);
            PEER_COMPUTE(ub, vb, b + 1);
        }
        float* xr = X1 + (size_t)t * D + 16 * lane;
        float ssq = 0.f; f32x4 xv[4];
#pragma unroll
        for (int j = 0; j < 4; ++j) { xv[j] = *(const f32x4*)(xr + 4 * j);
#pragma unroll
            for (int i = 0; i < 4; ++i) { xv[j][i] += acc[4 * j + i]; ssq += xv[j][i] * xv[j][i]; } }
        const float rstd = 1.0f / sqrtf(wave_sum(ssq) * (1.f / D) + RMS_EPS);
#pragma unroll
        for (int j = 0; j < 4; ++j) { const f32x4 gg = *(const f32x4*)(p.lnf_g + 16 * lane + 4 * j); f32x4 o;
#pragma unroll
            for (int i = 0; i < 4; ++i) o[i] = xv[j][i] * rstd * gg[i];
            *(f32x4*)(OUT + (size_t)t * D + 16 * lane + 4 * j) = o; }
      }
      BSYNC();
#ifndef EMU
      if (TID == 0 && rnd + 1 < nround) {
          __hip_atomic_fetch_add(rcnt, 1u, __ATOMIC_RELAXED, __HIP_MEMORY_SCOPE_AGENT);
          const unsigned want = (unsigned)(grp_blocks * (epoch0 + rnd + 1));
          for (int sp = 0; sp < 4000; ++sp) { if (__hip_atomic_load(rcnt, __ATOMIC_RELAXED, __HIP_MEMORY_SCOPE_AGENT) >= want) break; __builtin_amdgcn_s_sleep(8); }
      }
#endif
      BSYNC();
    }
#undef PEER_LOAD
#undef PEER_COMPUTE
}

#ifndef EMU
namespace pg8 {
#define PG8_LAS __attribute__((address_space(3)))
typedef unsigned short bf16_t;
typedef short bf16x8 __attribute__((ext_vector_type(8)));
typedef float f32x4 __attribute__((ext_vector_type(4)));
typedef unsigned u32x4 __attribute__((ext_vector_type(4)));
constexpr int BM = 256, BK = 64, HALF = 128, HTB = HALF * BK * 2  , STAGE_BYTES = 8 * HTB, NXCD = 8, WGM = 8;

__host__ __device__ __forceinline__ int lds_byte(int r, int c) { const int st = (r >> 4) * 2 + (c >> 5), rr = r & 15, cc = c & 31, ob = rr * 64 + cc * 2; return st * 1024 + (ob ^ (((ob >> 9) & 1) << 5)); }
__host__ __device__ __forceinline__ void stage_rc(int b, int& R, int& C) { const int st = b / 1024, sb = b % 1024, swz = sb ^ (((sb >> 9) & 1) << 5); R = (st >> 1) * 16 + swz / 64; C = (st & 1) * 32 + (swz % 64) / 2; }
__host__ __device__ __forceinline__ int perm32(int rho) { const int n = rho >> 4, i = rho & 15; return 8 * (i >> 2) + 4 * n + (i & 3); }

struct Unit { int pm, pn; };
struct Gemm { const bf16_t* A; const bf16_t* Bt; int M, N, K; };

struct StaticOrder {
    int nM, nN, nwg, G, c;
    __host__ __device__ void init(int M, int N, int G_, int c_) { nM = M / BM; nN = N / BM; nwg = nM * nN; G = G_; c = c_; }
    __host__ __device__ bool next(int i, Unit& u) const {
        const long L = (long)i * G + c; if (L >= nwg) return false;
        int wgid = (int)L; { const int q = nwg / NXCD, r = nwg % NXCD, xcd = wgid % NXCD, off = wgid / NXCD; wgid = (xcd < r ? xcd * (q + 1) : r * (q + 1) + (xcd - r) * q) + off; }
        const int nig = WGM * nN, gid = wgid / nig, fm = gid * WGM, gsz = (nM - fm) < WGM ? (nM - fm) : WGM;
        u.pm = fm + ((wgid % nig) % gsz); u.pn = (wgid % nig) / gsz; return true;
    }
    __device__ __forceinline__ void a_ready(const Unit&) const {}
    __device__ __forceinline__ void done(const Unit&) const {}
};

__device__ __forceinline__ unsigned cvt_pk_bf16(float lo, float hi) { unsigned r; asm volatile("v_cvt_pk_bf16_f32 %0, %1, %2" : "=v"(r) : "v"(lo), "v"(hi)); return r; }
typedef float f32x2 __attribute__((ext_vector_type(2)));
__device__ __forceinline__ f32x2 gelu_pk(f32x2 v) {
    const f32x2 av = __builtin_elementwise_abs(v), d = av * 0.2316418882f + 1.0f;
    f32x2 t; t.x = __builtin_amdgcn_rcpf(d.x); t.y = __builtin_amdgcn_rcpf(d.y);
    f32x2 q = t * 0.5307027145f + (-0.7265760135f); q = q * t + 0.7107068705f; q = q * t + (-0.142248368f); q = q * t + 0.127414796f; q = q * t;
    const f32x2 s = (v * v) * (-0.72134752044f);
    f32x2 e; e.x = __builtin_amdgcn_exp2f(s.x); e.y = __builtin_amdgcn_exp2f(s.y);
    const f32x2 m = v * (q * e), r = v - m;
    f32x2 o; o.x = v.x < 0.f ? m.x : r.x; o.y = v.y < 0.f ? m.y : r.y; return o;
}

template <int ACT  > struct EpiBf16 {
    static constexpr bool PERM = true, AFTER_DRAIN = false; static_assert(ACT == 0 || ACT == 1, "EpiBf16: ACT is 0 (none) or 1 (gelu_pk)");
    bf16_t* O; int ldc; const float* bias; int split_cols; size_t split_stride; float scale0;
    __device__ __forceinline__ void operator()(const f32x4 (&acc)[2][2][4][2], const Unit& u, int wr, int wc, int fr, int fq) const {
        const int row0 = u.pm * BM + wr * 64 + fr; int colt = u.pn * BM; bf16_t* base = O;
        float sc = 1.f; if (split_cols) { const int t = colt / split_cols; base += (size_t)t * split_stride; colt -= t * split_cols; if (t == 0) sc = scale0; }
        const int col0 = colt + wc * 32 + 8 * fq, bcol0 = u.pn * BM + wc * 32 + 8 * fq;
        f32x4 bv[2][2];
#pragma unroll
        for (int bj = 0; bj < 2; ++bj)
#pragma unroll
            for (int n = 0; n < 2; ++n) bv[bj][n] = bias ? *(const f32x4*)(bias + bcol0 + bj * HALF + 4 * n) : (f32x4){0.f, 0.f, 0.f, 0.f};
#pragma unroll
        for (int ai = 0; ai < 2; ++ai)
#pragma unroll
            for (int m = 0; m < 4; ++m) { bf16_t* rowp = base + (size_t)(row0 + ai * HALF + m * 16) * ldc + col0;
#pragma unroll
                for (int bj = 0; bj < 2; ++bj) { f32x4 v0 = acc[ai][bj][m][0] + bv[bj][0], v1 = acc[ai][bj][m][1] + bv[bj][1];
                    if (ACT == 1) { f32x2 a = gelu_pk((f32x2){v0[0], v0[1]}), b = gelu_pk((f32x2){v0[2], v0[3]}), c = gelu_pk((f32x2){v1[0], v1[1]}), d = gelu_pk((f32x2){v1[2], v1[3]});
                        v0 = (f32x4){a.x, a.y, b.x, b.y}; v1 = (f32x4){c.x, c.y, d.x, d.y}; }
                    v0 = v0 * sc; v1 = v1 * sc; u32x4 w; w.x = cvt_pk_bf16(v0[0], v0[1]); w.y = cvt_pk_bf16(v0[2], v0[3]); w.z = cvt_pk_bf16(v1[0], v1[1]); w.w = cvt_pk_bf16(v1[2], v1[3]);
                    *(u32x4*)(rowp + bj * HALF) = w; } }
    }
};
template <class Epi, class Sched, bool ALIGN_EPI = false, bool SP2 = false>
__device__ __forceinline__ void gemm_phase(PG8_LAS unsigned char* lds, const Gemm g, const Sched& S, const Epi& E) {
    int tid = threadIdx.x; asm volatile("" : "+v"(tid));
    const int wid = __builtin_amdgcn_readfirstlane(tid >> 6), lane = tid & 63, wr = wid >> 2, wc = wid & 3, fr = lane & 15, fq = lane >> 4;
    const int K = g.K, nt = K / BK;
    unsigned voffA[2], voffB[2];
#pragma unroll
    for (int i = 0; i < 2; ++i) { int R, C; stage_rc(tid * 16 + i * 8192, R, C); const int Rb = Epi::PERM ? ((R & ~31) + perm32(R & 31)) : R;
        voffA[i] = (unsigned)(R * K + C) * 2u; voffB[i] = (unsigned)(Rb * K + C) * 2u; }
    const size_t kstep = (size_t)(BK * 2);
    const size_t hstep = (size_t)HALF * K * 2;
    const size_t tstep = 2 * hstep;
    const unsigned ldsw = (unsigned)wid * 1024u;
    const int aoff = lds_byte(wr * 64 + fr, fq * 8), boff = lds_byte(wc * 32 + fr, fq * 8);
#define PG8_SA(b, h) (((b) * 2 + (h)) * HTB)
#define PG8_SB(b, h) ((4 + (b) * 2 + (h)) * HTB)
#define PG8_STAGE(bufoff, gbase, voff) do { _Pragma("unroll") for (int _i = 0; _i < 2; ++_i) \
        __builtin_amdgcn_global_load_lds((const unsigned*)((const char*)(gbase) + (voff)[_i]), (PG8_LAS unsigned*)(lds + (bufoff) + ldsw + _i * 8192), 16, 0, 0); } while (0)
#define PG8_LDA(dst, b, h) do { _Pragma("unroll") for (int m = 0; m < 4; ++m) _Pragma("unroll") for (int k = 0; k < 2; ++k) dst[m][k] = *(const PG8_LAS bf16x8*)(lds + PG8_SA(b, h) + aoff + m * 2048 + k * 1024); } while (0)
#define PG8_LDB(dst, b, h) do { _Pragma("unroll") for (int n = 0; n < 2; ++n) _Pragma("unroll") for (int k = 0; k < 2; ++k) dst[n][k] = *(const PG8_LAS bf16x8*)(lds + PG8_SB(b, h) + boff + n * 2048 + k * 1024); } while (0)
#define PG8_MMA(ai, bj, At, Bt) do { __builtin_amdgcn_s_setprio(1); _Pragma("unroll") for (int m = 0; m < 4; ++m) _Pragma("unroll") for (int n = 0; n < 2; ++n) _Pragma("unroll") for (int k = 0; k < 2; ++k) \
        acc[ai][bj][m][n] = __builtin_amdgcn_mfma_f32_16x16x32_bf16(Bt[n][k], At[m][k], acc[ai][bj][m][n], 0, 0, 0); __builtin_amdgcn_s_setprio(0); } while (0)
#define PG8_WAIT_V(n) asm volatile("s_waitcnt vmcnt(" #n ")" ::: "memory")
#define PG8_WAIT_L(n) asm volatile("s_waitcnt lgkmcnt(" #n ")" ::: "memory")
#define PG8_BAR __builtin_amdgcn_s_barrier()
#define PG8_SCHED __builtin_amdgcn_sched_barrier(0)
    Unit cur, nxt; int ui = 0;
    if (!S.next(0, cur)) return;
    f32x4 acc[2][2][4][2];
#pragma unroll
    for (int a = 0; a < 2; ++a)
#pragma unroll
        for (int b = 0; b < 2; ++b)
#pragma unroll
            for (int m = 0; m < 4; ++m)
#pragma unroll
                for (int n = 0; n < 2; ++n) acc[a][b][m][n] = (f32x4){0.f, 0.f, 0.f, 0.f};
    bf16x8 At[4][2], B0[2][2], B1[2][2];
    const char* cA = (const char*)g.A + (size_t)cur.pm * tstep; const char* cB = (const char*)g.Bt + (size_t)cur.pn * tstep;
    S.a_ready(cur);
    if constexpr (SP2) {
        PG8_STAGE(PG8_SB(0, 0), cB, voffB); PG8_STAGE(PG8_SB(0, 1), cB + hstep, voffB); PG8_STAGE(PG8_SA(0, 0), cA, voffA); PG8_STAGE(PG8_SA(0, 1), cA + hstep, voffA);
        if (wr == 1) PG8_BAR;
        PG8_WAIT_V(2); PG8_BAR;
        PG8_STAGE(PG8_SB(1, 0), cB + kstep, voffB); PG8_STAGE(PG8_SA(1, 0), cA + kstep, voffA); PG8_STAGE(PG8_SB(1, 1), cB + hstep + kstep, voffB);
        PG8_WAIT_V(6); PG8_BAR;
    } else {
        PG8_STAGE(PG8_SB(0, 0), cB, voffB); PG8_STAGE(PG8_SA(0, 0), cA, voffA); PG8_STAGE(PG8_SB(0, 1), cB + hstep, voffB); PG8_STAGE(PG8_SA(0, 1), cA + hstep, voffA);
        if (wr == 1) PG8_BAR;
        PG8_WAIT_V(4); PG8_BAR;
        PG8_STAGE(PG8_SB(1, 0), cB + kstep, voffB); PG8_STAGE(PG8_SA(1, 0), cA + kstep, voffA); PG8_STAGE(PG8_SB(1, 1), cB + hstep + kstep, voffB);
        PG8_WAIT_V(6); PG8_BAR;
    }
    for (;;) {
        const bool has_next = S.next(ui + 1, nxt);
        const char* nA = has_next ? (const char*)g.A + (size_t)nxt.pm * tstep : cA; const char* nB = has_next ? (const char*)g.Bt + (size_t)nxt.pn * tstep : cB;
        for (int t = 0; t < nt; t += 2) {
            const bool last = (t == nt - 2);
            const char* a1 = cA + (size_t)(t + 1) * kstep;
            const char* a2 = last ? nA : cA + (size_t)(t + 2) * kstep; const char* b2 = last ? nB : cB + (size_t)(t + 2) * kstep;
            const char* a3 = a2 + kstep; const char* b3 = b2 + kstep;
            if (last && has_next) S.a_ready(nxt);
            if constexpr (SP2) {
            PG8_LDB(B0, 0, 0); PG8_LDB(B1, 0, 1); PG8_SCHED; PG8_LDA(At, 0, 0); PG8_STAGE(PG8_SA(1, 1), a1 + hstep, voffA);
            PG8_WAIT_V(8); PG8_WAIT_L(0); PG8_BAR; PG8_MMA(0, 0, At, B0); PG8_MMA(0, 1, At, B1); PG8_BAR; PG8_SCHED;
            PG8_LDA(At, 0, 1); PG8_STAGE(PG8_SB(0, 0), b2, voffB); PG8_STAGE(PG8_SB(0, 1), b2 + hstep, voffB); PG8_STAGE(PG8_SA(0, 0), a2, voffA);
            PG8_WAIT_V(8); PG8_WAIT_L(0); PG8_BAR; PG8_MMA(1, 0, At, B0); PG8_MMA(1, 1, At, B1); PG8_BAR; PG8_SCHED;
            PG8_LDB(B0, 1, 0); PG8_LDB(B1, 1, 1); PG8_SCHED; PG8_LDA(At, 1, 0); PG8_STAGE(PG8_SA(0, 1), a2 + hstep, voffA);
            PG8_WAIT_V(8); PG8_WAIT_L(0); PG8_BAR; PG8_MMA(0, 0, At, B0); PG8_MMA(0, 1, At, B1); PG8_BAR; PG8_SCHED;
            PG8_LDA(At, 1, 1); PG8_STAGE(PG8_SB(1, 0), b3, voffB); PG8_STAGE(PG8_SB(1, 1), b3 + hstep, voffB); PG8_STAGE(PG8_SA(1, 0), a3, voffA);
            PG8_WAIT_V(8); PG8_WAIT_L(0); PG8_BAR; PG8_MMA(1, 0, At, B0); PG8_MMA(1, 1, At, B1); PG8_BAR; PG8_SCHED;
            } else {
            PG8_LDB(B0, 0, 0); PG8_SCHED; PG8_LDA(At, 0, 0); PG8_STAGE(PG8_SA(1, 1), a1 + hstep, voffA);
            PG8_WAIT_L(8); PG8_BAR; PG8_WAIT_L(0); PG8_MMA(0, 0, At, B0); PG8_BAR; PG8_SCHED;
            PG8_LDB(B1, 0, 1); PG8_STAGE(PG8_SB(0, 0), b2, voffB);
            PG8_BAR; PG8_WAIT_L(0); PG8_MMA(0, 1, At, B1); PG8_BAR;
            PG8_LDA(At, 0, 1); PG8_STAGE(PG8_SA(0, 0), a2, voffA);
            PG8_BAR; PG8_WAIT_L(0); PG8_MMA(1, 0, At, B0); PG8_BAR; PG8_SCHED;
            PG8_STAGE(PG8_SB(0, 1), b2 + hstep, voffB);
            PG8_WAIT_V(6); PG8_BAR; PG8_MMA(1, 1, At, B1); PG8_BAR;
            PG8_LDB(B0, 1, 0); PG8_SCHED; PG8_LDA(At, 1, 0); PG8_STAGE(PG8_SA(0, 1), a2 + hstep, voffA);
            PG8_WAIT_L(8); PG8_BAR; PG8_WAIT_L(0); PG8_MMA(0, 0, At, B0); PG8_BAR; PG8_SCHED;
            PG8_LDB(B1, 1, 1); PG8_STAGE(PG8_SB(1, 0), b3, voffB);
            PG8_BAR; PG8_WAIT_L(0); PG8_MMA(0, 1, At, B1); PG8_BAR;
            PG8_LDA(At, 1, 1); PG8_STAGE(PG8_SA(1, 0), a3, voffA);
            PG8_BAR; PG8_WAIT_L(0); PG8_MMA(1, 0, At, B0); PG8_BAR; PG8_SCHED;
            PG8_STAGE(PG8_SB(1, 1), b3 + hstep, voffB);
            PG8_WAIT_V(6); PG8_BAR; PG8_MMA(1, 1, At, B1); PG8_BAR;
            }
        }
        if constexpr (ALIGN_EPI) { if (wr == 0) PG8_BAR; }
        if constexpr (!Epi::AFTER_DRAIN) { E(acc, cur, wr, wc, fr, fq); S.done(cur); }
        if (!has_next) break;
#pragma unroll
        for (int a = 0; a < 2; ++a)
#pragma unroll
            for (int b = 0; b < 2; ++b)
#pragma unroll
                for (int m = 0; m < 4; ++m)
#pragma unroll
                    for (int n = 0; n < 2; ++n) acc[a][b][m][n] = (f32x4){0.f, 0.f, 0.f, 0.f};
        cur = nxt; cA = nA; cB = nB; ++ui;
        if constexpr (ALIGN_EPI) { if (wr == 1) PG8_BAR; }
    }
    PG8_WAIT_V(0);
    if constexpr (!ALIGN_EPI) { if (wr == 0) PG8_BAR; }
    PG8_BAR;
    if constexpr (Epi::AFTER_DRAIN) { E.fused(acc, cur, wr, wc, fr, fq, lds, wid, lane); S.done(cur); }
#undef PG8_SA
#undef PG8_SB
#undef PG8_STAGE
#undef PG8_LDA
#undef PG8_LDB
#undef PG8_MMA
#undef PG8_WAIT_V
#undef PG8_WAIT_L
#undef PG8_BAR
#undef PG8_SCHED
}
}

struct OneUnit {
    pg8::Unit u;
    __device__ __forceinline__ bool next(int i, pg8::Unit& o) const { if (i) return false; o = u; return true; }
    __device__ __forceinline__ void a_ready(const pg8::Unit&) const {}
    __device__ __forceinline__ void done(const pg8::Unit&) const {}
};
struct EpiResF32 {
    static constexpr bool PERM = false, AFTER_DRAIN = false;
    const float* base; float* out; pg8::bf16_t* xb; float* ssq;
    __device__ __forceinline__ void operator()(const pg8::f32x4 (&acc)[2][2][4][2], const pg8::Unit& u, int wr, int wc, int fr, int fq) const {
#pragma unroll
        for (int ai = 0; ai < 2; ++ai)
#pragma unroll
            for (int m = 0; m < 4; ++m) {
                const size_t row = (size_t)u.pm * 256 + ai * 128 + wr * 64 + m * 16 + fr;
                float sq = 0.f;
#pragma unroll
                for (int bj = 0; bj < 2; ++bj)
#pragma unroll
                    for (int n = 0; n < 2; ++n) {
                        const size_t off = row * D + u.pn * 256 + bj * 128 + wc * 32 + n * 16 + 4 * fq;
                        const pg8::f32x4 b = *(const pg8::f32x4*)(base + off);
                        const pg8::f32x4 v = b + acc[ai][bj][m][n];
                        *(pg8::f32x4*)(out + off) = v;
                        u32x2 w; w.x = pk2(v[0], v[1]); w.y = pk2(v[2], v[3]); *(u32x2*)(xb + off) = w;
                        sq += (v[0] * v[0] + v[1] * v[1]) + (v[2] * v[2] + v[3] * v[3]);
                    }
                sq += __shfl_xor(sq, 16); sq += __shfl_xor(sq, 32);
                if (fq == 0) ssq[row * 16 + u.pn * 4 + wc] = sq;
            }
    }
};
struct EpiTopK {
    static constexpr bool PERM = false, AFTER_DRAIN = true;
    int* IDX; float* GATE; const float* ssq;
    __device__ __forceinline__ void fused(pg8::f32x4 (&acc)[2][2][4][2], const pg8::Unit& u, int wr, int wc, int fr, int fq, PG8_LAS unsigned char* lds, int wid, int lane) const {
        float* S = (float*)lds; float* lists = S + 128 * 260; float* rs = lists + 128 * 2 * 16;
        if (threadIdx.x < 256) {
            const pg8::f32x4* sp = (const pg8::f32x4*)(ssq + ((size_t)u.pm * 256 + threadIdx.x) * 16);
            const pg8::f32x4 a = sp[0], b = sp[1], c = sp[2], d = sp[3];
            const float tot = ((a[0] + a[1]) + (a[2] + a[3])) + ((b[0] + b[1]) + (b[2] + b[3])) + ((c[0] + c[1]) + (c[2] + c[3])) + ((d[0] + d[1]) + (d[2] + d[3]));
            rs[threadIdx.x] = 1.0f / sqrtf(tot * (1.f / D) + RMS_EPS);
        }
        __syncthreads();
#pragma unroll
        for (int ai = 0; ai < 2; ++ai) {
#pragma unroll
            for (int m = 0; m < 4; ++m) {
                const float r = rs[ai * 128 + wr * 64 + m * 16 + fr];
#pragma unroll
                for (int bj = 0; bj < 2; ++bj)
#pragma unroll
                    for (int n = 0; n < 2; ++n) *(pg8::f32x4*)(S + (wr * 64 + m * 16 + fr) * 260 + bj * 128 + wc * 32 + n * 16 + 4 * fq) = acc[ai][bj][m][n] * r;
            }
            __syncthreads();
            topk_half(S, lists, u.pm * 256 + ai * 128, u.pn, IDX, GATE);
        }
    }
};

#ifndef PHM
#define PHM 255
#endif
#ifndef DUP
#define DUP 0
#endif
constexpr int LDS_BYTES = 155648;
__global__ void __launch_bounds__(NTHR, 2) fwd_kernel(Params p) {
    extern __shared__ __attribute__((aligned(16))) unsigned char lds[];
    cg::grid_group grid = cg::this_grid();
    const int bid = blockIdx.x, nblk = gridDim.x;
    unsigned char* ws = p.ws;
#if PHM & 1
    p0_prologue(p, bid, nblk, (char*)lds);
#if DUP & 1
    p0_prologue(p, bid, nblk, (char*)lds);
#endif
#endif
    grid.sync();
#if PHM & 2
    {
        pg8::Gemm g{(const pg8::bf16_t*)(ws + WS_H), (const pg8::bf16_t*)(ws + WS_WINT), T, PCOLS, D};
        pg8::StaticOrder S; S.init(T, PCOLS, nblk, bid);
        pg8::EpiBf16<0> E{(pg8::bf16_t*)(ws + WS_P), PCOLS, (const float*)(ws + WS_BIASP), 0, 0, 1.f};
        pg8::gemm_phase<pg8::EpiBf16<0>, pg8::StaticOrder, true, true>((PG8_LAS unsigned char*)lds, g, S, E);
    }
#if DUP & 2
    {
        pg8::Gemm g{(const pg8::bf16_t*)(ws + WS_H), (const pg8::bf16_t*)(ws + WS_WINT), T, PCOLS, D};
        pg8::StaticOrder S; S.init(T, PCOLS, nblk, bid);
        pg8::EpiBf16<0> E{(pg8::bf16_t*)(ws + WS_P), PCOLS, (const float*)(ws + WS_BIASP), 0, 0, 1.f};
        pg8::gemm_phase<pg8::EpiBf16<0>, pg8::StaticOrder, true, true>((PG8_LAS unsigned char*)lds, g, S, E);
    }
#endif
#endif
    grid.sync();
#if PHM & 4
#if DUP & 4
    for (int u = bid; u < BATCH * 8; u += nblk) rwkv_unit(p, u >> 3, u & 7, (char*)lds);
#endif
    for (int u = bid; u < BATCH * 8; u += nblk) rwkv_unit(p, u >> 3, u & 7, (char*)lds);
#endif
#if PHM & 8
    for (int u = bid; u < BATCH * (SEQ / 128); u += nblk) attn_unit(p, u / (SEQ / 128), u % (SEQ / 128), (char*)lds);
#if DUP & 8
    for (int u = bid; u < BATCH * (SEQ / 128); u += nblk) attn_unit(p, u / (SEQ / 128), u % (SEQ / 128), (char*)lds);
#endif
#endif
    grid.sync();
#if PHM & 16
    {
        pg8::Gemm g{(const pg8::bf16_t*)(ws + WS_Y), (const pg8::bf16_t*)(ws + WS_WOUTT), T, D, D};
        pg8::StaticOrder S; S.init(T, D, nblk, bid);
        EpiResF32 E{p.x, p.out, (pg8::bf16_t*)(ws + WS_H), (float*)(ws + WS_SSQ)};
        pg8::gemm_phase<EpiResF32, pg8::StaticOrder, true, true>((PG8_LAS unsigned char*)lds, g, S, E);
    }
#if DUP & 16
    {
        pg8::Gemm g{(const pg8::bf16_t*)(ws + WS_Y), (const pg8::bf16_t*)(ws + WS_WOUTT), T, D, D};
        pg8::StaticOrder S; S.init(T, D, nblk, bid);
        EpiResF32 E{p.x, p.out, (pg8::bf16_t*)(ws + WS_H), (float*)(ws + WS_SSQ)};
        pg8::gemm_phase<EpiResF32, pg8::StaticOrder, true, true>((PG8_LAS unsigned char*)lds, g, S, E);
    }
#endif
#endif
    grid.sync();
#if PHM & 64
    {
        pg8::Gemm g{(const pg8::bf16_t*)(ws + WS_H), (const pg8::bf16_t*)(ws + WS_WFT), T, 2048, D};
        pg8::StaticOrder S; S.init(T, 2048, nblk, bid);
        EpiTopK E{(int*)(ws + WS_IDX), (float*)(ws + WS_GATE), (const float*)(ws + WS_SSQ)};
        OneUnit one;
        for (int i = 0; S.next(i, one.u); ++i) pg8::gemm_phase<EpiTopK, OneUnit, false, true>((PG8_LAS unsigned char*)lds, g, one, E);
    }
#if DUP & 64
    {
        pg8::Gemm g{(const pg8::bf16_t*)(ws + WS_H), (const pg8::bf16_t*)(ws + WS_WFT), T, 2048, D};
        pg8::StaticOrder S; S.init(T, 2048, nblk, bid);
        EpiTopK E{(int*)(ws + WS_IDX), (float*)(ws + WS_GATE), (const float*)(ws + WS_SSQ)};
        OneUnit one;
        for (int i = 0; S.next(i, one.u); ++i) pg8::gemm_phase<EpiTopK, OneUnit, false, true>((PG8_LAS unsigned char*)lds, g, one, E);
    }
#endif
#endif
    grid.sync();
#if PHM & 128
#if DUP & 128
    peer_phase(p, bid, nblk, (float*)(ws + WS_P), (char*)lds, 0);
#endif
    peer_phase(p, bid, nblk, p.out, (char*)lds, (DUP & 128) ? (T + nblk * (NTHR / 64) - 1) / (nblk * (NTHR / 64)) - 1 : 0);
#endif
}

extern "C" void kernel_launch(void* const* d_in, const int* in_sizes, int n_in, void* d_out, int out_size, void* d_ws, size_t ws_size, hipStream_t stream) {
    static int grid = 0;
    if (grid == 0) {
        if (n_in != 24 || out_size != T * D || ws_size < WS_END) { fprintf(stderr, "kernel_launch: unexpected shapes (n_in %d, out %d, ws %zu < %zu)\n", n_in, out_size, ws_size, (size_t)WS_END); grid = -1; return; }
        int dev = 0, cus = 0, per_cu = 0;
        hipGetDevice(&dev);
        hipDeviceGetAttribute(&cus, hipDeviceAttributeMultiprocessorCount, dev);
        hipFuncSetAttribute((const void*)fwd_kernel, hipFuncAttributeMaxDynamicSharedMemorySize, LDS_BYTES);
        hipOccupancyMaxActiveBlocksPerMultiprocessor(&per_cu, (const void*)fwd_kernel, NTHR, LDS_BYTES);
        if (per_cu < 1) { fprintf(stderr, "kernel_launch: occupancy query says %d blocks per CU\n", per_cu); per_cu = 1; }
        if (per_cu > 1) per_cu = 1;
        grid = cus * per_cu;
        (void)hipGetLastError();
    }
    if (grid < 0) return;
    Params p{};
    const float** pp = (const float**)&p;
    for (int i = 0; i < 24; ++i) pp[i] = (const float*)d_in[i];
    p.out = (float*)d_out; p.ws = (unsigned char*)d_ws;
    void* args[] = {&p};
    hipError_t e = hipLaunchCooperativeKernel((const void*)fwd_kernel, dim3(grid), dim3(NTHR), args, LDS_BYTES, stream);
    if (e != hipSuccess) fprintf(stderr, "cooperative launch failed: %s (grid %d)\n", hipGetErrorString(e), grid);
}
#endif
```

```cpp
#ifndef EMU
#include <hip/hip_runtime.h>
#include <hip/hip_cooperative_groups.h>
#include <cstdio>
#include <cstdint>
namespace cg = cooperative_groups;
typedef short bf16x8 __attribute__((ext_vector_type(8)));
typedef short bf16x4 __attribute__((ext_vector_type(4)));
typedef float f32x16 __attribute__((ext_vector_type(16)));
typedef float f32x4 __attribute__((ext_vector_type(4)));
typedef float f32x2 __attribute__((ext_vector_type(2)));
typedef unsigned u32x4 __attribute__((ext_vector_type(4)));
typedef unsigned u32x2 __attribute__((ext_vector_type(2)));
#define TID ((int)threadIdx.x)
#define BSYNC() __syncthreads()
#define WSYNC() __builtin_amdgcn_wave_barrier()
#define OPAQUE(x) asm volatile("" : "+v"(x))
#define TIE8(A, i) asm volatile("" : "+v"(A[i]), "+v"(A[i + 1]), "+v"(A[i + 2]), "+v"(A[i + 3]), "+v"(A[i + 4]), "+v"(A[i + 5]), "+v"(A[i + 6]), "+v"(A[i + 7]) :: "memory")
#define TIEM(x) asm volatile("" : "+v"(x) :: "memory")
__device__ __forceinline__ float shfl_xor_f(float v, int m) { return __shfl_xor(v, m); }
__device__ __forceinline__ float shfl_f(float v, int s) { return __shfl(v, s); }
__device__ __forceinline__ int shfl_i(int v, int s) { return __shfl(v, s); }
__device__ __forceinline__ float rdlane_f(float v, int l) { return __builtin_bit_cast(float, __builtin_amdgcn_readlane(__builtin_bit_cast(int, v), l)); }
__device__ __forceinline__ int rdlane_i(int v, int l) { return __builtin_amdgcn_readlane(v, l); }
__device__ __forceinline__ f32x2 cvt_pk_f32_fp8(unsigned w, bool hi) { return hi ? __builtin_amdgcn_cvt_pk_f32_fp8((int)w, true) : __builtin_amdgcn_cvt_pk_f32_fp8((int)w, false); }
__device__ __forceinline__ unsigned cvt_pk_fp8_f32(float a, float b, unsigned old, bool hi) { return hi ? (unsigned)__builtin_amdgcn_cvt_pk_fp8_f32(a, b, (int)old, true) : (unsigned)__builtin_amdgcn_cvt_pk_fp8_f32(a, b, (int)old, false); }
template <int CTRL> __device__ __forceinline__ float dppf(float v) { return __builtin_bit_cast(float, __builtin_amdgcn_update_dpp(0, __builtin_bit_cast(int, v), CTRL, 0xF, 0xF, true)); }
__device__ __forceinline__ float row_sum(float v) { v += dppf<0xB1>(v); v += dppf<0x4E>(v); v += dppf<0x141>(v); v += dppf<0x140>(v); return v; }
__device__ __forceinline__ void swap16(float v, float& r0, float& r1) { unsigned a = __builtin_bit_cast(unsigned, v), b = a; asm volatile("" : "+v"(b)); auto rr = __builtin_amdgcn_permlane16_swap(a, b, false, false); const unsigned u0 = rr[0], u1 = rr[1]; r0 = __builtin_bit_cast(float, u0); r1 = __builtin_bit_cast(float, u1); }
__device__ __forceinline__ void swap32(float v, float& r0, float& r1) { unsigned a = __builtin_bit_cast(unsigned, v), b = a; asm volatile("" : "+v"(b)); auto rr = __builtin_amdgcn_permlane32_swap(a, b, false, false); const unsigned u0 = rr[0], u1 = rr[1]; r0 = __builtin_bit_cast(float, u0); r1 = __builtin_bit_cast(float, u1); }
__device__ __forceinline__ float xor16_f(float v, int lane) { float r0, r1; swap16(v, r0, r1); return (lane & 16) ? r0 : r1; }
__device__ __forceinline__ float xor32_f(float v, int lane) { float r0, r1; swap32(v, r0, r1); return (lane & 32) ? r0 : r1; }
__device__ __forceinline__ float half_sum(float v) { v = row_sum(v); float r0, r1; swap16(v, r0, r1); return r0 + r1; }
__device__ __forceinline__ float wave_sum(float v) { v = half_sum(v); float r0, r1; swap32(v, r0, r1); return r0 + r1; }
__device__ __forceinline__ float wave_max(float v) { v = fmaxf(v, dppf<0xB1>(v)); v = fmaxf(v, dppf<0x4E>(v)); v = fmaxf(v, dppf<0x141>(v)); v = fmaxf(v, dppf<0x140>(v)); float r0, r1; swap16(v, r0, r1); v = fmaxf(r0, r1); swap32(v, r0, r1); return fmaxf(r0, r1); }
typedef __amdgpu_buffer_rsrc_t rsrc_t;
__device__ __forceinline__ rsrc_t make_rsrc(const void* p, unsigned bytes) { return __builtin_amdgcn_make_buffer_rsrc((void*)p, 0, bytes, 0x00020000); }
__device__ __forceinline__ u32x4 bload16(rsrc_t r, int voff, int soff) { return __builtin_amdgcn_raw_buffer_load_b128(r, voff, soff, 0); }
__device__ __forceinline__ int rfl_i(int v) { return __builtin_amdgcn_readfirstlane(v); }
typedef unsigned u32x3 __attribute__((ext_vector_type(3)));
__device__ __forceinline__ u32x3 bload12(rsrc_t r, int voff) { return __builtin_amdgcn_raw_buffer_load_b96(r, voff, 0, 0); }
__device__ __forceinline__ void dma_row(rsrc_t r, char* lds_dst, int voff, int soff) { __builtin_amdgcn_raw_ptr_buffer_load_lds(r, (__attribute__((address_space(3))) void*)lds_dst, 16, voff, soff, 0, 0); }
#define RAW_BARRIER() __builtin_amdgcn_s_barrier()
typedef unsigned u32x6 __attribute__((ext_vector_type(6)));
typedef float f32x32 __attribute__((ext_vector_type(32)));
__device__ __forceinline__ u32x6 cvt_2xpk16_fp6(f32x16 a, f32x16 b) { return __builtin_amdgcn_cvt_scalef32_2xpk16_fp6_f32(a, b, 1.0f); }
__device__ __forceinline__ f32x32 cvt_pk32_fp6(u32x6 p) { return __builtin_amdgcn_cvt_scalef32_pk32_f32_fp6(p, 1.0f); }
__device__ __forceinline__ void dma_row12(rsrc_t r, char* lds_dst, int voff12, int soff) { __builtin_amdgcn_raw_ptr_buffer_load_lds(r, (__attribute__((address_space(3))) void*)lds_dst, 12, voff12, soff, 0, 0); }
__device__ __forceinline__ void dma_piece(rsrc_t r, char* lds_dst, int gvoff) { __builtin_amdgcn_raw_ptr_buffer_load_lds(r, (__attribute__((address_space(3))) void*)lds_dst, 16, gvoff, 0, 0, 0); }
typedef int i32x8 __attribute__((ext_vector_type(8)));
__device__ __forceinline__ f32x4 mfma_fp6_fp8(u32x6 a, i32x8 b, f32x4 c) {
    i32x8 a8; a8[0] = (int)a[0]; a8[1] = (int)a[1]; a8[2] = (int)a[2]; a8[3] = (int)a[3]; a8[4] = (int)a[4]; a8[5] = (int)a[5]; a8[6] = 0; a8[7] = 0;
    return __builtin_amdgcn_mfma_scale_f32_16x16x128_f8f6f4(a8, b, c, 2  , 0  , 0, 0x7f7f7f7f, 0, 0x7f7f7f7f);
}
__device__ __forceinline__ f32x4 mfma_fp4_fp8(u32x4 a, i32x8 b, f32x4 c) {
    i32x8 a8; a8[0] = (int)a[0]; a8[1] = (int)a[1]; a8[2] = (int)a[2]; a8[3] = (int)a[3]; a8[4] = 0; a8[5] = 0; a8[6] = 0; a8[7] = 0;
    return __builtin_amdgcn_mfma_scale_f32_16x16x128_f8f6f4(a8, b, c, 4  , 0  , 0, 0x7f7f7f7f, 0, 0x7f7f7f7f);
}
#define CVT_FP4X2(w, SEL) __builtin_amdgcn_cvt_scalef32_pk_f32_fp4((w), 1.0f, (SEL))
#define VM_WAIT(N) asm volatile("s_waitcnt vmcnt(" #N ")" ::: "memory")
#define LGKM_WAIT0() asm volatile("s_waitcnt lgkmcnt(0)" ::: "memory")
#define SCHED_FENCE() __builtin_amdgcn_sched_barrier(0)
__device__ __forceinline__ float fexp2(float x) { return __builtin_amdgcn_exp2f(x); }
__device__ __forceinline__ float frcp(float x) { return __builtin_amdgcn_rcpf(x); }
__device__ __forceinline__ float frsq(float x) { return __builtin_amdgcn_rsqf(x); }
__device__ __forceinline__ f32x16 mfma32(bf16x8 a, bf16x8 b, f32x16 c) { return __builtin_amdgcn_mfma_f32_32x32x16_bf16(a, b, c, 0, 0, 0); }
__device__ __forceinline__ f32x4 mfma16(bf16x8 a, bf16x8 b, f32x4 c) { return __builtin_amdgcn_mfma_f32_16x16x32_bf16(a, b, c, 0, 0, 0); }
#else
#define WSYNC() emu_barrier(g_wave_bar[TID >> 6], 64)
#define OPAQUE(x)
#define TIE8(A, i)
#define TIEM(x)
#endif

#ifndef CFG_BATCH
#define CFG_BATCH 32
#endif
#ifndef CFG_SEQ
#define CFG_SEQ 2048
#endif
constexpr int D = 1024, BATCH = CFG_BATCH, SEQ = CFG_SEQ, T = BATCH * SEQ;
constexpr int NTHR = 512;
constexpr int PCOLS = 2560;
constexpr int PC_R = 0, PC_K = 512, PC_V = 1024, PC_Q = 1536, PC_AK = 2048, PC_AV = 2176, PC_LORA = 2304;
constexpr int NEXP = 16384;
constexpr float RMS_EPS = 1e-6f, LNX_EPS = 64e-5f;

constexpr size_t MiB = 1u << 20;
constexpr size_t al1m(size_t x) { return (x + MiB - 1) / MiB * MiB; }
constexpr size_t WS_CTL = 0;
constexpr size_t WS_BIASP = 1 * MiB;
constexpr size_t WS_WINT = 2 * MiB;
constexpr size_t WS_WOUTT = 7 * MiB;
constexpr size_t WS_WFT = 9 * MiB;
constexpr size_t WS_UV6 = 16 * MiB;
constexpr size_t WS_FRG = 50 * MiB;
constexpr size_t WS_SSQ = 52 * MiB;
constexpr size_t WS_USC = 48 * MiB;
constexpr size_t WS_VSC = 49 * MiB;
constexpr size_t WS_H = 80 * MiB;
constexpr size_t WS_Y = WS_H + al1m((size_t)T * D * 2);
constexpr size_t WS_P = WS_Y + al1m((size_t)T * D * 2);
constexpr size_t WS_IDX = WS_P + al1m((size_t)T * PCOLS * 2);
constexpr size_t WS_GATE = WS_IDX + al1m((size_t)T * 128 * 4);
constexpr size_t WS_END = WS_GATE + al1m((size_t)T * 128 * 4);

struct Params {
    const float* x; const float* ln1_g; const float* w_in; const float* b_attn; const float* mu_shift; const float* w0; const float* w_up; const float* a0;
    const float* a_up; const float* g_up; const float* k_k; const float* k_a; const float* r_k; const float* lnx_w; const float* lnx_b; const float* attn_sinks;
    const float* attn_norm_g; const float* w_out; const float* ln2_g; const float* peer_wq; const float* peer_subkeys; const float* peer_u; const float* peer_v; const float* lnf_g;
    float* out; unsigned char* ws;
};

#ifndef EMU
typedef __bf16 hwbf16x2 __attribute__((ext_vector_type(2)));
__device__ __forceinline__ unsigned f2bf(float f) { const __bf16 b = (__bf16)f; return (unsigned)__builtin_bit_cast(unsigned short, b); }
__device__ __forceinline__ unsigned pk2(float lo, float hi) { const f32x2 v = {lo, hi}; const hwbf16x2 b = __builtin_convertvector(v, hwbf16x2); return __builtin_bit_cast(unsigned, b); }
#else
__device__ __forceinline__ unsigned f2bf(float f) { unsigned u = __builtin_bit_cast(unsigned, f); return (u + 0x7fffu + ((u >> 16) & 1u)) >> 16; }
__device__ __forceinline__ unsigned pk2(float lo, float hi) { return f2bf(lo) | (f2bf(hi) << 16); }
#endif
__device__ __forceinline__ float bfl(unsigned short b) { return __builtin_bit_cast(float, (unsigned)b << 16); }
__device__ __forceinline__ float bf_lo(unsigned w) { return __builtin_bit_cast(float, w << 16); }
__device__ __forceinline__ float bf_hi(unsigned w) { return __builtin_bit_cast(float, w & 0xffff0000u); }
__device__ __forceinline__ int crow(int r, int hi) { return (r & 3) + 8 * (r >> 2) + 4 * hi; }
__device__ __forceinline__ int win_src_col(int n) { if (n < 1536) return n; if (n < 2304) return n + 160; if (n < 2464) return n - 768; return -1; }
__device__ __forceinline__ float sigmoidf_(float z) { return 1.f / (1.f + expf(-z)); }

__device__ __forceinline__ void p0_transpose_tile(const float* W, int K, int ldw, unsigned short* WT, int k0, int n0, int mode, float* tl) {
    const int t = TID, kk = t >> 6, nn = t & 63;
    const int sc = mode ? win_src_col(n0 + nn) : (n0 + nn);
#pragma unroll
    for (int i = 0; i < 8; ++i) { const int k = kk + 8 * i; tl[k * 65 + nn] = sc >= 0 ? W[(size_t)(k0 + k) * ldw + sc] : 0.f; }
    BSYNC();
    const int n = t >> 3, c = t & 7;
    u32x4 o;
    o.x = pk2(tl[(8 * c + 0) * 65 + n], tl[(8 * c + 1) * 65 + n]); o.y = pk2(tl[(8 * c + 2) * 65 + n], tl[(8 * c + 3) * 65 + n]);
    o.z = pk2(tl[(8 * c + 4) * 65 + n], tl[(8 * c + 5) * 65 + n]); o.w = pk2(tl[(8 * c + 6) * 65 + n], tl[(8 * c + 7) * 65 + n]);
    *(u32x4*)(WT + (size_t)(n0 + n) * K + k0 + 8 * c) = o;
    BSYNC();
}
__device__ __forceinline__ void p0_wfused_item(const float* wq, const float* sk, const float* g2, unsigned short* WfT, int hc, int kt, float* lds) {
    float* skl = lds;
    float* wql = lds + 128 * 129;
    for (int i = TID; i < 16384; i += NTHR) { const int n = i >> 7, d = i & 127; skl[n * 129 + d] = sk[(size_t)hc * 16384 + i]; }
    for (int i = TID; i < 64 * 128; i += NTHR) { const int k = i >> 7, d = i & 127; wql[d * 64 + k] = wq[(size_t)(kt * 64 + k) * 2048 + hc * 128 + d]; }
    BSYNC();
    const int n = TID & 127, kg = TID >> 7;
    float acc[16];
#pragma unroll
    for (int j = 0; j < 16; ++j) acc[j] = 0.f;
    for (int d = 0; d < 128; ++d) {
        const float a = skl[n * 129 + d]; const float* bp = wql + d * 64 + kg * 16;
#pragma unroll
        for (int j = 0; j < 16; ++j) acc[j] += a * bp[j];
    }
#pragma unroll
    for (int j = 0; j < 16; ++j) acc[j] *= g2[kt * 64 + kg * 16 + j];
    unsigned short* dst = WfT + (size_t)(hc * 128 + n) * D + kt * 64 + kg * 16;
    u32x4 o0, o1;
    o0.x = pk2(acc[0], acc[1]); o0.y = pk2(acc[2], acc[3]); o0.z = pk2(acc[4], acc[5]); o0.w = pk2(acc[6], acc[7]);
    o1.x = pk2(acc[8], acc[9]); o1.y = pk2(acc[10], acc[11]); o1.z = pk2(acc[12], acc[13]); o1.w = pk2(acc[14], acc[15]);
    *(u32x4*)dst = o0; *(u32x4*)(dst + 8) = o1;
    BSYNC();
}
__device__ __forceinline__ void rms_rows(const float* X, const float* g, unsigned short* H, int gw, int ngw) {
    const int lane = TID & 63;
    f32x4 gg[4];
#pragma unroll
    for (int j = 0; j < 4; ++j) gg[j] = ((const f32x4*)g)[lane + 64 * j];
    for (int m0 = gw; m0 < T; m0 += 4 * ngw) {
        f32x4 v[4][4]; float s[4];
#pragma unroll
        for (int r = 0; r < 4; ++r) { const f32x4* xr = (const f32x4*)(X + (size_t)(m0 + r * ngw) * D) + lane;
#pragma unroll
            for (int j = 0; j < 4; ++j) v[r][j] = xr[64 * j]; }
#pragma unroll
        for (int r = 0; r < 4; ++r) { s[r] = 0.f;
#pragma unroll
            for (int j = 0; j < 4; ++j) s[r] += (v[r][j].x * v[r][j].x + v[r][j].y * v[r][j].y) + (v[r][j].z * v[r][j].z + v[r][j].w * v[r][j].w); }
#pragma unroll
        for (int r = 0; r < 4; ++r) { const float rstd = 1.0f / sqrtf(wave_sum(s[r]) * (1.f / D) + RMS_EPS);
            u32x2* o8 = (u32x2*)(H + (size_t)(m0 + r * ngw) * D) + lane;
#pragma unroll
            for (int j = 0; j < 4; ++j) { u32x2 w; w.x = pk2(v[r][j].x * rstd * gg[j].x, v[r][j].y * rstd * gg[j].y); w.y = pk2(v[r][j].z * rstd * gg[j].z, v[r][j].w * rstd * gg[j].w); o8[64 * j] = w; } }
    }
}
__device__ __forceinline__ void p0_prologue(const Params& p, int bid, int nblk, char* smem) {
    float* lds = (float*)smem;
    unsigned char* ws = p.ws;
    unsigned short* WinT = (unsigned short*)(ws + WS_WINT); unsigned short* WoutT = (unsigned short*)(ws + WS_WOUTT); unsigned short* WfT = (unsigned short*)(ws + WS_WFT);
    constexpr int I_IN = 640, I_OUT = 256, I_WF = 256;
    for (int it = bid; it < I_IN + I_OUT + I_WF; it += nblk) {
        int r = it;
        if (r < I_IN) { p0_transpose_tile(p.w_in, D, 2464, WinT, (r / 40) * 64, (r % 40) * 64, 1, lds); continue; } r -= I_IN;
        if (r < I_OUT) { p0_transpose_tile(p.w_out, D, D, WoutT, (r / 16) * 64, (r % 16) * 64, 0, lds); continue; } r -= I_OUT;
        p0_wfused_item(p.peer_wq, p.peer_subkeys, p.ln2_g, WfT, r / 16, r % 16, lds);
    }
    const size_t gt = (size_t)bid * NTHR + TID, ngt = (size_t)nblk * NTHR;
    if (bid == 0 && TID == 0) ((unsigned*)(ws + WS_CTL))[1024] = 0u;
    float* biasP = (float*)(ws + WS_BIASP);
    for (size_t i = gt; i < (size_t)PCOLS; i += ngt) biasP[i] = (i >= 1536 && i < 2304) ? p.b_attn[i - 1536] : 0.f;
    {
        const int lane = TID & 63; const int gw = bid * (NTHR / 64) + (TID >> 6), ngw = nblk * (NTHR / 64);
        bool lowfirst;
        { const f32x2 t_ = CVT_FP4X2(0x21u, 0); lowfirst = (t_.x == 0.5f); }
        if (gw == 0) {
            bool ok = true;
#pragma unroll
            for (int c = 0; c < 16; c += 2) { const unsigned w_ = (unsigned)(c | ((c + 1) << 4)) * 0x01010101u; const int m0 = c & 7, m1 = (c + 1) & 7;
                float e0 = m0 == 0 ? 0.f : m0 == 1 ? 0.5f : m0 == 2 ? 1.f : m0 == 3 ? 1.5f : m0 == 4 ? 2.f : m0 == 5 ? 3.f : m0 == 6 ? 4.f : 6.f; if (c & 8) e0 = -e0;
                float e1 = m1 == 0 ? 0.f : m1 == 1 ? 0.5f : m1 == 2 ? 1.f : m1 == 3 ? 1.5f : m1 == 4 ? 2.f : m1 == 5 ? 3.f : m1 == 6 ? 4.f : 6.f; if ((c + 1) & 8) e1 = -e1;
                const f32x2 d0 = CVT_FP4X2(w_, 0), d1 = CVT_FP4X2(w_, 1), d2 = CVT_FP4X2(w_, 2), d3 = CVT_FP4X2(w_, 3);
                const float x0 = lowfirst ? e0 : e1, x1 = lowfirst ? e1 : e0;
                ok = ok && d0.x == x0 && d0.y == x1 && d1.x == x0 && d1.y == x1 && d2.x == x0 && d2.y == x1 && d3.x == x0 && d3.y == x1; }
            if (lane == 0) ((unsigned*)(ws + WS_CTL))[1025] = ok ? 0u : 1u;
        }
        if (gw == 0) {
            const int r_ = lane & 15, kg = lane >> 4;
            u32x4 ta4 = {0u, 0u, 0u, 0u}; i32x8 tb8 = {0, 0, 0, 0, 0, 0, 0, 0};
#pragma unroll
            for (int i = 0; i < 32; ++i) { const int ka = 32 * kg + i, kb = 64 * (i >> 4) + 16 * kg + (i & 15);
                const bool ona = (ka & 3) == (((ka >> 2) + (ka >> 4)) & 3), onb = (kb & 3) == (((kb >> 2) + (kb >> 4)) & 3);
                const unsigned ca = ona ? (unsigned)((5 * r_ + 3 * ka + 7 * (ka >> 3) + 11 * (ka >> 5)) & 15) : 0u;
                ta4[i >> 3] |= ca << (4 * (i & 7));
                const int cb = (kb + 3 * r_ + (kb >> 3) + 3 * (kb >> 4) + (kb >> 5)) & 7;
                const unsigned fb = !onb ? 0u : ((cb < 4 ? 0x40B83800u : 0x44B030C0u) >> (8 * (cb & 3))) & 255u; tb8[i >> 2] |= (int)(fb << (8 * (i & 3))); }
            const f32x4 tc = mfma_fp4_fp8(ta4, tb8, (f32x4){0.f, 0.f, 0.f, 0.f});
            float bad = 0.f;
#pragma unroll
            for (int j = 0; j < 4; ++j) { const int rw = 4 * kg + j; float e = 0.f;
#pragma unroll 4
                for (int m = 0; m < 32; ++m) { const int k = 4 * m + ((m + (m >> 2)) & 3);
                    const unsigned ca = (unsigned)((5 * rw + 3 * k + 7 * (k >> 3) + 11 * (k >> 5)) & 15); const f32x2 av2_ = CVT_FP4X2(ca | (ca << 4), 0); const float av = av2_[0];
                    const int cb = (k + 3 * r_ + (k >> 3) + 3 * (k >> 4) + (k >> 5)) & 7; const f32x2 bv2_ = cvt_pk_f32_fp8(((cb < 4 ? 0x40B83800u : 0x44B030C0u) >> (8 * (cb & 3))) & 255u, false); const float bv = bv2_[0];
                    e += av * bv; }
                bad += (tc[j] == e) ? 0.f : 1.f; }
            bad = wave_sum(bad);
            if (lane == 0) ((unsigned*)(ws + WS_CTL))[1026] = bad > 0.f ? 1u : 0u;
        }
#pragma unroll 1
        for (int row0 = gw; row0 < NEXP; row0 += 2 * ngw) {
            f32x4 xu[2][4], xv[2][4];
#pragma unroll
            for (int r = 0; r < 2; ++r) { const int row = row0 + r * ngw; const f32x4* su_ = (const f32x4*)(p.peer_u + (size_t)row * D) + lane; const f32x4* sv_ = (const f32x4*)(p.peer_v + (size_t)row * D) + lane;
#pragma unroll
                for (int j = 0; j < 4; ++j) { xu[r][j] = su_[64 * j]; xv[r][j] = sv_[64 * j]; } }
#pragma unroll
            for (int r = 0; r < 2; ++r) { const int row = row0 + r * ngw;
#pragma unroll
                for (int hv_ = 0; hv_ < 2; ++hv_) {
                    float mx = 0.f;
#pragma unroll
                    for (int j = 0; j < 4; ++j) { const f32x4 a4 = hv_ ? xv[r][j] : xu[r][j]; mx = fmaxf(mx, fmaxf(fmaxf(fabsf(a4.x), fabsf(a4.y)), fmaxf(fabsf(a4.z), fabsf(a4.w)))); }
                    mx = wave_max(mx);
                    const float inv = mx > 0.f ? mx * (1.f / 6.f) : 1.f, sc_ = 1.f / inv;
                    const int flip_ = (hv_ && !lowfirst) ? 1 : 0;
                    unsigned short* dst = (unsigned short*)(ws + WS_UV6 + (size_t)row * 1024 + hv_ * 512) + lane;
#pragma unroll
                    for (int j = 0; j < 4; ++j) { const f32x4 a4 = hv_ ? xv[r][j] : xu[r][j]; unsigned pk = 0u;
#pragma unroll
                        for (int i = 0; i < 4; ++i) { const float xs = a4[i]; const float a_ = fabsf(xs) * sc_;
                            const unsigned c_ = (unsigned)(a_ > 0.25f) + (unsigned)(a_ > 0.75f) + (unsigned)(a_ > 1.25f) + (unsigned)(a_ > 1.75f) + (unsigned)(a_ > 2.5f) + (unsigned)(a_ > 3.5f) + (unsigned)(a_ > 5.0f);
                            pk |= (c_ | (xs < 0.f ? 8u : 0u)) << (4 * (i ^ flip_)); }
                        dst[64 * j] = (unsigned short)pk; }
                    if (lane == 0) ((float*)(ws + (hv_ ? WS_VSC : WS_USC)))[row] = inv;
                } }
        }
    }
    for (size_t i = gt; i < (size_t)8 * 10 * 2 * 64; i += ngt) {
        const int ln = (int)(i & 63), tc = (int)((i >> 6) & 1), f = (int)((i >> 7) % 10), hd = (int)((i >> 7) / 10);
        const float* src = f < 2 ? p.w_up : (f < 4 ? p.a_up : p.g_up); const int ks = f < 2 ? f : (f < 4 ? f - 2 : f - 4);
        const int cg = hd * 64 + 32 * tc + (ln & 31);
        float v8[8];
#pragma unroll
        for (int j = 0; j < 8; ++j) v8[j] = src[(16 * ks + 8 * (ln >> 5) + j) * 512 + cg];
        u32x4 o; o.x = pk2(v8[0], v8[1]); o.y = pk2(v8[2], v8[3]); o.z = pk2(v8[4], v8[5]); o.w = pk2(v8[6], v8[7]);
        ((u32x4*)(ws + WS_FRG))[i] = o;
    }
    rms_rows(p.x, p.ln1_g, (unsigned short*)(ws + WS_H), bid * (NTHR / 64) + (TID >> 6), nblk * (NTHR / 64));
}

constexpr int MP = 72;
constexpr int SLOTB = 64 * MP * 2;
constexpr int LP = 168;
constexpr int RW_PAR = 0;
constexpr int RW_SB = 4096;
constexpr int RW_AT = RW_SB + SLOTB, RW_RT = RW_AT + SLOTB, RW_BHT = RW_RT + SLOTB, RW_KHT = RW_BHT + SLOTB, RW_VT = RW_KHT + SLOTB, RW_GM = RW_VT + SLOTB;
constexpr int RW_RA = RW_GM + SLOTB;
constexpr int RW_P = RW_RA, RW_PT = RW_P + SLOTB, RW_TM = RW_PT + SLOTB, RW_AAK = RW_TM + SLOTB, RW_ARB = RW_AAK + SLOTB, RW_ARK = RW_ARB + SLOTB;
constexpr int RW_RB = RW_RA + 6 * SLOTB;
constexpr int RW_BH = RW_RB, RW_KH = RW_RB + SLOTB, RW_WT = RW_RB, RW_UT = RW_RB + SLOTB;
constexpr int RW_TOT = RW_RB + 3 * SLOTB;
constexpr int RW_BON = RW_TOT + 2048;
constexpr int RW_GC = RW_BON + 256;
constexpr int RW_END = RW_GC + 256;
static_assert(RW_END <= 155648, "rwkv LDS map");

__device__ __forceinline__ f32x16 zero16() { f32x16 z;
#pragma unroll
    for (int i = 0; i < 16; ++i) z[i] = 0.f; return z; }
__device__ __forceinline__ f32x16 tile_mm(f32x16 acc, const unsigned short* A, const unsigned short* B, int tr, int tc, int lane) {
    const unsigned short* ap = A + (32 * tr + (lane & 31)) * MP + 8 * (lane >> 5);
    const unsigned short* bp = B + (32 * tc + (lane & 31)) * MP + 8 * (lane >> 5);
#pragma unroll
    for (int ks = 0; ks < 4; ++ks) acc = mfma32(*(const bf16x8*)(ap + 16 * ks), *(const bf16x8*)(bp + 16 * ks), acc);
    return acc;
}
__device__ __forceinline__ void store_rm(const f32x16& acc, unsigned short* M, int tr, int tc, int lane) {
    unsigned short* base = M + (32 * tr + 4 * (lane >> 5)) * MP + 32 * tc + (lane & 31);
#pragma unroll
    for (int r = 0; r < 16; ++r) base[((r & 3) + 8 * (r >> 2)) * MP] = (unsigned short)f2bf(acc[r]);
}
__device__ __forceinline__ void store_tr(const f32x16& acc, unsigned short* MT, int tr, int tc, int lane) {
    unsigned short* base = MT + (32 * tc + (lane & 31)) * MP + 32 * tr + 4 * (lane >> 5);
#pragma unroll
    for (int g4 = 0; g4 < 4; ++g4) { u32x2 w; w.x = pk2(acc[4 * g4], acc[4 * g4 + 1]); w.y = pk2(acc[4 * g4 + 2], acc[4 * g4 + 3]); *(u32x2*)(base + 8 * g4) = w; }
}
__device__ __forceinline__ float fexp(float x) { return __expf(x); }

__device__ __forceinline__ void rwkv_unit(const Params& p, int b, int h, char* smem) {
    float* par = (float*)(smem + RW_PAR);
    unsigned short* Sb = (unsigned short*)(smem + RW_SB);
    unsigned short* At = (unsigned short*)(smem + RW_AT); unsigned short* Rt = (unsigned short*)(smem + RW_RT);
    unsigned short* BhT = (unsigned short*)(smem + RW_BHT); unsigned short* KhT = (unsigned short*)(smem + RW_KHT);
    unsigned short* VT = (unsigned short*)(smem + RW_VT); unsigned short* Gm = (unsigned short*)(smem + RW_GM);
    float* lres = (float*)(smem + RW_RA); float* Ol = (float*)(smem + RW_RA);
    unsigned short* Pm = (unsigned short*)(smem + RW_P); unsigned short* PT = (unsigned short*)(smem + RW_PT); unsigned short* Tm = (unsigned short*)(smem + RW_TM);
    unsigned short* Aak = (unsigned short*)(smem + RW_AAK); unsigned short* Arb = (unsigned short*)(smem + RW_ARB); unsigned short* Ark = (unsigned short*)(smem + RW_ARK);
    unsigned short* lora = (unsigned short*)(smem + RW_RB); unsigned short* Bh = (unsigned short*)(smem + RW_BH); unsigned short* Kh = (unsigned short*)(smem + RW_KH);
    unsigned short* WT = (unsigned short*)(smem + RW_WT); unsigned short* UT = (unsigned short*)(smem + RW_UT);
    float* tot = (float*)(smem + RW_TOT); float* bon = (float*)(smem + RW_BON); float* gC = (float*)(smem + RW_GC);
    const unsigned short* P = (const unsigned short*)(p.ws + WS_P);
    unsigned short* Y = (unsigned short*)(p.ws + WS_Y);
    int tid = TID; OPAQUE(tid);
    const int w = tid >> 6; int lane = tid & 63;
    const int ch = tid & 63, tg = w;
    const int q4 = w & 3, qtr = q4 >> 1, qtc = q4 & 1;
    if (tid < 64) {
        const int c = h * 64 + tid;
        par[tid] = p.mu_shift[c]; par[64 + tid] = p.mu_shift[512 + c]; par[128 + tid] = p.mu_shift[1024 + c];
        par[352 + tid] = p.w0[c]; par[416 + tid] = p.a0[c]; par[480 + tid] = p.k_k[c]; par[544 + tid] = p.k_a[c]; par[608 + tid] = p.r_k[c]; par[672 + tid] = p.lnx_w[c]; par[736 + tid] = p.lnx_b[c];
    }
    if (tid < 160) par[192 + tid] = p.mu_shift[1536 + tid];
    for (int i = tid; i < 64 * MP; i += NTHR) Sb[i] = 0;
    const bf16x8* frg = (const bf16x8*)(p.ws + WS_FRG) + ((size_t)(h * 10 + (w < 4 ? 0 : 4)) * 2 + qtc) * 64 + (tid & 63);
    f32x16 sreg = zero16();
    const float mu_r = p.mu_shift[h * 64 + ch], mu_k = p.mu_shift[512 + h * 64 + ch], mu_v = p.mu_shift[1024 + h * 64 + ch];
    const float c_w0 = p.w0[h * 64 + ch], c_a0 = p.a0[h * 64 + ch], c_kk = p.k_k[h * 64 + ch], c_ka = p.k_a[h * 64 + ch], c_rk = p.r_k[h * 64 + ch], c_lw = p.lnx_w[h * 64 + ch], c_lb = p.lnx_b[h * 64 + ch];
    u32x4 lcu[3], lpv[3];
#define RW_LOAD_LORA(SS) do { _Pragma("unroll") for (int qi = 0; qi < 3; ++qi) { int it_ = tid + NTHR * qi; it_ = it_ < 64 * 20 ? it_ : 64 * 20 - 1; const int tok_ = it_ / 20, c_ = it_ - tok_ * 20; \
        const unsigned short* row_ = P + ((size_t)b * SEQ + (SS) + tok_) * PCOLS + PC_LORA + 8 * c_; lcu[qi] = *(const u32x4*)row_; lpv[qi] = *(const u32x4*)(row_ - (((SS) + tok_) > 0 ? PCOLS : 0)); } } while (0)
#define RW_LOAD_RKV(SS) do { _Pragma("unroll") for (int i_ = 0; i_ < 9; ++i_) { int sp_ = (SS) + 8 * tg - 1 + i_; sp_ = sp_ < 0 ? 0 : sp_; const unsigned short* row_ = P + ((size_t)b * SEQ + sp_) * PCOLS + h * 64 + ch; \
        rr[i_] = bfl(row_[PC_R]); kr[i_] = bfl(row_[PC_K]); vr[i_] = bfl(row_[PC_V]); } } while (0)
    RW_LOAD_LORA(0);
    BSYNC();
#pragma unroll 1
    for (int s0 = 0; s0 < SEQ; s0 += 64) {
        const size_t tbase = (size_t)b * SEQ + s0;
        OPAQUE(lane);
        const int hh = lane >> 5, l31 = lane & 31;
        float rr[9], kr[9], vr[9];
        RW_LOAD_RKV(s0);
        bf16x8 fr[6];
#pragma unroll
        for (int f = 0; f < 6; ++f) fr[f] = frg[128 * (w < 4 ? (f & 3) : f)];
#pragma unroll
        for (int qi = 0; qi < 3; ++qi) {
            const int it = tid + NTHR * qi;
            if (it < 64 * 20) {
                const int tok = it / 20, c = it - tok * 20;
                const u32x4 cu = lcu[qi]; u32x4 pv = lpv[qi];
                if (s0 + tok == 0) pv = (u32x4){0u, 0u, 0u, 0u};
                float o8[8];
#pragma unroll
                for (int j = 0; j < 4; ++j) {
                    const unsigned cw = cu[j], pw = pv[j];
                    const float c0 = bf_lo(cw), c1 = bf_hi(cw), p0 = bf_lo(pw), p1 = bf_hi(pw);
                    const float m0 = par[192 + 8 * c + 2 * j], m1 = par[192 + 8 * c + 2 * j + 1];
                    o8[2 * j] = c0 + m0 * (p0 - c0); o8[2 * j + 1] = c1 + m1 * (p1 - c1);
                }
                if (c < 4) {
#pragma unroll
                    for (int j = 0; j < 8; ++j) { const float e2 = fexp(2.f * o8[j]); o8[j] = 1.f - 2.f * frcp(e2 + 1.f); }
                } else if (c >= 8) {
#pragma unroll
                    for (int j = 0; j < 8; ++j) o8[j] = frcp(1.f + fexp(-o8[j]));
                }
                u32x4 ow; ow.x = pk2(o8[0], o8[1]); ow.y = pk2(o8[2], o8[3]); ow.z = pk2(o8[4], o8[5]); ow.w = pk2(o8[6], o8[7]);
                *(u32x4*)(lora + tok * LP + 8 * c) = ow;
            }
        }
        { const int sn = (s0 + 64 < SEQ) ? s0 + 64 : s0; RW_LOAD_LORA(sn); }
        BSYNC();
        {
            const unsigned short* ap = lora + (32 * qtr + l31) * LP + 8 * hh;
            if (w < 4) {
                f32x16 aw = zero16(), aa = zero16();
#pragma unroll
                for (int ks = 0; ks < 2; ++ks) { aw = mfma32(*(const bf16x8*)(ap + 16 * ks), fr[ks], aw); aa = mfma32(*(const bf16x8*)(ap + 32 + 16 * ks), fr[2 + ks], aa); }
                { float* lb = lres + (32 * qtr + 4 * hh) * 64 + 32 * qtc + l31;
#pragma unroll
                for (int r = 0; r < 16; ++r) { lb[((r & 3) + 8 * (r >> 2)) * 64] = aw[r]; lb[4096 + ((r & 3) + 8 * (r >> 2)) * 64] = aa[r]; } }
            } else {
                f32x16 ag = zero16();
#pragma unroll
                for (int ks = 0; ks < 6; ++ks) ag = mfma32(*(const bf16x8*)(ap + 64 + 16 * ks), fr[ks], ag);
                store_rm(ag, Gm, qtr, qtc, lane);
            }
        }
        BSYNC();
        {
            float lw[8], kkv[8], bb[8], km[8], rs[8], vs[8], csl[8];
            float cs = 0.f;
            if (s0 + 8 * tg == 0) { rr[0] = 0.f; kr[0] = 0.f; vr[0] = 0.f; }
#pragma unroll
            for (int i = 0; i < 8; ++i) {
                const int t = 8 * tg + i;
                rs[i] = rr[i + 1] + mu_r * (rr[i] - rr[i + 1]);
                const float ksh = kr[i + 1] + mu_k * (kr[i] - kr[i + 1]);
                vs[i] = vr[i + 1] + mu_v * (vr[i] - vr[i + 1]);
                const float z = -(c_w0 + lres[t * 64 + ch]);
                const float sp = fmaxf(z, 0.f) + __logf(1.f + fexp(-fabsf(z)));
                lw[i] = -fexp(-sp - 0.5f);
                const float alpha = frcp(1.f + fexp(-(c_a0 + lres[4096 + t * 64 + ch])));
                const float kx = ksh * c_kk;
                kkv[i] = kx * frsq(fmaxf(wave_sum(kx * kx), 1e-24f));
                bb[i] = kkv[i] * alpha;
                km[i] = ksh * (1.f + (alpha - 1.f) * c_ka);
                const float bo = wave_sum(rs[i] * km[i] * c_rk);
                if (ch == 0) bon[t] = bo;
                cs += lw[i]; csl[i] = cs;
            }
            tot[tg * 64 + ch] = cs;
            BSYNC();
            float pre = 0.f;
#pragma unroll
            for (int g = 0; g < 8; ++g) { const float tv = tot[g * 64 + ch]; pre += (g < tg) ? tv : 0.f; }
            u32x4 bt, kt, vt; float tb[8], tk[8];
#pragma unroll
            for (int i = 0; i < 8; ++i) {
                const int t = 8 * tg + i;
                const float c = pre + csl[i];
                const float gt = fexp(c), gp = fexp(c - lw[i]), gi = fexp(-c);
                At[t * MP + ch] = (unsigned short)f2bf(-kkv[i] * gp);
                Rt[t * MP + ch] = (unsigned short)f2bf(rs[i] * gt);
                tb[i] = bb[i] * gi; tk[i] = km[i] * gi;
                Bh[t * MP + ch] = (unsigned short)f2bf(tb[i]);
                Kh[t * MP + ch] = (unsigned short)f2bf(tk[i]);
            }
            bt.x = pk2(tb[0], tb[1]); bt.y = pk2(tb[2], tb[3]); bt.z = pk2(tb[4], tb[5]); bt.w = pk2(tb[6], tb[7]);
            kt.x = pk2(tk[0], tk[1]); kt.y = pk2(tk[2], tk[3]); kt.z = pk2(tk[4], tk[5]); kt.w = pk2(tk[6], tk[7]);
            vt.x = pk2(vs[0], vs[1]); vt.y = pk2(vs[2], vs[3]); vt.z = pk2(vs[4], vs[5]); vt.w = pk2(vs[6], vs[7]);
            *(u32x4*)(BhT + ch * MP + 8 * tg) = bt; *(u32x4*)(KhT + ch * MP + 8 * tg) = kt; *(u32x4*)(VT + ch * MP + 8 * tg) = vt;
            if (tg == 7) gC[ch] = fexp(pre + csl[7]);
        }
        BSYNC();
        f32x16 treg[2];
        treg[0] = zero16(); treg[1] = zero16();
        {
            const int prod = w >> 1, tr = w & 1;
            const unsigned short* Lm = prod < 2 ? At : Rt; const unsigned short* Rm = (prod & 1) ? Kh : Bh;
            unsigned short* dst = prod == 0 ? Pm : (prod == 1 ? Aak : (prod == 2 ? Arb : Ark));
#pragma unroll
            for (int tc = 0; tc < 2; ++tc) {
                f32x16 acc = zero16();
                if (tc <= tr) acc = tile_mm(acc, Lm, Rm, tr, tc, lane);
                { const int dlt = 32 * tc + l31 - 32 * tr - 4 * hh - (prod < 2 ? 0 : 1);
#pragma unroll
                for (int r = 0; r < 16; ++r) acc[r] = (dlt < (r & 3) + 8 * (r >> 2)) ? acc[r] : 0.f; }
                store_rm(acc, dst, tr, tc, lane);
                if (prod == 0) {
                    store_tr(acc, PT, tr, tc, lane);
                    { const int dl2 = 32 * tc + l31 - 32 * tr - 4 * hh;
#pragma unroll
                    for (int r = 0; r < 16; ++r) acc[r] += (dl2 == (r & 3) + 8 * (r >> 2)) ? 1.f : 0.f; }
                    store_rm(acc, Tm, tr, tc, lane);
                    treg[tc] = acc;
                }
            }
        }
        BSYNC();
        if (w >= 4) { f32x16 acc = zero16(); acc = tile_mm(acc, At, Sb, qtr, qtc, lane); acc = tile_mm(acc, Aak, VT, qtr, qtc, lane); store_tr(acc, WT, qtr, qtc, lane); }
#pragma unroll 1
        for (int j = 1; j <= 6; ++j) {
            const int tr = w & 1;
            const bool sq = (w == 2 || w == 3) && j <= 5, tu = w < 2 && j >= 2;
            if (sq) {
                treg[0] = tile_mm(zero16(), Pm, PT, tr, 0, lane);
                if (tr == 1) treg[1] = tile_mm(zero16(), Pm, PT, tr, 1, lane);
            }
            if (tu) {
                treg[0] = tile_mm(treg[0], Tm, PT, tr, 0, lane);
                if (tr == 1) treg[1] = tile_mm(treg[1], Tm, PT, tr, 1, lane);
            }
            BSYNC();
            if (sq) {
                store_rm(treg[0], Pm, tr, 0, lane); store_tr(treg[0], PT, tr, 0, lane);
                if (tr == 1) { store_rm(treg[1], Pm, tr, 1, lane); store_tr(treg[1], PT, tr, 1, lane); }
            }
            if (tu) {
                store_rm(treg[0], Tm, tr, 0, lane);
                if (tr == 1) store_rm(treg[1], Tm, tr, 1, lane);
            }
            BSYNC();
        }
        if (w < 4) { f32x16 acc = zero16(); acc = tile_mm(acc, Tm, WT, qtr, qtc, lane); store_tr(acc, UT, qtr, qtc, lane); }
        BSYNC();
        f32x16 oacc = zero16();
        if (w < 4) { oacc = tile_mm(oacc, Rt, Sb, qtr, qtc, lane); oacc = tile_mm(oacc, Arb, UT, qtr, qtc, lane); oacc = tile_mm(oacc, Ark, VT, qtr, qtc, lane); }
        else {
            sreg = tile_mm(sreg, UT, BhT, qtr, qtc, lane); sreg = tile_mm(sreg, VT, KhT, qtr, qtc, lane);
            const float gc = gC[32 * qtc + l31];
#pragma unroll
            for (int r = 0; r < 16; ++r) sreg[r] *= gc;
        }
        BSYNC();
        if (w < 4) {
            { float* ob = Ol + (32 * qtr + 4 * hh) * 64 + 32 * qtc + l31;
#pragma unroll
            for (int r = 0; r < 16; ++r) ob[((r & 3) + 8 * (r >> 2)) * 64] = oacc[r]; }
        } else store_rm(sreg, Sb, qtr, qtc, lane);
        BSYNC();
#pragma unroll
        for (int i = 0; i < 8; ++i) {
            const int t = 8 * tg + i;
            const float o = Ol[t * 64 + ch];
            const float mean = wave_sum(o) * (1.f / 64.f);
            const float dv = o - mean;
            const float var = wave_sum(dv * dv) * (1.f / 64.f);
            float y = dv * frsq(var + LNX_EPS) * c_lw + c_lb;
            y = (y + bon[t] * bfl(VT[ch * MP + t])) * bfl(Gm[t * MP + ch]);
            Y[(tbase + t) * D + h * 64 + ch] = (unsigned short)f2bf(y);
        }
        BSYNC();
    }
}

constexpr int KPITCH = 72, VPITCH = 260;
__device__ __forceinline__ void attn_unit(const Params& p, int b, int n, char* smem) {
    unsigned short* Kl = (unsigned short*)smem;
    unsigned short* Vt = Kl + 2 * 256 * KPITCH;
    float* ssl = (float*)(Vt + 2 * 64 * VPITCH);
    float* rstdl = ssl + 1024;
    float* wsf = rstdl + 128;
    unsigned short* ostg = (unsigned short*)(wsf + 256) + (TID >> 6) * (32 * 32);
    const unsigned short* P = (const unsigned short*)(p.ws + WS_P);
    unsigned short* Y = (unsigned short*)(p.ws + WS_Y);
    const int tid = TID, lane = tid & 63, w = tid >> 6, q = lane & 31, hh = lane >> 5, g = w >> 2;
    const long tb = (long)b * SEQ + (long)(n - 1) * 128;
#pragma unroll
    for (int i = tid; i < 4096; i += NTHR) {
        const int c = i & 7, kj = (i >> 3) & 255, gg = i >> 11;
        const bool valid = (n > 0) || (kj >= 128);
        const unsigned short* row = P + (size_t)(valid ? tb + kj : tb + 128 + (kj & 127)) * PCOLS;
        u32x4 kv = *(const u32x4*)(row + PC_AK + gg * 64 + c * 8), vv = *(const u32x4*)(row + PC_AV + gg * 64 + c * 8);
        if (!valid) { kv = (u32x4){0u, 0u, 0u, 0u}; vv = (u32x4){0u, 0u, 0u, 0u}; }
        *(u32x4*)(Kl + (gg * 256 + kj) * KPITCH + c * 8) = kv;
        unsigned short* vd = Vt + (gg * 64 + c * 8) * VPITCH + kj;
        vd[0 * VPITCH] = (unsigned short)(vv.x & 0xffff); vd[1 * VPITCH] = (unsigned short)(vv.x >> 16);
        vd[2 * VPITCH] = (unsigned short)(vv.y & 0xffff); vd[3 * VPITCH] = (unsigned short)(vv.y >> 16);
        vd[4 * VPITCH] = (unsigned short)(vv.z & 0xffff); vd[5 * VPITCH] = (unsigned short)(vv.z >> 16);
        vd[6 * VPITCH] = (unsigned short)(vv.w & 0xffff); vd[7 * VPITCH] = (unsigned short)(vv.w >> 16);
    }
    BSYNC();
    const float sink = p.attn_sinks[w];
    const long tq_blk = (long)b * SEQ + (long)n * 128;
    for (int it = 0; it < 4; ++it) {
        bf16x8 qf[4];
#pragma unroll
        for (int ks = 0; ks < 4; ++ks) qf[ks] = *(const bf16x8*)(P + (size_t)(tq_blk + 32 * it + q) * PCOLS + PC_Q + w * 64 + 16 * ks + 8 * hh);
        f32x16 pb[5];
        float mloc = sink;
        const int iq = 32 * it + q;
#pragma unroll
        for (int bi = 0; bi < 5; ++bi) {
            const int jb = it + bi;
            const bool active = (n > 0) || (jb >= 4);
#pragma unroll
            for (int r = 0; r < 16; ++r) pb[bi][r] = 0.f;
            if (active) {
#pragma unroll
                for (int ks = 0; ks < 4; ++ks) { const bf16x8 kf = *(const bf16x8*)(Kl + (g * 256 + 32 * jb + q) * KPITCH + 16 * ks + 8 * hh); pb[bi] = mfma32(kf, qf[ks], pb[bi]); }
            }
#pragma unroll
            for (int r = 0; r < 16; ++r) {
                const int kj = 32 * jb + crow(r, hh);
                const bool ok = active && (kj >= iq + 1) && (kj <= iq + 128);
                const float s = ok ? pb[bi][r] * 0.125f : -1e30f;
                pb[bi][r] = s; mloc = fmaxf(mloc, s);
            }
        }
        mloc = fmaxf(mloc, xor32_f(mloc, lane));
        float lsum = 0.f;
#pragma unroll
        for (int bi = 0; bi < 5; ++bi)
#pragma unroll
            for (int r = 0; r < 16; ++r) { const float e = expf(pb[bi][r] - mloc); pb[bi][r] = e; lsum += e; }
        lsum += xor32_f(lsum, lane);
        lsum += expf(sink - mloc);
        f32x16 o[2];
#pragma unroll
        for (int r = 0; r < 16; ++r) { o[0][r] = 0.f; o[1][r] = 0.f; }
#pragma unroll
        for (int bi = 0; bi < 5; ++bi) {
            const int jb = it + bi;
            const bool active = (n > 0) || (jb >= 4);
            if (active) {
#pragma unroll
                for (int s2 = 0; s2 < 2; ++s2) {
                    bf16x8 pa;
#pragma unroll
                    for (int j = 0; j < 8; ++j) pa[j] = (short)f2bf(pb[bi][8 * s2 + j]);
#pragma unroll
                    for (int dt = 0; dt < 2; ++dt) {
                        const unsigned short* vp = Vt + (g * 64 + 32 * dt + q) * VPITCH + 32 * jb + 16 * s2 + 4 * hh;
                        const bf16x4 lo = *(const bf16x4*)vp, hi = *(const bf16x4*)(vp + 8);
                        const bf16x8 vf = (bf16x8){lo[0], lo[1], lo[2], lo[3], hi[0], hi[1], hi[2], hi[3]};
                        o[dt] = mfma32(pa, vf, o[dt]);
                    }
                }
            }
        }
        if (hh == 0) wsf[w * 32 + q] = 1.f / lsum;
        WSYNC();
        float ss[16];
#pragma unroll
        for (int r = 0; r < 16; ++r) { const float il = wsf[w * 32 + crow(r, hh)]; o[0][r] *= il; o[1][r] *= il; ss[r] = o[0][r] * o[0][r] + o[1][r] * o[1][r]; }
        WSYNC();
#pragma unroll
        for (int r = 0; r < 16; ++r) { const float s = half_sum(ss[r]); if (q == 0) ssl[(32 * it + crow(r, hh)) * 8 + w] = s; }
#pragma unroll
        for (int dt = 0; dt < 2; ++dt) {
            unsigned short* tb = ostg + (4 * hh) * 32 + q;
#pragma unroll
            for (int r = 0; r < 16; ++r) tb[((r & 3) + 8 * (r >> 2)) * 32] = (unsigned short)f2bf(o[dt][r]);
            WSYNC();
            const int rq = lane >> 1, hc = lane & 1;
            const u32x4 v0 = *(const u32x4*)(ostg + rq * 32 + 16 * hc), v1 = *(const u32x4*)(ostg + rq * 32 + 16 * hc + 8);
            unsigned short* yp = Y + (size_t)(tq_blk + 32 * it + rq) * D + 512 + w * 64 + 32 * dt + 16 * hc;
            *(u32x4*)yp = v0; *(u32x4*)(yp + 8) = v1;
            WSYNC();
        }
    }
    BSYNC();
    if (tid < 128) { float s = 0.f;
#pragma unroll
        for (int j = 0; j < 8; ++j) s += ssl[tid * 8 + j];
        rstdl[tid] = 1.0f / sqrtf(s * (1.f / 512.f) + RMS_EPS); }
    BSYNC();
    for (int i = tid; i < 128 * 64; i += NTHR) {
        const int qi = i >> 6, c8 = (i & 63) * 8;
        unsigned short* yp = Y + (size_t)(tq_blk + qi) * D + 512 + c8;
        const u32x4 v = *(const u32x4*)yp; const float rs = rstdl[qi];
        const f32x4 ga = *(const f32x4*)(p.attn_norm_g + c8), gb = *(const f32x4*)(p.attn_norm_g + c8 + 4);
        u32x4 ov;
        ov.x = pk2(bf_lo(v.x) * rs * ga[0], bf_hi(v.x) * rs * ga[1]); ov.y = pk2(bf_lo(v.y) * rs * ga[2], bf_hi(v.y) * rs * ga[3]);
        ov.z = pk2(bf_lo(v.z) * rs * gb[0], bf_hi(v.z) * rs * gb[1]); ov.w = pk2(bf_lo(v.w) * rs * gb[2], bf_hi(v.w) * rs * gb[3]);
        *(u32x4*)yp = ov;
    }
    BSYNC();
}

__device__ __forceinline__ void ce_desc(float& a, float& b) { const float hi = fmaxf(a, b), lo = fminf(a, b); a = hi; b = lo; }
__device__ __forceinline__ void sort16_desc(float (&k)[16]) {
#pragma unroll
    for (int size = 2; size <= 16; size *= 2)
#pragma unroll
        for (int stride = size / 2; stride > 0; stride /= 2)
#pragma unroll
            for (int i = 0; i < 16; ++i) { const int j = i ^ stride; if (j > i) { if ((i & size) == 0) ce_desc(k[i], k[j]); else ce_desc(k[j], k[i]); } }
}
__device__ __forceinline__ void merge_top16(float (&g)[16], const float (&s)[16]) {
#pragma unroll
    for (int i = 0; i < 16; ++i) g[i] = fmaxf(g[i], s[15 - i]);
#pragma unroll
    for (int stride = 8; stride > 0; stride /= 2)
#pragma unroll
        for (int i = 0; i < 16; ++i) { const int j = i ^ stride; if (j > i) ce_desc(g[i], g[j]); }
}
__device__ __forceinline__ float key7(float v, unsigned n) { return __builtin_bit_cast(float, (__builtin_bit_cast(unsigned, v) & ~127u) | (127u - n)); }
__device__ __forceinline__ float clean7(float k) { return __builtin_bit_cast(float, __builtin_bit_cast(unsigned, k) & ~127u); }
__device__ __forceinline__ float key8(float v, unsigned code) { return __builtin_bit_cast(float, (__builtin_bit_cast(unsigned, v) & ~255u) | code); }
__device__ __forceinline__ void topk_half(float* S, float* lists, int trow0, int hd, int* IDX, float* GATE) {
    const int tid = TID, row = tid & 127, grp = (tid >> 7) & 1, half = tid >> 8;
    float g[16];
    {
        const float* src = S + row * 260 + grp * 128 + half * 64;
#pragma unroll 1
        for (int q = 0; q < 4; ++q) {
            float sgrp[16];
#pragma unroll
            for (int c = 0; c < 16; c += 4) { const f32x4 v = *(const f32x4*)(src + 16 * q + c); const float v0 = v[0], v1 = v[1], v2 = v[2], v3 = v[3];
                const unsigned nb = (unsigned)(half * 64 + 16 * q + c);
                sgrp[c] = key7(v0, nb); sgrp[c + 1] = key7(v1, nb + 1); sgrp[c + 2] = key7(v2, nb + 2); sgrp[c + 3] = key7(v3, nb + 3); }
            sort16_desc(sgrp);
            if (q == 0) {
#pragma unroll
                for (int i = 0; i < 16; ++i) g[i] = sgrp[i];
            } else merge_top16(g, sgrp);
        }
    }
    float* slot = lists + (row * 2 + grp) * 16;
    if (half == 1) {
#pragma unroll
        for (int i = 0; i < 16; ++i) slot[i] = g[i];
    }
    BSYNC();
    if (half == 0) {
        float o[16];
#pragma unroll
        for (int i = 0; i < 16; ++i) o[i] = slot[i];
        merge_top16(g, o);
#pragma unroll
        for (int i = 0; i < 16; ++i) slot[i] = g[i];
    }
    BSYNC();
    if (tid < 128) {
        const float* al = lists + (row * 2) * 16; const float* bl = al + 16;
        float a[16], bs[16];
#pragma unroll
        for (int i = 0; i < 16; ++i) { a[i] = clean7(g[i]); bs[i] = clean7(bl[i]); }
        const float NEGK = -3.0e38f;
        float m0[16], m1[16];
#pragma unroll
        for (int j = 0; j < 16; ++j) m0[j] = key8(a[0] + bs[j], (unsigned)j);
#pragma unroll
        for (int j = 0; j < 8; ++j) m1[j] = key8(a[1] + bs[j], (unsigned)(16 + j));
#pragma unroll
        for (int j = 0; j < 5; ++j) m1[8 + j] = key8(a[2] + bs[j], (unsigned)(32 + j));
        m1[13] = key8(a[8] + bs[0], 128u); m1[14] = key8(a[9] + bs[0], 144u); m1[15] = key8(a[10] + bs[0], 160u);
        sort16_desc(m1); merge_top16(m0, m1);
#pragma unroll
        for (int j = 0; j < 4; ++j) m1[j] = key8(a[3] + bs[j], (unsigned)(48 + j));
#pragma unroll
        for (int j = 0; j < 3; ++j) m1[4 + j] = key8(a[4] + bs[j], (unsigned)(64 + j));
#pragma unroll
        for (int j = 0; j < 2; ++j) { m1[7 + j] = key8(a[5] + bs[j], (unsigned)(80 + j)); m1[9 + j] = key8(a[6] + bs[j], (unsigned)(96 + j)); m1[11 + j] = key8(a[7] + bs[j], (unsigned)(112 + j)); }
        m1[13] = key8(a[11] + bs[0], 176u); m1[14] = key8(a[12] + bs[0], 192u); m1[15] = key8(a[13] + bs[0], 208u);
        sort16_desc(m1); merge_top16(m0, m1);
        { const float c0 = key8(a[14] + bs[0], 224u), c1 = key8(a[15] + bs[0], 240u);
          m1[0] = fmaxf(c0, c1); m1[1] = fminf(c0, c1);
#pragma unroll
          for (int i = 2; i < 16; ++i) m1[i] = NEGK; }
        merge_top16(m0, m1);
        float den = 0.f;
        const float mx = __builtin_bit_cast(float, __builtin_bit_cast(unsigned, m0[0]) & ~255u);
#pragma unroll
        for (int k = 0; k < 16; ++k) { const float sv = __builtin_bit_cast(float, __builtin_bit_cast(unsigned, m0[k]) & ~255u); den += expf(sv - mx); }
        const float inv = 1.f / den;
        int* ip = IDX + (size_t)(trow0 + row) * 128 + hd * 16; float* gp = GATE + (size_t)(trow0 + row) * 128 + hd * 16;
#pragma unroll
        for (int k = 0; k < 16; ++k) {
            const unsigned kb = __builtin_bit_cast(unsigned, m0[k]); const unsigned code = kb & 255u;
            const unsigned abits = __builtin_bit_cast(unsigned, al[code >> 4]), bbits = __builtin_bit_cast(unsigned, bl[code & 15u]);
            ip[k] = (127 - (int)(abits & 127u)) * 128 + (127 - (int)(bbits & 127u)); gp[k] = expf(__builtin_bit_cast(float, kb & ~255u) - mx) * inv;
        }
    }
    BSYNC();
}

__device__ __forceinline__ float gelu_erf(float v) { return 0.5f * v * (1.f + erff(v * 0.70710678118654752f)); }
__device__ __forceinline__ float reduce4(const float (&d)[4], int lane) {
    const bool b5 = (lane & 32) != 0, b4 = (lane & 16) != 0;
    float r[2];
#pragma unroll
    for (int i = 0; i < 2; ++i) { const float x = b5 ? d[2 + i] : d[i], y = b5 ? d[i] : d[2 + i]; r[i] = x + xor32_f(y, lane); }
    const float t = (b4 ? r[1] : r[0]) + xor16_f(b4 ? r[0] : r[1], lane);
    return row_sum(t);
}
__device__ __forceinline__ float gelu_fast(float v) {
    const float t = frcp(fabsf(v) * 0.2316418882f + 1.0f);
    float q = t * 0.5307027145f + (-0.7265760135f); q = q * t + 0.7107068705f; q = q * t + (-0.142248368f); q = q * t + 0.127414796f; q = q * t;
    const float m = v * (q * fexp2(v * v * (-0.72134752044f)));
    return v < 0.f ? m : v - m;
}
constexpr int PEER_UP = 528;
constexpr int PEER_URING = 16 * PEER_UP;
constexpr int PEER_VRING = 2048;
constexpr int PEER_LIST = 3 * 1024;
constexpr int PEER_XROW = 2 * 2048;
constexpr int PEER_WAVE = PEER_URING + PEER_VRING + PEER_LIST + PEER_XROW;
#ifndef PEER_MIDBAR
#define PEER_MIDBAR 0
#endif
static_assert((NTHR / 64) * PEER_WAVE + 8192 <= 163840, "PEER LDS map");
__device__ __forceinline__ void peer_phase(const Params& p, int bid, int nblk, float* OUT_, char* smem, int emask_ = 0x3fff, const int pass = 1) {
#if DUP & 128
#define OUT (pass ? p.out : (float*)(p.ws + WS_P))
#define emask (pass ? 0x3fff : PROBE_EMASK)
#else
#define OUT OUT_
#define emask emask_
#endif
    int lane = TID & 63; const int wv = rfl_i(TID >> 6);
    const int gw = bid * (NTHR / 64) + wv, ngw = nblk * (NTHR / 64);
    char* uring = smem + wv * PEER_WAVE; char* vring = uring + PEER_URING;
    unsigned* se = (unsigned*)(vring + PEER_VRING); float* su = (float*)(se + 256); float* sc = su + 256;
    unsigned short* xrowA = (unsigned short*)((char*)se + PEER_LIST); unsigned short* xrowB = xrowA + 1024;
    unsigned* keys = (unsigned*)uring; unsigned char* h8A = (unsigned char*)vring; unsigned char* h8B = h8A + 1024;
    const rsrc_t rU = make_rsrc(p.ws + WS_UV6, NEXP * 1024);
    const unsigned* ctl = (const unsigned*)(p.ws + WS_CTL);
    const float poison_scale = (ctl[1025] != 0u || ctl[1026] != 0u) ? 2.f : 1.f;
    const float* USC = (const float*)(p.ws + WS_USC); const float* VSC = (const float*)(p.ws + WS_VSC);
    const int* IDX = (const int*)(p.ws + WS_IDX); const float* GATE = (const float*)(p.ws + WS_GATE);
    const unsigned short* X1 = (const unsigned short*)(p.ws + WS_H);
    float* g2l = (float*)(smem + (NTHR / 64) * PEER_WAVE); float* gfl = g2l + D;
    for (int i_ = TID; i_ < D / 4; i_ += NTHR) { ((f32x4*)g2l)[i_] = ((const f32x4*)p.ln2_g)[i_]; ((f32x4*)gfl)[i_] = ((const f32x4*)p.lnf_g)[i_]; }
    BSYNC();
#define PEER_ROWS(b, O) do { const unsigned* sp_ = se + 16 * (b); \
        _Pragma("unroll") for (int j_ = 0; j_ < 4; ++j_) { const u32x4 e_ = *(const u32x4*)(sp_ + 4 * j_); O[4 * j_] = rfl_i((int)e_.x); O[4 * j_ + 1] = rfl_i((int)e_.y); O[4 * j_ + 2] = rfl_i((int)e_.z); O[4 * j_ + 3] = rfl_i((int)e_.w); } } while (0)
#define PEER_ISSUE_U(O) do { if (lane < 32) { _Pragma("unroll") for (int r_ = 0; r_ < 16; ++r_) dma_row(rU, uring + PEER_UP * r_, vo16, O[r_]); } } while (0)
#define PEER_LOAD_V(IDX_, VQ) do { const int vo_ = (int)se[(IDX_) + (lane >> 5)] + voffv; VQ = bload16(rU, vo_, 0); } while (0)
#define PEER_LOAD_VO(VO, VQ) do { VQ = bload16(rU, (VO), 0); } while (0)
#define PEER_PRO_LOAD(tt, XA, XB, I0, I1, G0, G1) do { XA = *(const u32x4*)(X1 + (size_t)(tt) * D + 16 * lane); XB = *(const u32x4*)(X1 + (size_t)(tt) * D + 16 * lane + 8); \
        I0 = IDX[(size_t)(tt) * 128 + lane]; I1 = IDX[(size_t)(tt) * 128 + 64 + lane]; G0 = GATE[(size_t)(tt) * 128 + lane]; G1 = GATE[(size_t)(tt) * 128 + 64 + lane]; } while (0)
#define PEER_PRO_SCALES(I0, I1, G0, G1, U0, U1, C0, C1) do { U0 = USC[I0]; U1 = USC[I1]; C0 = G0 * VSC[I0]; C1 = G1 * VSC[I1]; } while (0)
#define PEER_PRO_SORT(XA, XB, I0, I1, U0, U1, C0, C1, H8, HINV, SE, SU, SC, FLIP, XROW) do { \
        float hf_[16]; float sq_ = 0.f; \
        *(u32x4*)((XROW) + 16 * lane) = XA; *(u32x4*)((XROW) + 16 * lane + 8) = XB; \
        _Pragma("unroll") for (int j = 0; j < 4; ++j) { hf_[2 * j] = bf_lo(XA[j]); hf_[2 * j + 1] = bf_hi(XA[j]); hf_[8 + 2 * j] = bf_lo(XB[j]); hf_[9 + 2 * j] = bf_hi(XB[j]); } \
        _Pragma("unroll") for (int i = 0; i < 16; ++i) sq_ += hf_[i] * hf_[i]; \
        const float rs2_ = 1.0f / sqrtf(wave_sum(sq_) * (1.f / D) + RMS_EPS); float hm_ = 0.f; \
        _Pragma("unroll") for (int j = 0; j < 4; ++j) { const f32x4 gv_ = *(const f32x4*)(g2l + 16 * lane + 4 * j); _Pragma("unroll") for (int i = 0; i < 4; ++i) { hf_[4 * j + i] *= rs2_ * gv_[i]; hm_ = fmaxf(hm_, fabsf(hf_[4 * j + i])); } } \
        hm_ = wave_max(hm_); \
        HINV = hm_ > 0.f ? hm_ * (1.f / 224.f) : 1.f; const float hs_ = 1.f / HINV; \
        u32x4 hq_; \
        _Pragma("unroll") for (int j = 0; j < 4; ++j) { unsigned w_ = 0u; w_ = cvt_pk_fp8_f32(hf_[4 * j] * hs_, hf_[4 * j + 1] * hs_, w_, false); w_ = cvt_pk_fp8_f32(hf_[4 * j + 2] * hs_, hf_[4 * j + 3] * hs_, w_, true); hq_[j] = w_; } \
        *(u32x4*)(H8 + 16 * lane) = hq_; \
        const unsigned k0_ = (((unsigned)I0 ^ (FLIP)) << 7) | (unsigned)lane, k1_ = (((unsigned)I1 ^ (FLIP)) << 7) | (unsigned)(64 + lane);     \
        WSYNC(); keys[lane] = k0_; keys[64 + lane] = k1_; WSYNC(); \
        int r0_ = 0, r1_ = 0; \
        _Pragma("unroll 4") for (int j = 0; j < 32; ++j) { const u32x4 kv_ = *(const u32x4*)(keys + 4 * j); \
            r0_ += (kv_.x < k0_) + (kv_.y < k0_) + (kv_.z < k0_) + (kv_.w < k0_); r1_ += (kv_.x < k1_) + (kv_.y < k1_) + (kv_.z < k1_) + (kv_.w < k1_); } \
        SE[r0_] = (unsigned)(I0 & emask) * 1024u; SE[r1_] = (unsigned)(I1 & emask) * 1024u; SU[r0_] = U0; SU[r1_] = U1; SC[r0_] = C0; SC[r1_] = C1; WSYNC(); } while (0)
#define PEER_BATCH(ACC2, HINV, H8, b) do { \
        if ((b) == 0) VM_WAIT(4); else VM_WAIT(8);     \
        f32x4 cac = (f32x4){0.f, 0.f, 0.f, 0.f}; int on_[16]; int vo_[8];     \
        _Pragma("unroll") for (int s_ = 0; s_ < 8; ++s_) vo_[s_] = (int)se[16 * (b) + 8 + 2 * s_ + (lane >> 5)] + voffv; \
        _Pragma("unroll") for (int hf_ = 0; hf_ < 4; ++hf_) { u32x4 a6[2]; i32x8 hb[2]; \
          _Pragma("unroll") for (int s_ = 0; s_ < 2; ++s_) { a6[s_] = *(const u32x4*)(uring + aoff + 64 * (2 * hf_ + s_)); \
            const u32x4 lo_ = *(const u32x4*)((H8) + hoff + 128 * (2 * hf_ + s_)), hi_ = *(const u32x4*)((H8) + hoff + 128 * (2 * hf_ + s_) + 64); \
            hb[s_] = (i32x8){(int)lo_.x, (int)lo_.y, (int)lo_.z, (int)lo_.w, (int)hi_.x, (int)hi_.y, (int)hi_.z, (int)hi_.w}; } \
          if (hf_ == 3) { if ((b) < 15) PEER_ROWS((b) + 1, on_); LGKM_WAIT0(); WSYNC(); if ((b) < 15) PEER_ISSUE_U(on_); } \
          _Pragma("unroll") for (int s_ = 0; s_ < 2; ++s_) cac = mfma_fp4_fp8(a6[s_], hb[s_], cac); \
          TIEM(cac); } \
        f32x4 a4; \
        { const f32x4 su4 = *(const f32x4*)(su + 16 * (b) + q4), sc4 = *(const f32x4*)(sc + 16 * (b) + q4); \
          _Pragma("unroll") for (int j = 0; j < 4; ++j) a4[j] = gelu_fast(cac[j] * su4[j] * (HINV)) * sc4[j]; } \
        _Pragma("unroll") for (int s_ = 0; s_ < 8; ++s_) { \
            const u32x4 vw_ = vq[s_ & 3]; \
            if (s_ < 4 || (b) < 15) PEER_LOAD_VO(vo_[s_], vq[s_ & 3]); \
            const float c0_ = rdlane_f(a4[2 * (s_ & 1)], 16 * (s_ >> 1)), c1_ = rdlane_f(a4[2 * (s_ & 1) + 1], 16 * (s_ >> 1)); \
            const float cf_ = lo32 ? c0_ : c1_; const f32x2 a2 = (f32x2){cf_, cf_}; \
            _Pragma("unroll") for (int j = 0; j < 4; ++j) { const unsigned w_ = vw_[j]; \
                ACC2[4 * j] = __builtin_elementwise_fma(a2, CVT_FP4X2(w_, 0), ACC2[4 * j]); ACC2[4 * j + 1] = __builtin_elementwise_fma(a2, CVT_FP4X2(w_, 1), ACC2[4 * j + 1]); \
                ACC2[4 * j + 2] = __builtin_elementwise_fma(a2, CVT_FP4X2(w_, 2), ACC2[4 * j + 2]); ACC2[4 * j + 3] = __builtin_elementwise_fma(a2, CVT_FP4X2(w_, 3), ACC2[4 * j + 3]); } \
            TIE8(ACC2, 0); TIE8(ACC2, 8); } } while (0)
#define PEER_TOKEN_EPI(tt, ACC2, XROW) do { \
        float ssq_ = 0.f; \
        _Pragma("unroll") for (int q = 0; q < 16; ++q) { ACC2[q].x += xor32_f(ACC2[q].x, lane); ACC2[q].y += xor32_f(ACC2[q].y, lane); } \
        const unsigned short* xr_ = (XROW) + 32 * l31; \
        _Pragma("unroll") for (int j = 0; j < 4; ++j) { const u32x4 xw_ = *(const u32x4*)(xr_ + 8 * j); \
            _Pragma("unroll") for (int i = 0; i < 4; ++i) { ACC2[4 * j + i].x += bf_lo(xw_[i]); ACC2[4 * j + i].y += bf_hi(xw_[i]); ssq_ += ACC2[4 * j + i].x * ACC2[4 * j + i].x + ACC2[4 * j + i].y * ACC2[4 * j + i].y; } } \
        const float rstd_ = 1.0f / sqrtf(wave_sum(lo32 ? ssq_ : 0.f) * (1.f / D) + RMS_EPS); \
        if (lo32) { _Pragma("unroll") for (int j = 0; j < 8; ++j) { const f32x4 gg_ = *(const f32x4*)(gfl + 32 * l31 + 4 * j); f32x4 o_; \
            o_[0] = ACC2[2 * j].x * rstd_ * gg_[0] * poison_scale; o_[1] = ACC2[2 * j].y * rstd_ * gg_[1] * poison_scale; o_[2] = ACC2[2 * j + 1].x * rstd_ * gg_[2] * poison_scale; o_[3] = ACC2[2 * j + 1].y * rstd_ * gg_[3] * poison_scale; \
            *(f32x4*)(OUT + (size_t)(tt) * D + 32 * l31 + 4 * j) = o_; } } } while (0)
    const int nround = T / (2 * ngw);
    u32x4 xaA, xbA, xaB, xbB; int i0A, i1A, i0B, i1B; float g0A, g1A, g0B, g1B;
    { const int t0_ = gw, t1_ = ngw + gw; PEER_PRO_LOAD(t0_, xaA, xbA, i0A, i1A, g0A, g1A); PEER_PRO_LOAD(t1_, xaB, xbB, i0B, i1B, g0B, g1B); }
#pragma unroll 1
    for (int rnd = 0; rnd < nround; ++rnd) {
        OPAQUE(lane);
        const int vo16 = 16 * lane, l31 = lane & 31, q4 = 4 * (lane >> 4); const bool lo32 = lane < 32;
        const int aoff = (lane & 15) * PEER_UP + 16 * (lane >> 4);
        const int voffv = 512 + 16 * l31, hoff = 16 * (lane >> 4);
        const int tA = (2 * rnd) * ngw + gw, tB = (2 * rnd + 1) * ngw + gw;
        f32x2 acc[16]; float hinvA, hinvB;
        {
            float u0A, u1A, c0A, c1A, u0B, u1B, c0B, c1B;
            PEER_PRO_SCALES(i0A, i1A, g0A, g1A, u0A, u1A, c0A, c1A); PEER_PRO_SCALES(i0B, i1B, g0B, g1B, u0B, u1B, c0B, c1B);
            PEER_PRO_SORT(xaA, xbA, i0A, i1A, u0A, u1A, c0A, c1A, h8A, hinvA, se, su, sc, 0u, xrowA);
            PEER_PRO_SORT(xaB, xbB, i0B, i1B, u0B, u1B, c0B, c1B, h8B, hinvB, (se + 128), (su + 128), (sc + 128), 0x3fffu, xrowB);
        }
#pragma unroll
        for (int q = 0; q < 16; ++q) acc[q] = (f32x2){0.f, 0.f};
        LGKM_WAIT0(); WSYNC();
        VM_WAIT(0);
        u32x4 vq[4];
        { int oc_[16]; PEER_ROWS(0, oc_); PEER_ISSUE_U(oc_); WSYNC(); }
#pragma unroll
        for (int s_ = 0; s_ < 4; ++s_) PEER_LOAD_V(2 * s_, vq[s_]);
#pragma unroll 1
        for (int b = 0; b < 16; ++b) {
            const float hinvT = b < 8 ? hinvA : hinvB; const unsigned char* h8T = b < 8 ? h8A : h8B;
            PEER_BATCH(acc, hinvT, h8T, b);
            if (false) RAW_BARRIER();
            if (b == 7) {
                int tA2 = tA; OPAQUE(tA2); PEER_TOKEN_EPI(tA2, acc, xrowA);
#pragma unroll
                for (int q = 0; q < 16; ++q) acc[q] = (f32x2){0.f, 0.f};
#if PEER_MIDBAR
                RAW_BARRIER();
#endif
            }
        }
        if (rnd + 1 < nround) { int tn0_ = (2 * rnd + 2) * ngw + gw, tn1_ = (2 * rnd + 3) * ngw + gw; OPAQUE(tn0_); OPAQUE(tn1_);
            PEER_PRO_LOAD(tn0_, xaA, xbA, i0A, i1A, g0A, g1A); PEER_PRO_LOAD(tn1_, xaB, xbB, i0B, i1B, g0B, g1B); }
        { int tB2 = tB; OPAQUE(tB2); PEER_TOKEN_EPI(tB2, acc, xrowB); }
        BSYNC();
    }
#undef PEER_ISSUE_U
#undef PEER_ROWS
#undef PEER_LOAD_V
#undef PEER_LOAD_VO
#undef PEER_PRO_LOAD
#undef PEER_PRO_SCALES
#undef PEER_PRO_SORT
#undef PEER_BATCH
#undef PEER_TOKEN_EPI
#undef OUT
#undef emask
}

#ifndef EMU
namespace pg8 {
#define PG8_LAS __attribute__((address_space(3)))
typedef unsigned short bf16_t;
typedef short bf16x8 __attribute__((ext_vector_type(8)));
typedef float f32x4 __attribute__((ext_vector_type(4)));
typedef unsigned u32x4 __attribute__((ext_vector_type(4)));
constexpr int BM = 256, BK = 64, HALF = 128, HTB = HALF * BK * 2  , STAGE_BYTES = 8 * HTB, NXCD = 8, WGM = 8;

__host__ __device__ __forceinline__ int lds_byte(int r, int c) { const int st = (r >> 4) * 2 + (c >> 5), rr = r & 15, cc = c & 31, ob = rr * 64 + cc * 2; return st * 1024 + (ob ^ (((ob >> 9) & 1) << 5)); }
__host__ __device__ __forceinline__ void stage_rc(int b, int& R, int& C) { const int st = b / 1024, sb = b % 1024, swz = sb ^ (((sb >> 9) & 1) << 5); R = (st >> 1) * 16 + swz / 64; C = (st & 1) * 32 + (swz % 64) / 2; }
__host__ __device__ __forceinline__ int perm32(int rho) { const int n = rho >> 4, i = rho & 15; return 8 * (i >> 2) + 4 * n + (i & 3); }

struct Unit { int pm, pn; };
struct Gemm { const bf16_t* A; const bf16_t* Bt; int M, N, K; };

struct StaticOrder {
    int nM, nN, nwg, G, c;
    __host__ __device__ void init(int M, int N, int G_, int c_) { nM = M / BM; nN = N / BM; nwg = nM * nN; G = G_; c = c_; }
    __host__ __device__ bool next(int i, Unit& u) const {
        const long L = (long)i * G + c; if (L >= nwg) return false;
        int wgid = (int)L; { const int q = nwg / NXCD, r = nwg % NXCD, xcd = wgid % NXCD, off = wgid / NXCD; wgid = (xcd < r ? xcd * (q + 1) : r * (q + 1) + (xcd - r) * q) + off; }
        const int nig = WGM * nN, gid = wgid / nig, fm = gid * WGM, gsz = (nM - fm) < WGM ? (nM - fm) : WGM;
        u.pm = fm + ((wgid % nig) % gsz); u.pn = (wgid % nig) / gsz; return true;
    }
    __device__ __forceinline__ void a_ready(const Unit&) const {}
    __device__ __forceinline__ void done(const Unit&) const {}
};

__device__ __forceinline__ unsigned cvt_pk_bf16(float lo, float hi) { unsigned r; asm volatile("v_cvt_pk_bf16_f32 %0, %1, %2" : "=v"(r) : "v"(lo), "v"(hi)); return r; }
typedef float f32x2 __attribute__((ext_vector_type(2)));
__device__ __forceinline__ f32x2 gelu_pk(f32x2 v) {
    const f32x2 av = __builtin_elementwise_abs(v), d = av * 0.2316418882f + 1.0f;
    f32x2 t; t.x = __builtin_amdgcn_rcpf(d.x); t.y = __builtin_amdgcn_rcpf(d.y);
    f32x2 q = t * 0.5307027145f + (-0.7265760135f); q = q * t + 0.7107068705f; q = q * t + (-0.142248368f); q = q * t + 0.127414796f; q = q * t;
    const f32x2 s = (v * v) * (-0.72134752044f);
    f32x2 e; e.x = __builtin_amdgcn_exp2f(s.x); e.y = __builtin_amdgcn_exp2f(s.y);
    const f32x2 m = v * (q * e), r = v - m;
    f32x2 o; o.x = v.x < 0.f ? m.x : r.x; o.y = v.y < 0.f ? m.y : r.y; return o;
}

template <int ACT  > struct EpiBf16 {
    static constexpr bool PERM = true, AFTER_DRAIN = false; static_assert(ACT == 0 || ACT == 1, "EpiBf16: ACT is 0 (none) or 1 (gelu_pk)");
    bf16_t* O; int ldc; const float* bias; int split_cols; size_t split_stride; float scale0;
    __device__ __forceinline__ void operator()(const f32x4 (&acc)[2][2][4][2], const Unit& u, int wr, int wc, int fr, int fq) const {
        const int row0 = u.pm * BM + wr * 64 + fr; int colt = u.pn * BM; bf16_t* base = O;
        float sc = 1.f; if (split_cols) { const int t = colt / split_cols; base += (size_t)t * split_stride; colt -= t * split_cols; if (t == 0) sc = scale0; }
        const int col0 = colt + wc * 32 + 8 * fq, bcol0 = u.pn * BM + wc * 32 + 8 * fq;
        f32x4 bv[2][2];
#pragma unroll
        for (int bj = 0; bj < 2; ++bj)
#pragma unroll
            for (int n = 0; n < 2; ++n) bv[bj][n] = bias ? *(const f32x4*)(bias + bcol0 + bj * HALF + 4 * n) : (f32x4){0.f, 0.f, 0.f, 0.f};
#pragma unroll
        for (int ai = 0; ai < 2; ++ai)
#pragma unroll
            for (int m = 0; m < 4; ++m) { bf16_t* rowp = base + (size_t)(row0 + ai * HALF + m * 16) * ldc + col0;
#pragma unroll
                for (int bj = 0; bj < 2; ++bj) { f32x4 v0 = acc[ai][bj][m][0] + bv[bj][0], v1 = acc[ai][bj][m][1] + bv[bj][1];
                    if (ACT == 1) { f32x2 a = gelu_pk((f32x2){v0[0], v0[1]}), b = gelu_pk((f32x2){v0[2], v0[3]}), c = gelu_pk((f32x2){v1[0], v1[1]}), d = gelu_pk((f32x2){v1[2], v1[3]});
                        v0 = (f32x4){a.x, a.y, b.x, b.y}; v1 = (f32x4){c.x, c.y, d.x, d.y}; }
                    v0 = v0 * sc; v1 = v1 * sc; u32x4 w; w.x = cvt_pk_bf16(v0[0], v0[1]); w.y = cvt_pk_bf16(v0[2], v0[3]); w.z = cvt_pk_bf16(v1[0], v1[1]); w.w = cvt_pk_bf16(v1[2], v1[3]);
                    *(u32x4*)(rowp + bj * HALF) = w; } }
    }
};
template <class Epi, class Sched, bool ALIGN_EPI = false, bool SP2 = false>
__device__ __forceinline__ void gemm_phase(PG8_LAS unsigned char* lds, const Gemm g, const Sched& S, const Epi& E) {
    int tid = threadIdx.x; asm volatile("" : "+v"(tid));
    const int wid = __builtin_amdgcn_readfirstlane(tid >> 6), lane = tid & 63, wr = wid >> 2, wc = wid & 3, fr = lane & 15, fq = lane >> 4;
    const int K = g.K, nt = K / BK;
    unsigned voffA[2], voffB[2];
#pragma unroll
    for (int i = 0; i < 2; ++i) { int R, C; stage_rc(tid * 16 + i * 8192, R, C); const int Rb = Epi::PERM ? ((R & ~31) + perm32(R & 31)) : R;
        voffA[i] = (unsigned)(R * K + C) * 2u; voffB[i] = (unsigned)(Rb * K + C) * 2u; }
    const size_t kstep = (size_t)(BK * 2);
    const size_t hstep = (size_t)HALF * K * 2;
    const size_t tstep = 2 * hstep;
    const unsigned ldsw = (unsigned)wid * 1024u;
    const int aoff = lds_byte(wr * 64 + fr, fq * 8), boff = lds_byte(wc * 32 + fr, fq * 8);
#define PG8_SA(b, h) (((b) * 2 + (h)) * HTB)
#define PG8_SB(b, h) ((4 + (b) * 2 + (h)) * HTB)
#define PG8_STAGE(bufoff, gbase, voff) do { _Pragma("unroll") for (int _i = 0; _i < 2; ++_i) \
        __builtin_amdgcn_global_load_lds((const unsigned*)((const char*)(gbase) + (voff)[_i]), (PG8_LAS unsigned*)(lds + (bufoff) + ldsw + _i * 8192), 16, 0, 0); } while (0)
#define PG8_LDA(dst, b, h) do { _Pragma("unroll") for (int m = 0; m < 4; ++m) _Pragma("unroll") for (int k = 0; k < 2; ++k) dst[m][k] = *(const PG8_LAS bf16x8*)(lds + PG8_SA(b, h) + aoff + m * 2048 + k * 1024); } while (0)
#define PG8_LDB(dst, b, h) do { _Pragma("unroll") for (int n = 0; n < 2; ++n) _Pragma("unroll") for (int k = 0; k < 2; ++k) dst[n][k] = *(const PG8_LAS bf16x8*)(lds + PG8_SB(b, h) + boff + n * 2048 + k * 1024); } while (0)
#define PG8_MMA(ai, bj, At, Bt) do { __builtin_amdgcn_s_setprio(1); _Pragma("unroll") for (int m = 0; m < 4; ++m) _Pragma("unroll") for (int n = 0; n < 2; ++n) _Pragma("unroll") for (int k = 0; k < 2; ++k) \
        acc[ai][bj][m][n] = __builtin_amdgcn_mfma_f32_16x16x32_bf16(Bt[n][k], At[m][k], acc[ai][bj][m][n], 0, 0, 0); __builtin_amdgcn_s_setprio(0); } while (0)
#define PG8_WAIT_V(n) asm volatile("s_waitcnt vmcnt(" #n ")" ::: "memory")
#define PG8_WAIT_L(n) asm volatile("s_waitcnt lgkmcnt(" #n ")" ::: "memory")
#define PG8_BAR __builtin_amdgcn_s_barrier()
#define PG8_SCHED __builtin_amdgcn_sched_barrier(0)
    Unit cur, nxt; int ui = 0;
    if (!S.next(0, cur)) return;
    f32x4 acc[2][2][4][2];
#pragma unroll
    for (int a = 0; a < 2; ++a)
#pragma unroll
        for (int b = 0; b < 2; ++b)
#pragma unroll
            for (int m = 0; m < 4; ++m)
#pragma unroll
                for (int n = 0; n < 2; ++n) acc[a][b][m][n] = (f32x4){0.f, 0.f, 0.f, 0.f};
    bf16x8 At[4][2], B0[2][2], B1[2][2];
    const char* cA = (const char*)g.A + (size_t)cur.pm * tstep; const char* cB = (const char*)g.Bt + (size_t)cur.pn * tstep;
    S.a_ready(cur);
    if constexpr (SP2) {
        PG8_STAGE(PG8_SB(0, 0), cB, voffB); PG8_STAGE(PG8_SB(0, 1), cB + hstep, voffB); PG8_STAGE(PG8_SA(0, 0), cA, voffA); PG8_STAGE(PG8_SA(0, 1), cA + hstep, voffA);
        if (wr == 1) PG8_BAR;
        PG8_WAIT_V(2); PG8_BAR;
        PG8_STAGE(PG8_SB(1, 0), cB + kstep, voffB); PG8_STAGE(PG8_SA(1, 0), cA + kstep, voffA); PG8_STAGE(PG8_SB(1, 1), cB + hstep + kstep, voffB);
        PG8_WAIT_V(6); PG8_BAR;
    } else {
        PG8_STAGE(PG8_SB(0, 0), cB, voffB); PG8_STAGE(PG8_SA(0, 0), cA, voffA); PG8_STAGE(PG8_SB(0, 1), cB + hstep, voffB); PG8_STAGE(PG8_SA(0, 1), cA + hstep, voffA);
        if (wr == 1) PG8_BAR;
        PG8_WAIT_V(4); PG8_BAR;
        PG8_STAGE(PG8_SB(1, 0), cB + kstep, voffB); PG8_STAGE(PG8_SA(1, 0), cA + kstep, voffA); PG8_STAGE(PG8_SB(1, 1), cB + hstep + kstep, voffB);
        PG8_WAIT_V(6); PG8_BAR;
    }
    for (;;) {
        const bool has_next = S.next(ui + 1, nxt);
        const char* nA = has_next ? (const char*)g.A + (size_t)nxt.pm * tstep : cA; const char* nB = has_next ? (const char*)g.Bt + (size_t)nxt.pn * tstep : cB;
        for (int t = 0; t < nt; t += 2) {
            const bool last = (t == nt - 2);
            const char* a1 = cA + (size_t)(t + 1) * kstep;
            const char* a2 = last ? nA : cA + (size_t)(t + 2) * kstep; const char* b2 = last ? nB : cB + (size_t)(t + 2) * kstep;
            const char* a3 = a2 + kstep; const char* b3 = b2 + kstep;
            if (last && has_next) S.a_ready(nxt);
            if constexpr (SP2) {
            PG8_LDB(B0, 0, 0); PG8_LDB(B1, 0, 1); PG8_SCHED; PG8_LDA(At, 0, 0); PG8_STAGE(PG8_SA(1, 1), a1 + hstep, voffA);
            PG8_WAIT_V(8); PG8_WAIT_L(0); PG8_BAR; PG8_MMA(0, 0, At, B0); PG8_MMA(0, 1, At, B1); PG8_BAR; PG8_SCHED;
            PG8_LDA(At, 0, 1); PG8_STAGE(PG8_SB(0, 0), b2, voffB); PG8_STAGE(PG8_SB(0, 1), b2 + hstep, voffB); PG8_STAGE(PG8_SA(0, 0), a2, voffA);
            PG8_WAIT_V(8); PG8_WAIT_L(0); PG8_BAR; PG8_MMA(1, 0, At, B0); PG8_MMA(1, 1, At, B1); PG8_BAR; PG8_SCHED;
            PG8_LDB(B0, 1, 0); PG8_LDB(B1, 1, 1); PG8_SCHED; PG8_LDA(At, 1, 0); PG8_STAGE(PG8_SA(0, 1), a2 + hstep, voffA);
            PG8_WAIT_V(8); PG8_WAIT_L(0); PG8_BAR; PG8_MMA(0, 0, At, B0); PG8_MMA(0, 1, At, B1); PG8_BAR; PG8_SCHED;
            PG8_LDA(At, 1, 1); PG8_STAGE(PG8_SB(1, 0), b3, voffB); PG8_STAGE(PG8_SB(1, 1), b3 + hstep, voffB); PG8_STAGE(PG8_SA(1, 0), a3, voffA);
            PG8_WAIT_V(8); PG8_WAIT_L(0); PG8_BAR; PG8_MMA(1, 0, At, B0); PG8_MMA(1, 1, At, B1); PG8_BAR; PG8_SCHED;
            } else {
            PG8_LDB(B0, 0, 0); PG8_SCHED; PG8_LDA(At, 0, 0); PG8_STAGE(PG8_SA(1, 1), a1 + hstep, voffA);
            PG8_WAIT_L(8); PG8_BAR; PG8_WAIT_L(0); PG8_MMA(0, 0, At, B0); PG8_BAR; PG8_SCHED;
            PG8_LDB(B1, 0, 1); PG8_STAGE(PG8_SB(0, 0), b2, voffB);
            PG8_BAR; PG8_WAIT_L(0); PG8_MMA(0, 1, At, B1); PG8_BAR;
            PG8_LDA(At, 0, 1); PG8_STAGE(PG8_SA(0, 0), a2, voffA);
            PG8_BAR; PG8_WAIT_L(0); PG8_MMA(1, 0, At, B0); PG8_BAR; PG8_SCHED;
            PG8_STAGE(PG8_SB(0, 1), b2 + hstep, voffB);
            PG8_WAIT_V(6); PG8_BAR; PG8_MMA(1, 1, At, B1); PG8_BAR;
            PG8_LDB(B0, 1, 0); PG8_SCHED; PG8_LDA(At, 1, 0); PG8_STAGE(PG8_SA(0, 1), a2 + hstep, voffA);
            PG8_WAIT_L(8); PG8_BAR; PG8_WAIT_L(0); PG8_MMA(0, 0, At, B0); PG8_BAR; PG8_SCHED;
            PG8_LDB(B1, 1, 1); PG8_STAGE(PG8_SB(1, 0), b3, voffB);
            PG8_BAR; PG8_WAIT_L(0); PG8_MMA(0, 1, At, B1); PG8_BAR;
            PG8_LDA(At, 1, 1); PG8_STAGE(PG8_SA(1, 0), a3, voffA);
            PG8_BAR; PG8_WAIT_L(0); PG8_MMA(1, 0, At, B0); PG8_BAR; PG8_SCHED;
            PG8_STAGE(PG8_SB(1, 1), b3 + hstep, voffB);
            PG8_WAIT_V(6); PG8_BAR; PG8_MMA(1, 1, At, B1); PG8_BAR;
            }
        }
        if constexpr (ALIGN_EPI) { if (wr == 0) PG8_BAR; }
        if constexpr (!Epi::AFTER_DRAIN) { E(acc, cur, wr, wc, fr, fq); S.done(cur); }
        if (!has_next) break;
#pragma unroll
        for (int a = 0; a < 2; ++a)
#pragma unroll
            for (int b = 0; b < 2; ++b)
#pragma unroll
                for (int m = 0; m < 4; ++m)
#pragma unroll
                    for (int n = 0; n < 2; ++n) acc[a][b][m][n] = (f32x4){0.f, 0.f, 0.f, 0.f};
        cur = nxt; cA = nA; cB = nB; ++ui;
        if constexpr (ALIGN_EPI) { if (wr == 1) PG8_BAR; }
    }
    PG8_WAIT_V(0);
    if constexpr (!ALIGN_EPI) { if (wr == 0) PG8_BAR; }
    PG8_BAR;
    if constexpr (Epi::AFTER_DRAIN) { E.fused(acc, cur, wr, wc, fr, fq, lds, wid, lane); S.done(cur); }
#undef PG8_SA
#undef PG8_SB
#undef PG8_STAGE
#undef PG8_LDA
#undef PG8_LDB
#undef PG8_MMA
#undef PG8_WAIT_V
#undef PG8_WAIT_L
#undef PG8_BAR
#undef PG8_SCHED
}
}

struct OneUnit {
    pg8::Unit u;
    __device__ __forceinline__ bool next(int i, pg8::Unit& o) const { if (i) return false; o = u; return true; }
    __device__ __forceinline__ void a_ready(const pg8::Unit&) const {}
    __device__ __forceinline__ void done(const pg8::Unit&) const {}
};
struct EpiResF32 {
    static constexpr bool PERM = true, AFTER_DRAIN = false;
    const float* base; float* out; pg8::bf16_t* xb; float* ssq;
    __device__ __forceinline__ void operator()(const pg8::f32x4 (&acc)[2][2][4][2], const pg8::Unit& u, int wr, int wc, int fr, int fq) const {
#pragma unroll
        for (int ai = 0; ai < 2; ++ai)
#pragma unroll
            for (int m = 0; m < 4; ++m) {
                const size_t row = (size_t)u.pm * 256 + ai * 128 + wr * 64 + m * 16 + fr;
                float sq = 0.f;
#pragma unroll
                for (int bj = 0; bj < 2; ++bj) {
                    const size_t off = row * D + u.pn * 256 + bj * 128 + wc * 32 + 8 * fq;
                    const pg8::f32x4 b0 = *(const pg8::f32x4*)(base + off), b1 = *(const pg8::f32x4*)(base + off + 4);
                    const pg8::f32x4 v0 = b0 + acc[ai][bj][m][0], v1 = b1 + acc[ai][bj][m][1];
                    u32x4 w; w.x = pk2(v0[0], v0[1]); w.y = pk2(v0[2], v0[3]); w.z = pk2(v1[0], v1[1]); w.w = pk2(v1[2], v1[3]); *(u32x4*)(xb + off) = w;
                    sq += ((v0[0] * v0[0] + v0[1] * v0[1]) + (v0[2] * v0[2] + v0[3] * v0[3])) + ((v1[0] * v1[0] + v1[1] * v1[1]) + (v1[2] * v1[2] + v1[3] * v1[3]));
                }
                sq += __shfl_xor(sq, 16); sq += __shfl_xor(sq, 32);
                if (fq == 0) ssq[row * 16 + u.pn * 4 + wc] = sq;
            }
    }
};
struct EpiTopK {
    static constexpr bool PERM = false, AFTER_DRAIN = true;
    int* IDX; float* GATE; const float* ssq;
    __device__ __forceinline__ void fused(pg8::f32x4 (&acc)[2][2][4][2], const pg8::Unit& u, int wr, int wc, int fr, int fq, PG8_LAS unsigned char* lds, int wid, int lane) const {
        float* S = (float*)lds; float* lists = S + 128 * 260; float* rs = lists + 128 * 2 * 16;
        if (threadIdx.x < 256) {
            const pg8::f32x4* sp = (const pg8::f32x4*)(ssq + ((size_t)u.pm * 256 + threadIdx.x) * 16);
            const pg8::f32x4 a = sp[0], b = sp[1], c = sp[2], d = sp[3];
            const float tot = ((a[0] + a[1]) + (a[2] + a[3])) + ((b[0] + b[1]) + (b[2] + b[3])) + ((c[0] + c[1]) + (c[2] + c[3])) + ((d[0] + d[1]) + (d[2] + d[3]));
            rs[threadIdx.x] = 1.0f / sqrtf(tot * (1.f / D) + RMS_EPS);
        }
        __syncthreads();
#pragma unroll
        for (int ai = 0; ai < 2; ++ai) {
#pragma unroll
            for (int m = 0; m < 4; ++m) {
                const float r = rs[ai * 128 + wr * 64 + m * 16 + fr];
#pragma unroll
                for (int bj = 0; bj < 2; ++bj)
#pragma unroll
                    for (int n = 0; n < 2; ++n) *(pg8::f32x4*)(S + (wr * 64 + m * 16 + fr) * 260 + bj * 128 + wc * 32 + n * 16 + 4 * fq) = acc[ai][bj][m][n] * r;
            }
            __syncthreads();
            topk_half(S, lists, u.pm * 256 + ai * 128, u.pn, IDX, GATE);
        }
    }
};

__device__ __forceinline__ void grid_bar(unsigned* cnt, unsigned epoch, unsigned nblk) {
    asm volatile("s_waitcnt vmcnt(0)" ::: "memory");
    __syncthreads();
    if (threadIdx.x == 0) {
        __builtin_amdgcn_fence(__ATOMIC_RELEASE, "agent");
        asm volatile("s_waitcnt vmcnt(0)" ::: "memory");
        __hip_atomic_fetch_add(cnt, 1u, __ATOMIC_RELAXED, __HIP_MEMORY_SCOPE_AGENT);
        const unsigned want = epoch * nblk;
        for (unsigned sp = 0; sp < (1u << 22); ++sp) { if (__hip_atomic_load(cnt, __ATOMIC_RELAXED, __HIP_MEMORY_SCOPE_AGENT) >= want) break; __builtin_amdgcn_s_sleep(2); }
        __builtin_amdgcn_fence(__ATOMIC_ACQUIRE, "agent");
        asm volatile("s_waitcnt vmcnt(0)" ::: "memory");
    }
    __syncthreads();
}

#ifndef PHM
#define PHM 255
#endif
#ifndef DUP
#define DUP 0
#endif
#ifndef PROBE_EMASK
#define PROBE_EMASK 0x3fff
#endif
#ifndef PROBE_PV
#define PROBE_PV 0
#endif
constexpr int LDS_BYTES = 163840;
__global__ void __launch_bounds__(NTHR, 2) fwd_kernel(Params p) {
    extern __shared__ __attribute__((aligned(16))) unsigned char lds[];
    cg::grid_group grid = cg::this_grid();
    const int bid = blockIdx.x, nblk = gridDim.x;
    unsigned char* ws = p.ws;
#if PHM & 1
    p0_prologue(p, bid, nblk, (char*)lds);
#if DUP & 1
    p0_prologue(p, bid, nblk, (char*)lds);
#endif
#endif
    grid.sync();
#if PHM & 2
    {
        pg8::Gemm g{(const pg8::bf16_t*)(ws + WS_H), (const pg8::bf16_t*)(ws + WS_WINT), T, PCOLS, D};
        pg8::StaticOrder S; S.init(T, PCOLS, nblk, bid);
        pg8::EpiBf16<0> E{(pg8::bf16_t*)(ws + WS_P), PCOLS, (const float*)(ws + WS_BIASP), 0, 0, 1.f};
        pg8::gemm_phase<pg8::EpiBf16<0>, pg8::StaticOrder, true, true>((PG8_LAS unsigned char*)lds, g, S, E);
    }
#if DUP & 2
    {
        pg8::Gemm g{(const pg8::bf16_t*)(ws + WS_H), (const pg8::bf16_t*)(ws + WS_WINT), T, PCOLS, D};
        pg8::StaticOrder S; S.init(T, PCOLS, nblk, bid);
        pg8::EpiBf16<0> E{(pg8::bf16_t*)(ws + WS_P), PCOLS, (const float*)(ws + WS_BIASP), 0, 0, 1.f};
        pg8::gemm_phase<pg8::EpiBf16<0>, pg8::StaticOrder, true, true>((PG8_LAS unsigned char*)lds, g, S, E);
    }
#endif
#endif
    grid_bar((unsigned*)(ws + WS_CTL) + 1024, 1u, (unsigned)nblk);
#if PHM & 4
#if DUP & 4
    for (int u = bid; u < BATCH * 8; u += nblk) rwkv_unit(p, u >> 3, u & 7, (char*)lds);
#endif
    for (int u = bid; u < BATCH * 8; u += nblk) rwkv_unit(p, u >> 3, u & 7, (char*)lds);
#endif
#if PHM & 8
    for (int u = bid; u < BATCH * (SEQ / 128); u += nblk) attn_unit(p, u / (SEQ / 128), u % (SEQ / 128), (char*)lds);
#if DUP & 8
    for (int u = bid; u < BATCH * (SEQ / 128); u += nblk) attn_unit(p, u / (SEQ / 128), u % (SEQ / 128), (char*)lds);
#endif
#endif
    grid_bar((unsigned*)(ws + WS_CTL) + 1024, 2u, (unsigned)nblk);
#if PHM & 16
    {
        pg8::Gemm g{(const pg8::bf16_t*)(ws + WS_Y), (const pg8::bf16_t*)(ws + WS_WOUTT), T, D, D};
        pg8::StaticOrder S; S.init(T, D, nblk, bid);
        EpiResF32 E{p.x, p.out, (pg8::bf16_t*)(ws + WS_H), (float*)(ws + WS_SSQ)};
        pg8::gemm_phase<EpiResF32, pg8::StaticOrder, true, true>((PG8_LAS unsigned char*)lds, g, S, E);
    }
#if DUP & 16
    {
        pg8::Gemm g{(const pg8::bf16_t*)(ws + WS_Y), (const pg8::bf16_t*)(ws + WS_WOUTT), T, D, D};
        pg8::StaticOrder S; S.init(T, D, nblk, bid);
        EpiResF32 E{p.x, p.out, (pg8::bf16_t*)(ws + WS_H), (float*)(ws + WS_SSQ)};
        pg8::gemm_phase<EpiResF32, pg8::StaticOrder, true, true>((PG8_LAS unsigned char*)lds, g, S, E);
    }
#endif
#endif
    grid_bar((unsigned*)(ws + WS_CTL) + 1024, 3u, (unsigned)nblk);
#if PHM & 64
    {
        pg8::Gemm g{(const pg8::bf16_t*)(ws + WS_H), (const pg8::bf16_t*)(ws + WS_WFT), T, 2048, D};
        pg8::StaticOrder S; S.init(T, 2048, nblk, bid);
        EpiTopK E{(int*)(ws + WS_IDX), (float*)(ws + WS_GATE), (const float*)(ws + WS_SSQ)};
        OneUnit one;
        for (int i = 0; S.next(i, one.u); ++i) pg8::gemm_phase<EpiTopK, OneUnit, false, true>((PG8_LAS unsigned char*)lds, g, one, E);
    }
#if DUP & 64
    {
        pg8::Gemm g{(const pg8::bf16_t*)(ws + WS_H), (const pg8::bf16_t*)(ws + WS_WFT), T, 2048, D};
        pg8::StaticOrder S; S.init(T, 2048, nblk, bid);
        EpiTopK E{(int*)(ws + WS_IDX), (float*)(ws + WS_GATE), (const float*)(ws + WS_SSQ)};
        OneUnit one;
        for (int i = 0; S.next(i, one.u); ++i) pg8::gemm_phase<EpiTopK, OneUnit, false, true>((PG8_LAS unsigned char*)lds, g, one, E);
    }
#endif
#endif
    grid_bar((unsigned*)(ws + WS_CTL) + 1024, 4u, (unsigned)nblk);
#if PHM & 128
#if DUP & 128
#pragma unroll 1
    for (int pass = 0; pass < 2; ++pass) peer_phase(p, bid, nblk, p.out, (char*)lds, 0x3fff, pass);
#else
    peer_phase(p, bid, nblk, p.out, (char*)lds);
#endif
#endif
}

extern "C" void kernel_launch(void* const* d_in, const int* in_sizes, int n_in, void* d_out, int out_size, void* d_ws, size_t ws_size, hipStream_t stream) {
    static int grid = 0;
    if (grid == 0) {
        if (n_in != 24 || out_size != T * D || ws_size < WS_END) { fprintf(stderr, "kernel_launch: unexpected shapes (n_in %d, out %d, ws %zu < %zu)\n", n_in, out_size, ws_size, (size_t)WS_END); grid = -1; return; }
        int dev = 0, cus = 0, per_cu = 0;
        hipGetDevice(&dev);
        hipDeviceGetAttribute(&cus, hipDeviceAttributeMultiprocessorCount, dev);
        hipFuncSetAttribute((const void*)fwd_kernel, hipFuncAttributeMaxDynamicSharedMemorySize, LDS_BYTES);
        hipOccupancyMaxActiveBlocksPerMultiprocessor(&per_cu, (const void*)fwd_kernel, NTHR, LDS_BYTES);
        if (per_cu < 1) { fprintf(stderr, "kernel_launch: occupancy query says %d blocks per CU\n", per_cu); per_cu = 1; }
        if (per_cu > 1) per_cu = 1;
        grid = cus * per_cu;
        if (T % (4 * grid * (NTHR / 64)) != 0 || NEXP % (2 * grid * (NTHR / 64)) != 0) { fprintf(stderr, "kernel_launch: T = %d is not a multiple of 2 * %d waves\n", T, grid * (NTHR / 64)); grid = -1; return; }
        (void)hipGetLastError();
    }
    if (grid < 0) return;
    Params p{};
    const float** pp = (const float**)&p;
    for (int i = 0; i < 24; ++i) pp[i] = (const float*)d_in[i];
    p.out = (float*)d_out; p.ws = (unsigned char*)d_ws;
    void* args[] = {&p};
    hipError_t e = hipLaunchCooperativeKernel((const void*)fwd_kernel, dim3(grid), dim3(NTHR), args, LDS_BYTES, stream);
    if (e != hipSuccess) fprintf(stderr, "cooperative launch failed: %s (grid %d)\n", hipGetErrorString(e), grid);
}
#endif
```

```cpp
#ifndef EMU
#include <hip/hip_runtime.h>
#include <hip/hip_cooperative_groups.h>
#include <cstdio>
#include <cstdint>
namespace cg = cooperative_groups;
typedef short bf16x8 __attribute__((ext_vector_type(8)));
typedef short bf16x4 __attribute__((ext_vector_type(4)));
typedef float f32x16 __attribute__((ext_vector_type(16)));
typedef float f32x4 __attribute__((ext_vector_type(4)));
typedef float f32x2 __attribute__((ext_vector_type(2)));
typedef unsigned u32x4 __attribute__((ext_vector_type(4)));
typedef unsigned u32x2 __attribute__((ext_vector_type(2)));
#define TID ((int)threadIdx.x)
#define BSYNC() __syncthreads()
#define WSYNC() __builtin_amdgcn_wave_barrier()
#define OPAQUE(x) asm volatile("" : "+v"(x))
#define TIE8(A, i) asm volatile("" : "+v"(A[i]), "+v"(A[i + 1]), "+v"(A[i + 2]), "+v"(A[i + 3]), "+v"(A[i + 4]), "+v"(A[i + 5]), "+v"(A[i + 6]), "+v"(A[i + 7]) :: "memory")
#define TIEM(x) asm volatile("" : "+v"(x) :: "memory")
__device__ __forceinline__ float shfl_xor_f(float v, int m) { return __shfl_xor(v, m); }
__device__ __forceinline__ float shfl_f(float v, int s) { return __shfl(v, s); }
__device__ __forceinline__ int shfl_i(int v, int s) { return __shfl(v, s); }
__device__ __forceinline__ float rdlane_f(float v, int l) { return __builtin_bit_cast(float, __builtin_amdgcn_readlane(__builtin_bit_cast(int, v), l)); }
__device__ __forceinline__ int rdlane_i(int v, int l) { return __builtin_amdgcn_readlane(v, l); }
__device__ __forceinline__ f32x2 cvt_pk_f32_fp8(unsigned w, bool hi) { return hi ? __builtin_amdgcn_cvt_pk_f32_fp8((int)w, true) : __builtin_amdgcn_cvt_pk_f32_fp8((int)w, false); }
__device__ __forceinline__ unsigned cvt_pk_fp8_f32(float a, float b, unsigned old, bool hi) { return hi ? (unsigned)__builtin_amdgcn_cvt_pk_fp8_f32(a, b, (int)old, true) : (unsigned)__builtin_amdgcn_cvt_pk_fp8_f32(a, b, (int)old, false); }
template <int CTRL> __device__ __forceinline__ float dppf(float v) { return __builtin_bit_cast(float, __builtin_amdgcn_update_dpp(0, __builtin_bit_cast(int, v), CTRL, 0xF, 0xF, true)); }
__device__ __forceinline__ float row_sum(float v) { v += dppf<0xB1>(v); v += dppf<0x4E>(v); v += dppf<0x141>(v); v += dppf<0x140>(v); return v; }
__device__ __forceinline__ void swap16(float v, float& r0, float& r1) { unsigned a = __builtin_bit_cast(unsigned, v), b = a; asm volatile("" : "+v"(b)); auto rr = __builtin_amdgcn_permlane16_swap(a, b, false, false); const unsigned u0 = rr[0], u1 = rr[1]; r0 = __builtin_bit_cast(float, u0); r1 = __builtin_bit_cast(float, u1); }
__device__ __forceinline__ void swap32(float v, float& r0, float& r1) { unsigned a = __builtin_bit_cast(unsigned, v), b = a; asm volatile("" : "+v"(b)); auto rr = __builtin_amdgcn_permlane32_swap(a, b, false, false); const unsigned u0 = rr[0], u1 = rr[1]; r0 = __builtin_bit_cast(float, u0); r1 = __builtin_bit_cast(float, u1); }
__device__ __forceinline__ float xor16_f(float v, int lane) { float r0, r1; swap16(v, r0, r1); return (lane & 16) ? r0 : r1; }
__device__ __forceinline__ float xor32_f(float v, int lane) { float r0, r1; swap32(v, r0, r1); return (lane & 32) ? r0 : r1; }
__device__ __forceinline__ float half_pair_sum(float a, float b) { auto rr = __builtin_amdgcn_permlane32_swap(__builtin_bit_cast(unsigned, a), __builtin_bit_cast(unsigned, b), false, false); const unsigned u0 = rr[0], u1 = rr[1]; return __builtin_bit_cast(float, u0) + __builtin_bit_cast(float, u1); }
__device__ __forceinline__ float half_sum(float v) { v = row_sum(v); float r0, r1; swap16(v, r0, r1); return r0 + r1; }
__device__ __forceinline__ float wave_sum(float v) { v = half_sum(v); float r0, r1; swap32(v, r0, r1); return r0 + r1; }
__device__ __forceinline__ float wave_sum_u(float v) { v = row_sum(v); v += dppf<0x142>(v); v += dppf<0x143>(v); return rdlane_f(v, 63); }
__device__ __forceinline__ float wave_max(float v) { v = fmaxf(v, dppf<0xB1>(v)); v = fmaxf(v, dppf<0x4E>(v)); v = fmaxf(v, dppf<0x141>(v)); v = fmaxf(v, dppf<0x140>(v)); float r0, r1; swap16(v, r0, r1); v = fmaxf(r0, r1); swap32(v, r0, r1); return fmaxf(r0, r1); }
typedef __amdgpu_buffer_rsrc_t rsrc_t;
__device__ __forceinline__ rsrc_t make_rsrc(const void* p, unsigned bytes) { return __builtin_amdgcn_make_buffer_rsrc((void*)p, 0, bytes, 0x00020000); }
__device__ __forceinline__ u32x4 bload16(rsrc_t r, int voff, int soff) { return __builtin_amdgcn_raw_buffer_load_b128(r, voff, soff, 0); }
__device__ __forceinline__ int rfl_i(int v) { return __builtin_amdgcn_readfirstlane(v); }
typedef unsigned u32x3 __attribute__((ext_vector_type(3)));
__device__ __forceinline__ u32x3 bload12(rsrc_t r, int voff) { return __builtin_amdgcn_raw_buffer_load_b96(r, voff, 0, 0); }
__device__ __forceinline__ void dma_row(rsrc_t r, char* lds_dst, int voff, int soff) { __builtin_amdgcn_raw_ptr_buffer_load_lds(r, (__attribute__((address_space(3))) void*)lds_dst, 16, voff, soff, 0, 0); }
#define RAW_BARRIER() __builtin_amdgcn_s_barrier()
#define SETPRIO(n) __builtin_amdgcn_s_setprio(n)
__device__ __forceinline__ unsigned long long ballot64(bool p) { return __builtin_amdgcn_ballot_w64(p); }
__device__ __forceinline__ int mbcnt64(unsigned long long m) { return (int)__builtin_amdgcn_mbcnt_hi((unsigned)(m >> 32), __builtin_amdgcn_mbcnt_lo((unsigned)m, 0u)); }
typedef unsigned u32x6 __attribute__((ext_vector_type(6)));
typedef float f32x32 __attribute__((ext_vector_type(32)));
__device__ __forceinline__ u32x6 cvt_2xpk16_fp6(f32x16 a, f32x16 b) { return __builtin_amdgcn_cvt_scalef32_2xpk16_fp6_f32(a, b, 1.0f); }
__device__ __forceinline__ f32x32 cvt_pk32_fp6(u32x6 p) { return __builtin_amdgcn_cvt_scalef32_pk32_f32_fp6(p, 1.0f); }
__device__ __forceinline__ void dma_row12(rsrc_t r, char* lds_dst, int voff12, int soff) { __builtin_amdgcn_raw_ptr_buffer_load_lds(r, (__attribute__((address_space(3))) void*)lds_dst, 12, voff12, soff, 0, 0); }
__device__ __forceinline__ void dma_piece(rsrc_t r, char* lds_dst, int gvoff) { __builtin_amdgcn_raw_ptr_buffer_load_lds(r, (__attribute__((address_space(3))) void*)lds_dst, 16, gvoff, 0, 0, 0); }
typedef int i32x8 __attribute__((ext_vector_type(8)));
__device__ __forceinline__ f32x4 mfma_fp6_fp8(u32x6 a, i32x8 b, f32x4 c) {
    i32x8 a8; a8[0] = (int)a[0]; a8[1] = (int)a[1]; a8[2] = (int)a[2]; a8[3] = (int)a[3]; a8[4] = (int)a[4]; a8[5] = (int)a[5]; a8[6] = 0; a8[7] = 0;
    return __builtin_amdgcn_mfma_scale_f32_16x16x128_f8f6f4(a8, b, c, 2  , 0  , 0, 0x7f7f7f7f, 0, 0x7f7f7f7f);
}
__device__ __forceinline__ f32x4 mfma_fp4_fp8(u32x4 a, i32x8 b, f32x4 c) {
    i32x8 a8; a8[0] = (int)a[0]; a8[1] = (int)a[1]; a8[2] = (int)a[2]; a8[3] = (int)a[3]; a8[4] = 0; a8[5] = 0; a8[6] = 0; a8[7] = 0;
    return __builtin_amdgcn_mfma_scale_f32_16x16x128_f8f6f4(a8, b, c, 4  , 0  , 0, 0x7f7f7f7f, 0, 0x7f7f7f7f);
}
#define CVT_FP4X2(w, SEL) __builtin_amdgcn_cvt_scalef32_pk_f32_fp4((w), 1.0f, (SEL))
#define CVT_PK_FP4(old, a, b, SEL) __builtin_amdgcn_cvt_scalef32_pk_fp4_f32((old), (a), (b), 1.0f, (SEL))
#define VM_WAIT(N) asm volatile("s_waitcnt vmcnt(" #N ")" ::: "memory")
#define LGKM_WAIT0() asm volatile("s_waitcnt lgkmcnt(0)" ::: "memory")
#define SCHED_FENCE() __builtin_amdgcn_sched_barrier(0)
__device__ __forceinline__ float fexp2(float x) { return __builtin_amdgcn_exp2f(x); }
__device__ __forceinline__ float frcp(float x) { return __builtin_amdgcn_rcpf(x); }
__device__ __forceinline__ float frsq(float x) { return __builtin_amdgcn_rsqf(x); }
__device__ __forceinline__ f32x16 mfma32(bf16x8 a, bf16x8 b, f32x16 c) { return __builtin_amdgcn_mfma_f32_32x32x16_bf16(a, b, c, 0, 0, 0); }
__device__ __forceinline__ f32x4 mfma16(bf16x8 a, bf16x8 b, f32x4 c) { return __builtin_amdgcn_mfma_f32_16x16x32_bf16(a, b, c, 0, 0, 0); }
#else
#define WSYNC() emu_barrier(g_wave_bar[TID >> 6], 64)
#define SETPRIO(n)
#define OPAQUE(x)
#define TIE8(A, i)
#define TIEM(x)
#endif

#ifndef CFG_BATCH
#define CFG_BATCH 32
#endif
#ifndef CFG_SEQ
#define CFG_SEQ 2048
#endif
constexpr int D = 1024, BATCH = CFG_BATCH, SEQ = CFG_SEQ, T = BATCH * SEQ;
constexpr int NTHR = 512;
constexpr int PCOLS = 2560;
constexpr int PC_R = 0, PC_K = 512, PC_V = 1024, PC_Q = 1536, PC_AK = 2048, PC_AV = 2176, PC_LORA = 2304;
constexpr int NEXP = 16384;
constexpr float RMS_EPS = 1e-6f, LNX_EPS = 64e-5f;

constexpr size_t MiB = 1u << 20;
constexpr size_t al1m(size_t x) { return (x + MiB - 1) / MiB * MiB; }
constexpr size_t WS_CTL = 0;
constexpr size_t WS_BIASP = 1 * MiB;
constexpr size_t WS_WINT = 2 * MiB;
constexpr size_t WS_WOUTT = 7 * MiB;
constexpr size_t WS_WFT = 9 * MiB;
constexpr size_t WS_UV6 = 16 * MiB;
constexpr size_t WS_FRG = 50 * MiB;
constexpr size_t WS_SSQ = 52 * MiB;
constexpr size_t WS_USC = 48 * MiB;
constexpr size_t WS_VSC = 49 * MiB;
constexpr size_t WS_H = 80 * MiB;
constexpr size_t WS_Y = WS_H + al1m((size_t)T * D * 2);
constexpr size_t WS_P = WS_Y + al1m((size_t)T * D * 2);
constexpr size_t WS_IDX = WS_P + al1m((size_t)T * PCOLS * 2);
constexpr size_t WS_GATE = WS_IDX + al1m((size_t)T * 128 * 4);
constexpr size_t WS_END = WS_GATE + al1m((size_t)T * 128 * 4);

struct Params {
    const float* x; const float* ln1_g; const float* w_in; const float* b_attn; const float* mu_shift; const float* w0; const float* w_up; const float* a0;
    const float* a_up; const float* g_up; const float* k_k; const float* k_a; const float* r_k; const float* lnx_w; const float* lnx_b; const float* attn_sinks;
    const float* attn_norm_g; const float* w_out; const float* ln2_g; const float* peer_wq; const float* peer_subkeys; const float* peer_u; const float* peer_v; const float* lnf_g;
    float* out; unsigned char* ws;
};

#ifndef EMU
typedef __bf16 hwbf16x2 __attribute__((ext_vector_type(2)));
__device__ __forceinline__ unsigned f2bf(float f) { const __bf16 b = (__bf16)f; return (unsigned)__builtin_bit_cast(unsigned short, b); }
__device__ __forceinline__ unsigned pk2(float lo, float hi) { const f32x2 v = {lo, hi}; const hwbf16x2 b = __builtin_convertvector(v, hwbf16x2); return __builtin_bit_cast(unsigned, b); }
#else
__device__ __forceinline__ unsigned f2bf(float f) { unsigned u = __builtin_bit_cast(unsigned, f); return (u + 0x7fffu + ((u >> 16) & 1u)) >> 16; }
__device__ __forceinline__ unsigned pk2(float lo, float hi) { return f2bf(lo) | (f2bf(hi) << 16); }
#endif
__device__ __forceinline__ float bfl(unsigned short b) { return __builtin_bit_cast(float, (unsigned)b << 16); }
__device__ __forceinline__ float bf_lo(unsigned w) { return __builtin_bit_cast(float, w << 16); }
__device__ __forceinline__ float bf_hi(unsigned w) { return __builtin_bit_cast(float, w & 0xffff0000u); }
__device__ __forceinline__ int crow(int r, int hi) { return (r & 3) + 8 * (r >> 2) + 4 * hi; }
__device__ __forceinline__ int win_src_col(int n) { if (n < 1536) return n; if (n < 2304) return n + 160; if (n < 2464) return n - 768; return -1; }
__device__ __forceinline__ float sigmoidf_(float z) { return 1.f / (1.f + expf(-z)); }

__device__ __forceinline__ void p0_transpose_tile(const float* W, int K, int ldw, unsigned short* WT, int k0, int n0, int mode, float* tl) {
    const int t = TID, kk = t >> 6, nn = t & 63;
    const int sc = mode ? win_src_col(n0 + nn) : (n0 + nn);
#pragma unroll
    for (int i = 0; i < 8; ++i) { const int k = kk + 8 * i; tl[k * 65 + nn] = sc >= 0 ? W[(size_t)(k0 + k) * ldw + sc] : 0.f; }
    BSYNC();
    const int n = t >> 3, c = t & 7;
    u32x4 o;
    o.x = pk2(tl[(8 * c + 0) * 65 + n], tl[(8 * c + 1) * 65 + n]); o.y = pk2(tl[(8 * c + 2) * 65 + n], tl[(8 * c + 3) * 65 + n]);
    o.z = pk2(tl[(8 * c + 4) * 65 + n], tl[(8 * c + 5) * 65 + n]); o.w = pk2(tl[(8 * c + 6) * 65 + n], tl[(8 * c + 7) * 65 + n]);
    *(u32x4*)(WT + (size_t)(n0 + n) * K + k0 + 8 * c) = o;
    BSYNC();
}
__device__ __forceinline__ void p0_wfused_item(const float* wq, const float* sk, const float* g2, unsigned short* WfT, int hc, int kt, float* lds) {
    float* skl = lds;
    float* wql = lds + 128 * 129;
    for (int i = TID; i < 16384; i += NTHR) { const int n = i >> 7, d = i & 127; skl[n * 129 + d] = sk[(size_t)hc * 16384 + i]; }
    for (int i = TID; i < 64 * 128; i += NTHR) { const int k = i >> 7, d = i & 127; wql[d * 64 + k] = wq[(size_t)(kt * 64 + k) * 2048 + hc * 128 + d]; }
    BSYNC();
    const int n = TID & 127, kg = TID >> 7;
    float acc[16];
#pragma unroll
    for (int j = 0; j < 16; ++j) acc[j] = 0.f;
    for (int d = 0; d < 128; ++d) {
        const float a = skl[n * 129 + d]; const float* bp = wql + d * 64 + kg * 16;
#pragma unroll
        for (int j = 0; j < 16; ++j) acc[j] += a * bp[j];
    }
#pragma unroll
    for (int j = 0; j < 16; ++j) acc[j] *= g2[kt * 64 + kg * 16 + j];
    unsigned short* dst = WfT + (size_t)(hc * 128 + n) * D + kt * 64 + kg * 16;
    u32x4 o0, o1;
    o0.x = pk2(acc[0], acc[1]); o0.y = pk2(acc[2], acc[3]); o0.z = pk2(acc[4], acc[5]); o0.w = pk2(acc[6], acc[7]);
    o1.x = pk2(acc[8], acc[9]); o1.y = pk2(acc[10], acc[11]); o1.z = pk2(acc[12], acc[13]); o1.w = pk2(acc[14], acc[15]);
    *(u32x4*)dst = o0; *(u32x4*)(dst + 8) = o1;
    BSYNC();
}
__device__ __forceinline__ void rms_rows(const float* X, const float* g, unsigned short* H, int gw, int ngw) {
    const int lane = TID & 63;
    f32x4 gg[4];
#pragma unroll
    for (int j = 0; j < 4; ++j) gg[j] = ((const f32x4*)g)[lane + 64 * j];
    for (int m0 = 4 * gw; m0 < T; m0 += 4 * ngw) {
        f32x4 v[4][4]; float s[4];
#pragma unroll
        for (int r = 0; r < 4; ++r) { const f32x4* xr = (const f32x4*)(X + (size_t)(m0 + r) * D) + lane;
#pragma unroll
            for (int j = 0; j < 4; ++j) v[r][j] = xr[64 * j]; }
#pragma unroll
        for (int r = 0; r < 4; ++r) { s[r] = 0.f;
#pragma unroll
            for (int j = 0; j < 4; ++j) s[r] += (v[r][j].x * v[r][j].x + v[r][j].y * v[r][j].y) + (v[r][j].z * v[r][j].z + v[r][j].w * v[r][j].w); }
#pragma unroll
        for (int r = 0; r < 4; ++r) { const float rstd = 1.0f / sqrtf(wave_sum_u(s[r]) * (1.f / D) + RMS_EPS);
            u32x2* o8 = (u32x2*)(H + (size_t)(m0 + r) * D) + lane;
#pragma unroll
            for (int j = 0; j < 4; ++j) { u32x2 w; w.x = pk2(v[r][j].x * rstd * gg[j].x, v[r][j].y * rstd * gg[j].y); w.y = pk2(v[r][j].z * rstd * gg[j].z, v[r][j].w * rstd * gg[j].w); o8[64 * j] = w; } }
    }
}
__device__ __forceinline__ void p0_prologue(const Params& p, int bid, int nblk, char* smem) {
    float* lds = (float*)smem;
    unsigned char* ws = p.ws;
    unsigned short* WinT = (unsigned short*)(ws + WS_WINT); unsigned short* WoutT = (unsigned short*)(ws + WS_WOUTT); unsigned short* WfT = (unsigned short*)(ws + WS_WFT);
    constexpr int I_IN = 640, I_OUT = 256, I_WF = 256;
    for (int it = bid; it < I_IN + I_OUT + I_WF; it += nblk) {
        int r = it;
        if (r < I_IN) { p0_transpose_tile(p.w_in, D, 2464, WinT, (r / 40) * 64, (r % 40) * 64, 1, lds); continue; } r -= I_IN;
        if (r < I_OUT) { p0_transpose_tile(p.w_out, D, D, WoutT, (r / 16) * 64, (r % 16) * 64, 0, lds); continue; } r -= I_OUT;
        p0_wfused_item(p.peer_wq, p.peer_subkeys, p.ln2_g, WfT, r / 16, r % 16, lds);
    }
    const size_t gt = (size_t)bid * NTHR + TID, ngt = (size_t)nblk * NTHR;
    if (bid == 0 && TID == 0) { ((unsigned*)(ws + WS_CTL))[1024] = 0u; ((unsigned*)(ws + WS_CTL))[1027] = 0u; }
    float* biasP = (float*)(ws + WS_BIASP);
    for (size_t i = gt; i < (size_t)PCOLS; i += ngt) biasP[i] = (i >= 1536 && i < 2304) ? p.b_attn[i - 1536] : 0.f;
    {
        const int lane = TID & 63; const int gw = bid * (NTHR / 64) + (TID >> 6), ngw = nblk * (NTHR / 64);
        bool lowfirst;
        { const f32x2 t_ = CVT_FP4X2(0x21u, 0); lowfirst = (t_.x == 0.5f); }
        const unsigned pt_ = CVT_PK_FP4(0u, 0.5f, 1.0f, 0) & 255u; const bool enc_lowfirst = (pt_ == 0x21u);
        if (gw == 0 && lane == 0 && pt_ != 0x21u && pt_ != 0x12u) ((unsigned*)(ws + WS_CTL))[1027] = 1u;
        if (gw == 0) {
            bool ok = true;
#pragma unroll
            for (int c = 0; c < 16; c += 2) { const unsigned w_ = (unsigned)(c | ((c + 1) << 4)) * 0x01010101u; const int m0 = c & 7, m1 = (c + 1) & 7;
                float e0 = m0 == 0 ? 0.f : m0 == 1 ? 0.5f : m0 == 2 ? 1.f : m0 == 3 ? 1.5f : m0 == 4 ? 2.f : m0 == 5 ? 3.f : m0 == 6 ? 4.f : 6.f; if (c & 8) e0 = -e0;
                float e1 = m1 == 0 ? 0.f : m1 == 1 ? 0.5f : m1 == 2 ? 1.f : m1 == 3 ? 1.5f : m1 == 4 ? 2.f : m1 == 5 ? 3.f : m1 == 6 ? 4.f : 6.f; if ((c + 1) & 8) e1 = -e1;
                const f32x2 d0 = CVT_FP4X2(w_, 0), d1 = CVT_FP4X2(w_, 1), d2 = CVT_FP4X2(w_, 2), d3 = CVT_FP4X2(w_, 3);
                const float x0 = lowfirst ? e0 : e1, x1 = lowfirst ? e1 : e0;
                ok = ok && d0.x == x0 && d0.y == x1 && d1.x == x0 && d1.y == x1 && d2.x == x0 && d2.y == x1 && d3.x == x0 && d3.y == x1; }
            if (lane == 0) ((unsigned*)(ws + WS_CTL))[1025] = ok ? 0u : 1u;
        }
        if (gw == 0) {
            const int r_ = lane & 15, kg = lane >> 4;
            u32x4 ta4 = {0u, 0u, 0u, 0u}; i32x8 tb8 = {0, 0, 0, 0, 0, 0, 0, 0};
#pragma unroll
            for (int i = 0; i < 32; ++i) { const int ka = 32 * kg + i, kb = 64 * (i >> 4) + 16 * kg + (i & 15);
                const bool ona = (ka & 3) == (((ka >> 2) + (ka >> 4)) & 3), onb = (kb & 3) == (((kb >> 2) + (kb >> 4)) & 3);
                const unsigned ca = ona ? (unsigned)((5 * r_ + 3 * ka + 7 * (ka >> 3) + 11 * (ka >> 5)) & 15) : 0u;
                ta4[i >> 3] |= ca << (4 * (i & 7));
                const int cb = (kb + 3 * r_ + (kb >> 3) + 3 * (kb >> 4) + (kb >> 5)) & 7;
                const unsigned fb = !onb ? 0u : ((cb < 4 ? 0x40B83800u : 0x44B030C0u) >> (8 * (cb & 3))) & 255u; tb8[i >> 2] |= (int)(fb << (8 * (i & 3))); }
            const f32x4 tc = mfma_fp4_fp8(ta4, tb8, (f32x4){0.f, 0.f, 0.f, 0.f});
            float bad = 0.f;
#pragma unroll
            for (int j = 0; j < 4; ++j) { const int rw = 4 * kg + j; float e = 0.f;
#pragma unroll 4
                for (int m = 0; m < 32; ++m) { const int k = 4 * m + ((m + (m >> 2)) & 3);
                    const unsigned ca = (unsigned)((5 * rw + 3 * k + 7 * (k >> 3) + 11 * (k >> 5)) & 15); const f32x2 av2_ = CVT_FP4X2(ca | (ca << 4), 0); const float av = av2_[0];
                    const int cb = (k + 3 * r_ + (k >> 3) + 3 * (k >> 4) + (k >> 5)) & 7; const f32x2 bv2_ = cvt_pk_f32_fp8(((cb < 4 ? 0x40B83800u : 0x44B030C0u) >> (8 * (cb & 3))) & 255u, false); const float bv = bv2_[0];
                    e += av * bv; }
                bad += (tc[j] == e) ? 0.f : 1.f; }
            bad = wave_sum(bad);
            if (lane == 0) ((unsigned*)(ws + WS_CTL))[1026] = bad > 0.f ? 1u : 0u;
        }
#pragma unroll 1
        for (int row0 = gw; row0 < NEXP; row0 += 2 * ngw) {
            f32x4 xu[2][4], xv[2][4];
#pragma unroll
            for (int r = 0; r < 2; ++r) { const int row = row0 + r * ngw; const f32x4* su_ = (const f32x4*)(p.peer_u + (size_t)row * D) + lane; const f32x4* sv_ = (const f32x4*)(p.peer_v + (size_t)row * D) + lane;
#pragma unroll
                for (int j = 0; j < 4; ++j) { xu[r][j] = su_[64 * j]; xv[r][j] = sv_[64 * j]; } }
#pragma unroll
            for (int r = 0; r < 2; ++r) { const int row = row0 + r * ngw;
#pragma unroll
                for (int hv_ = 0; hv_ < 2; ++hv_) {
                    float mx = 0.f;
#pragma unroll
                    for (int j = 0; j < 4; ++j) { const f32x4 a4 = hv_ ? xv[r][j] : xu[r][j]; mx = fmaxf(mx, fmaxf(fmaxf(fabsf(a4.x), fabsf(a4.y)), fmaxf(fabsf(a4.z), fabsf(a4.w)))); }
                    mx = wave_max(mx);
                    const float inv = mx > 0.f ? mx * (1.f / 6.f) : 1.f, sc_ = 1.f / inv;
                    const int flip_ = (hv_ && !lowfirst) ? 1 : 0;
                    unsigned short* dst = (unsigned short*)(ws + WS_UV6 + (size_t)row * 1024 + hv_ * 512) + lane;
                    const bool swp_ = ((flip_ != 0) == enc_lowfirst);
#pragma unroll
                    for (int j = 0; j < 4; ++j) { const f32x4 a4 = (hv_ ? xv[r][j] : xu[r][j]) * sc_;
                        unsigned pk = CVT_PK_FP4(0u, swp_ ? a4.y : a4.x, swp_ ? a4.x : a4.y, 0); pk = CVT_PK_FP4(pk, swp_ ? a4.w : a4.z, swp_ ? a4.z : a4.w, 1);
                        dst[64 * j] = (unsigned short)pk; }
                    if (lane == 0) ((float*)(ws + (hv_ ? WS_VSC : WS_USC)))[row] = inv;
                } }
        }
    }
    for (size_t i = gt; i < (size_t)8 * 10 * 2 * 64; i += ngt) {
        const int ln = (int)(i & 63), tc = (int)((i >> 6) & 1), f = (int)((i >> 7) % 10), hd = (int)((i >> 7) / 10);
        const float* src = f < 2 ? p.w_up : (f < 4 ? p.a_up : p.g_up); const int ks = f < 2 ? f : (f < 4 ? f - 2 : f - 4);
        const int cg = hd * 64 + 32 * tc + (ln & 31);
        float v8[8];
#pragma unroll
        for (int j = 0; j < 8; ++j) v8[j] = src[(16 * ks + 8 * (ln >> 5) + j) * 512 + cg];
        u32x4 o; o.x = pk2(v8[0], v8[1]); o.y = pk2(v8[2], v8[3]); o.z = pk2(v8[4], v8[5]); o.w = pk2(v8[6], v8[7]);
        ((u32x4*)(ws + WS_FRG))[i] = o;
    }
    rms_rows(p.x, p.ln1_g, (unsigned short*)(ws + WS_H), bid * (NTHR / 64) + (TID >> 6), nblk * (NTHR / 64));
}

constexpr int MP = 72;
constexpr int SLOTB = 64 * MP * 2;
constexpr int LP = 168;
constexpr int RW_PAR = 0;
constexpr int RW_SB = 4096;
constexpr int RW_AT = RW_SB + SLOTB, RW_RT = RW_AT + SLOTB, RW_BHT = RW_RT + SLOTB, RW_KHT = RW_BHT + SLOTB, RW_VT = RW_KHT + SLOTB, RW_GM = RW_VT + SLOTB;
constexpr int RW_RA = RW_GM + SLOTB;
constexpr int RW_P = RW_RA, RW_PT = RW_P + SLOTB, RW_TM = RW_PT + SLOTB, RW_AAK = RW_TM + SLOTB, RW_ARB = RW_AAK + SLOTB, RW_ARK = RW_ARB + SLOTB;
constexpr int RW_RB = RW_RA + 6 * SLOTB;
constexpr int RW_BH = RW_RB, RW_KH = RW_RB + SLOTB, RW_WT = RW_RB, RW_UT = RW_RB + SLOTB;
constexpr int RW_TOT = RW_RB + 3 * SLOTB;
constexpr int RW_BON = RW_TOT + 2048;
constexpr int RW_GC = RW_BON + 256;
constexpr int RW_PT2 = RW_GC + 256;
constexpr int RW_END = RW_PT2 + SLOTB;
static_assert(RW_END <= 163840, "RWKV LDS map");

__device__ __forceinline__ f32x16 zero16() { f32x16 z;
#pragma unroll
    for (int i = 0; i < 16; ++i) z[i] = 0.f; return z; }
__device__ __forceinline__ f32x16 tile_mm(f32x16 acc, const unsigned short* A, const unsigned short* B, int tr, int tc, int lane) {
    const unsigned short* ap = A + (32 * tr + (lane & 31)) * MP + 8 * (lane >> 5);
    const unsigned short* bp = B + (32 * tc + (lane & 31)) * MP + 8 * (lane >> 5);
#pragma unroll
    for (int ks = 0; ks < 4; ++ks) acc = mfma32(*(const bf16x8*)(ap + 16 * ks), *(const bf16x8*)(bp + 16 * ks), acc);
    return acc;
}
__device__ __forceinline__ f32x16 load_rm(const unsigned short* M, int tr, int tc, int lane) {
    const unsigned short* base = M + (32 * tr + 4 * (lane >> 5)) * MP + 32 * tc + (lane & 31);
    f32x16 acc;
#pragma unroll
    for (int r = 0; r < 16; ++r) acc[r] = bfl(base[((r & 3) + 8 * (r >> 2)) * MP]);
    return acc;
}
__device__ __forceinline__ void store_rm(const f32x16& acc, unsigned short* M, int tr, int tc, int lane) {
    unsigned short* base = M + (32 * tr + 4 * (lane >> 5)) * MP + 32 * tc + (lane & 31);
#pragma unroll
    for (int r = 0; r < 16; ++r) base[((r & 3) + 8 * (r >> 2)) * MP] = (unsigned short)f2bf(acc[r]);
}
__device__ __forceinline__ void store_tr(const f32x16& acc, unsigned short* MT, int tr, int tc, int lane) {
    unsigned short* base = MT + (32 * tc + (lane & 31)) * MP + 32 * tr + 4 * (lane >> 5);
#pragma unroll
    for (int g4 = 0; g4 < 4; ++g4) { u32x2 w; w.x = pk2(acc[4 * g4], acc[4 * g4 + 1]); w.y = pk2(acc[4 * g4 + 2], acc[4 * g4 + 3]); *(u32x2*)(base + 8 * g4) = w; }
}
__device__ __forceinline__ float fexp(float x) { return __expf(x); }

__device__ __forceinline__ void rwkv_unit(const Params& p, int b, int h, char* smem) {
    float* par = (float*)(smem + RW_PAR);
    unsigned short* Sb = (unsigned short*)(smem + RW_SB);
    unsigned short* At = (unsigned short*)(smem + RW_AT); unsigned short* Rt = (unsigned short*)(smem + RW_RT);
    unsigned short* BhT = (unsigned short*)(smem + RW_BHT); unsigned short* KhT = (unsigned short*)(smem + RW_KHT);
    unsigned short* VT = (unsigned short*)(smem + RW_VT); unsigned short* Gm = (unsigned short*)(smem + RW_GM);
    float* lres = (float*)(smem + RW_RA); float* Ol = (float*)(smem + RW_RA);
    unsigned short* Pm = (unsigned short*)(smem + RW_P); unsigned short* PT = (unsigned short*)(smem + RW_PT); unsigned short* Tm = (unsigned short*)(smem + RW_TM); unsigned short* PT2 = (unsigned short*)(smem + RW_PT2);
    unsigned short* Aak = (unsigned short*)(smem + RW_AAK); unsigned short* Arb = (unsigned short*)(smem + RW_ARB); unsigned short* Ark = (unsigned short*)(smem + RW_ARK);
    unsigned short* lora = (unsigned short*)(smem + RW_RB); unsigned short* Bh = (unsigned short*)(smem + RW_BH); unsigned short* Kh = (unsigned short*)(smem + RW_KH);
    unsigned short* WT = (unsigned short*)(smem + RW_WT); unsigned short* UT = (unsigned short*)(smem + RW_UT);
    float* tot = (float*)(smem + RW_TOT); float* bon = (float*)(smem + RW_BON); float* gC = (float*)(smem + RW_GC);
    const unsigned short* P = (const unsigned short*)(p.ws + WS_P);
    unsigned short* Y = (unsigned short*)(p.ws + WS_Y);
    int tid = TID; OPAQUE(tid);
    const int w = tid >> 6; int lane = tid & 63;
    const int ch = tid & 63, tg = w;
    const int q4 = w & 3, qtr = q4 >> 1, qtc = q4 & 1;
    if (tid < 64) {
        const int c = h * 64 + tid;
        par[tid] = p.mu_shift[c]; par[64 + tid] = p.mu_shift[512 + c]; par[128 + tid] = p.mu_shift[1024 + c];
        par[352 + tid] = p.w0[c]; par[416 + tid] = p.a0[c]; par[480 + tid] = p.k_k[c]; par[544 + tid] = p.k_a[c]; par[608 + tid] = p.r_k[c]; par[672 + tid] = p.lnx_w[c]; par[736 + tid] = p.lnx_b[c];
    }
    if (tid < 160) par[192 + tid] = p.mu_shift[1536 + tid];
    for (int i = tid; i < 64 * MP; i += NTHR) Sb[i] = 0;
    const bf16x8* frg = (const bf16x8*)(p.ws + WS_FRG) + ((size_t)(h * 10 + (w < 4 ? 0 : 4)) * 2 + qtc) * 64 + (tid & 63);
    f32x16 sreg = zero16();
    const float mu_r = p.mu_shift[h * 64 + ch], mu_k = p.mu_shift[512 + h * 64 + ch], mu_v = p.mu_shift[1024 + h * 64 + ch];
    const float c_w0 = p.w0[h * 64 + ch], c_a0 = p.a0[h * 64 + ch], c_kk = p.k_k[h * 64 + ch], c_ka = p.k_a[h * 64 + ch], c_rk = p.r_k[h * 64 + ch], c_lw = p.lnx_w[h * 64 + ch], c_lb = p.lnx_b[h * 64 + ch];
    u32x4 lcu[3], lpv[3];
#define RW_LOAD_LORA(SS) do { _Pragma("unroll") for (int qi = 0; qi < 3; ++qi) { int it_ = tid + NTHR * qi; it_ = it_ < 64 * 20 ? it_ : 64 * 20 - 1; const int tok_ = it_ / 20, c_ = it_ - tok_ * 20; \
        const unsigned short* row_ = P + ((size_t)b * SEQ + (SS) + tok_) * PCOLS + PC_LORA + 8 * c_; lcu[qi] = *(const u32x4*)row_; lpv[qi] = *(const u32x4*)(row_ - (((SS) + tok_) > 0 ? PCOLS : 0)); } } while (0)
#define RW_LOAD_RKV(SS) do { _Pragma("unroll") for (int i_ = 0; i_ < 9; ++i_) { int sp_ = (SS) + 8 * tg - 1 + i_; sp_ = sp_ < 0 ? 0 : sp_; const unsigned short* row_ = P + ((size_t)b * SEQ + sp_) * PCOLS + h * 64 + ch; \
        rr[i_] = bfl(row_[PC_R]); kr[i_] = bfl(row_[PC_K]); vr[i_] = bfl(row_[PC_V]); } } while (0)
    RW_LOAD_LORA(0);
    BSYNC();
#pragma unroll 1
    for (int s0 = 0; s0 < SEQ; s0 += 64) {
        const size_t tbase = (size_t)b * SEQ + s0;
        OPAQUE(lane);
        const int hh = lane >> 5, l31 = lane & 31;
        float rr[9], kr[9], vr[9];
        RW_LOAD_RKV(s0);
        bf16x8 fr[6];
#pragma unroll
        for (int f = 0; f < 6; ++f) fr[f] = frg[128 * (w < 4 ? (f & 3) : f)];
#pragma unroll
        for (int qi = 0; qi < 3; ++qi) {
            const int it = tid + NTHR * qi;
            if (it < 64 * 20) {
                const int tok = it / 20, c = it - tok * 20;
                const u32x4 cu = lcu[qi]; u32x4 pv = lpv[qi];
                if (s0 + tok == 0) pv = (u32x4){0u, 0u, 0u, 0u};
                float o8[8];
#pragma unroll
                for (int j = 0; j < 4; ++j) {
                    const unsigned cw = cu[j], pw = pv[j];
                    const float c0 = bf_lo(cw), c1 = bf_hi(cw), p0 = bf_lo(pw), p1 = bf_hi(pw);
                    const float m0 = par[192 + 8 * c + 2 * j], m1 = par[192 + 8 * c + 2 * j + 1];
                    o8[2 * j] = c0 + m0 * (p0 - c0); o8[2 * j + 1] = c1 + m1 * (p1 - c1);
                }
                if (c < 4) {
#pragma unroll
                    for (int j = 0; j < 8; ++j) { const float e2 = fexp(2.f * o8[j]); o8[j] = 1.f - 2.f * frcp(e2 + 1.f); }
                } else if (c >= 8) {
#pragma unroll
                    for (int j = 0; j < 8; ++j) o8[j] = frcp(1.f + fexp(-o8[j]));
                }
                u32x4 ow; ow.x = pk2(o8[0], o8[1]); ow.y = pk2(o8[2], o8[3]); ow.z = pk2(o8[4], o8[5]); ow.w = pk2(o8[6], o8[7]);
                *(u32x4*)(lora + tok * LP + 8 * c) = ow;
            }
        }
        { const int sn = (s0 + 64 < SEQ) ? s0 + 64 : s0; RW_LOAD_LORA(sn); }
        BSYNC();
        {
            const unsigned short* ap = lora + (32 * qtr + l31) * LP + 8 * hh;
            if (w < 4) {
                f32x16 aw = zero16(), aa = zero16();
#pragma unroll
                for (int ks = 0; ks < 2; ++ks) { aw = mfma32(*(const bf16x8*)(ap + 16 * ks), fr[ks], aw); aa = mfma32(*(const bf16x8*)(ap + 32 + 16 * ks), fr[2 + ks], aa); }
                { float* lb = lres + (32 * qtr + 4 * hh) * 64 + 32 * qtc + l31;
#pragma unroll
                for (int r = 0; r < 16; ++r) { lb[((r & 3) + 8 * (r >> 2)) * 64] = aw[r]; lb[4096 + ((r & 3) + 8 * (r >> 2)) * 64] = aa[r]; } }
            } else {
                f32x16 ag = zero16();
#pragma unroll
                for (int ks = 0; ks < 6; ++ks) ag = mfma32(*(const bf16x8*)(ap + 64 + 16 * ks), fr[ks], ag);
                store_rm(ag, Gm, qtr, qtc, lane);
            }
        }
        BSYNC();
        {
            float lw[8], kkv[8], bb[8], km[8], rs[8], vs[8], csl[8];
            float cs = 0.f;
            if (s0 + 8 * tg == 0) { rr[0] = 0.f; kr[0] = 0.f; vr[0] = 0.f; }
#pragma unroll
            for (int i = 0; i < 8; ++i) {
                const int t = 8 * tg + i;
                rs[i] = rr[i + 1] + mu_r * (rr[i] - rr[i + 1]);
                const float ksh = kr[i + 1] + mu_k * (kr[i] - kr[i + 1]);
                vs[i] = vr[i + 1] + mu_v * (vr[i] - vr[i + 1]);
                const float z = -(c_w0 + lres[t * 64 + ch]);
                const float sp = fmaxf(z, 0.f) + __logf(1.f + fexp(-fabsf(z)));
                lw[i] = -fexp(-sp - 0.5f);
                const float alpha = frcp(1.f + fexp(-(c_a0 + lres[4096 + t * 64 + ch])));
                const float kx = ksh * c_kk;
                kkv[i] = kx * frsq(fmaxf(wave_sum_u(kx * kx), 1e-24f));
                bb[i] = kkv[i] * alpha;
                km[i] = ksh * (1.f + (alpha - 1.f) * c_ka);
                const float bo = wave_sum_u(rs[i] * km[i] * c_rk);
                if (ch == 0) bon[t] = bo;
                cs += lw[i]; csl[i] = cs;
            }
            tot[tg * 64 + ch] = cs;
            BSYNC();
            float pre = 0.f;
#pragma unroll
            for (int g = 0; g < 8; ++g) { const float tv = tot[g * 64 + ch]; pre += (g < tg) ? tv : 0.f; }
            u32x4 bt, kt, vt; float tb[8], tk[8];
#pragma unroll
            for (int i = 0; i < 8; ++i) {
                const int t = 8 * tg + i;
                const float c = pre + csl[i];
                const float gt = fexp(c), gp = fexp(c - lw[i]), gi = fexp(-c);
                At[t * MP + ch] = (unsigned short)f2bf(-kkv[i] * gp);
                Rt[t * MP + ch] = (unsigned short)f2bf(rs[i] * gt);
                tb[i] = bb[i] * gi; tk[i] = km[i] * gi;
                Bh[t * MP + ch] = (unsigned short)f2bf(tb[i]);
                Kh[t * MP + ch] = (unsigned short)f2bf(tk[i]);
            }
            bt.x = pk2(tb[0], tb[1]); bt.y = pk2(tb[2], tb[3]); bt.z = pk2(tb[4], tb[5]); bt.w = pk2(tb[6], tb[7]);
            kt.x = pk2(tk[0], tk[1]); kt.y = pk2(tk[2], tk[3]); kt.z = pk2(tk[4], tk[5]); kt.w = pk2(tk[6], tk[7]);
            vt.x = pk2(vs[0], vs[1]); vt.y = pk2(vs[2], vs[3]); vt.z = pk2(vs[4], vs[5]); vt.w = pk2(vs[6], vs[7]);
            *(u32x4*)(BhT + ch * MP + 8 * tg) = bt; *(u32x4*)(KhT + ch * MP + 8 * tg) = kt; *(u32x4*)(VT + ch * MP + 8 * tg) = vt;
            if (tg == 7) gC[ch] = fexp(pre + csl[7]);
        }
        BSYNC();
        f32x16 tacc = zero16();
        {
            const int prod = w >> 1, tr = w & 1;
            const unsigned short* Lm = prod < 2 ? At : Rt; const unsigned short* Rm = (prod & 1) ? Kh : Bh;
            unsigned short* dst = prod == 0 ? Pm : (prod == 1 ? Aak : (prod == 2 ? Arb : Ark));
#pragma unroll
            for (int tc = 0; tc < 2; ++tc) {
                f32x16 acc = zero16();
                if (tc <= tr) acc = tile_mm(acc, Lm, Rm, tr, tc, lane);
                { const int dlt = 32 * tc + l31 - 32 * tr - 4 * hh - (prod < 2 ? 0 : 1);
#pragma unroll
                for (int r = 0; r < 16; ++r) acc[r] = (dlt < (r & 3) + 8 * (r >> 2)) ? acc[r] : 0.f; }
                store_rm(acc, dst, tr, tc, lane);
                if (prod == 0) {
                    store_tr(acc, PT, tr, tc, lane);
                    if (tc > tr) store_tr(acc, PT2, tr, tc, lane);
                    { const int dl2 = 32 * tc + l31 - 32 * tr - 4 * hh;
#pragma unroll
                    for (int r = 0; r < 16; ++r) acc[r] += (dl2 == (r & 3) + 8 * (r >> 2)) ? 1.f : 0.f; }
                    store_rm(acc, Tm, tr, tc, lane);
                    if (tc == 0) tacc = acc;
                }
            }
        }
        BSYNC();
        if (w >= 4) { f32x16 acc = zero16(); acc = tile_mm(acc, At, Sb, qtr, qtc, lane); acc = tile_mm(acc, Aak, VT, qtr, qtc, lane); store_tr(acc, WT, qtr, qtc, lane); }
        {
            const int wu = rfl_i(w);
            const bool isq = (wu >= 2 && wu <= 4), itu = (wu < 2 || wu == 5);
            const int trS = (wu == 0 || wu == 2) ? 0 : 1, tcS = (wu == 4 || wu == 5) ? 1 : 0;
            if (wu == 5) tacc = load_rm(Tm, 1, 1, lane);
#pragma unroll 1
            for (int j = 1; j <= 6; ++j) {
                const bool sq = isq && j <= 5, tu = itu && j >= 2;
                if (sq) tacc = tile_mm(zero16(), Pm, PT, trS, tcS, lane);
                if (tu) tacc = tile_mm(tacc, Tm, PT, trS, tcS, lane);
                BSYNC();
                if (sq) { store_rm(tacc, Pm, trS, tcS, lane); store_tr(tacc, PT, trS, tcS, lane); }
                if (tu) store_rm(tacc, Tm, trS, tcS, lane);
                BSYNC();
            }
        }
        if (w < 4) { f32x16 acc = zero16(); acc = tile_mm(acc, Tm, WT, qtr, qtc, lane); store_tr(acc, UT, qtr, qtc, lane); }
        BSYNC();
        if (w < 4) {
            f32x16 oacc = zero16();
            oacc = tile_mm(oacc, Rt, Sb, qtr, qtc, lane); oacc = tile_mm(oacc, Arb, UT, qtr, qtc, lane); oacc = tile_mm(oacc, Ark, VT, qtr, qtc, lane);
            { float* ob = Ol + (32 * qtr + 4 * hh) * 64 + 32 * qtc + l31;
#pragma unroll
            for (int r = 0; r < 16; ++r) ob[((r & 3) + 8 * (r >> 2)) * 64] = oacc[r]; }
        } else {
            sreg = tile_mm(sreg, UT, BhT, qtr, qtc, lane); sreg = tile_mm(sreg, VT, KhT, qtr, qtc, lane);
            const float gc = gC[32 * qtc + l31];
#pragma unroll
            for (int r = 0; r < 16; ++r) sreg[r] *= gc;
        }
        BSYNC();
        if (w >= 4) store_rm(sreg, Sb, qtr, qtc, lane);
#pragma unroll
        for (int i = 0; i < 8; ++i) {
            const int t = 8 * tg + i;
            const float o = Ol[t * 64 + ch];
            const float mean = wave_sum_u(o) * (1.f / 64.f);
            const float dv = o - mean;
            const float var = wave_sum_u(dv * dv) * (1.f / 64.f);
            float y = dv * frsq(var + LNX_EPS) * c_lw + c_lb;
            y = (y + bon[t] * bfl(VT[ch * MP + t])) * bfl(Gm[t * MP + ch]);
            Y[(tbase + t) * D + h * 64 + ch] = (unsigned short)f2bf(y);
        }
    }
    BSYNC();
}

constexpr int KPITCH = 72, VPITCH = 260;
__device__ __forceinline__ void attn_unit(const Params& p, int b, int n, char* smem) {
    unsigned short* Kl = (unsigned short*)smem;
    unsigned short* Vt = Kl + 2 * 256 * KPITCH;
    float* ssl = (float*)(Vt + 2 * 64 * VPITCH);
    float* rstdl = ssl + 1024;
    float* wsf = rstdl + 128;
    unsigned short* ostg = (unsigned short*)(wsf + 256) + (TID >> 6) * (32 * 32);
    const unsigned short* P = (const unsigned short*)(p.ws + WS_P);
    unsigned short* Y = (unsigned short*)(p.ws + WS_Y);
    const int tid = TID, lane = tid & 63, w = tid >> 6, q = lane & 31, hh = lane >> 5, g = w >> 2;
    const long tb = (long)b * SEQ + (long)(n - 1) * 128;
#pragma unroll
    for (int i = tid; i < 4096; i += NTHR) {
        const int c = i & 7, kj = (i >> 3) & 255, gg = i >> 11;
        const bool valid = (n > 0) || (kj >= 128);
        const unsigned short* row = P + (size_t)(valid ? tb + kj : tb + 128 + (kj & 127)) * PCOLS;
        u32x4 kv = *(const u32x4*)(row + PC_AK + gg * 64 + c * 8), vv = *(const u32x4*)(row + PC_AV + gg * 64 + c * 8);
        if (!valid) { kv = (u32x4){0u, 0u, 0u, 0u}; vv = (u32x4){0u, 0u, 0u, 0u}; }
        *(u32x4*)(Kl + (gg * 256 + kj) * KPITCH + c * 8) = kv;
        unsigned short* vd = Vt + (gg * 64 + c * 8) * VPITCH + kj;
        vd[0 * VPITCH] = (unsigned short)(vv.x & 0xffff); vd[1 * VPITCH] = (unsigned short)(vv.x >> 16);
        vd[2 * VPITCH] = (unsigned short)(vv.y & 0xffff); vd[3 * VPITCH] = (unsigned short)(vv.y >> 16);
        vd[4 * VPITCH] = (unsigned short)(vv.z & 0xffff); vd[5 * VPITCH] = (unsigned short)(vv.z >> 16);
        vd[6 * VPITCH] = (unsigned short)(vv.w & 0xffff); vd[7 * VPITCH] = (unsigned short)(vv.w >> 16);
    }
    BSYNC();
    const float sink = p.attn_sinks[w];
    const long tq_blk = (long)b * SEQ + (long)n * 128;
    for (int it = 0; it < 4; ++it) {
        bf16x8 qf[4];
#pragma unroll
        for (int ks = 0; ks < 4; ++ks) qf[ks] = *(const bf16x8*)(P + (size_t)(tq_blk + 32 * it + q) * PCOLS + PC_Q + w * 64 + 16 * ks + 8 * hh);
        f32x16 pb[5];
        float mloc = sink;
        const int iq = 32 * it + q;
#pragma unroll
        for (int bi = 0; bi < 5; ++bi) {
            const int jb = it + bi;
            const bool active = (n > 0) || (jb >= 4);
#pragma unroll
            for (int r = 0; r < 16; ++r) pb[bi][r] = 0.f;
            if (active) {
#pragma unroll
                for (int ks = 0; ks < 4; ++ks) { const bf16x8 kf = *(const bf16x8*)(Kl + (g * 256 + 32 * jb + q) * KPITCH + 16 * ks + 8 * hh); pb[bi] = mfma32(kf, qf[ks], pb[bi]); }
            }
#pragma unroll
            for (int r = 0; r < 16; ++r) {
                const int kj = 32 * jb + crow(r, hh);
                const bool ok = active && (kj >= iq + 1) && (kj <= iq + 128);
                const float s = ok ? pb[bi][r] * 0.125f : -1e30f;
                pb[bi][r] = s; mloc = fmaxf(mloc, s);
            }
        }
        mloc = fmaxf(mloc, xor32_f(mloc, lane));
        float lsum = 0.f;
#pragma unroll
        for (int bi = 0; bi < 5; ++bi)
#pragma unroll
            for (int r = 0; r < 16; ++r) { const float e = fexp(pb[bi][r] - mloc); pb[bi][r] = e; lsum += e; }
        lsum += xor32_f(lsum, lane);
        lsum += fexp(sink - mloc);
        f32x16 o[2];
#pragma unroll
        for (int r = 0; r < 16; ++r) { o[0][r] = 0.f; o[1][r] = 0.f; }
#pragma unroll
        for (int bi = 0; bi < 5; ++bi) {
            const int jb = it + bi;
            const bool active = (n > 0) || (jb >= 4);
            if (active) {
#pragma unroll
                for (int s2 = 0; s2 < 2; ++s2) {
                    bf16x8 pa;
#pragma unroll
                    for (int j = 0; j < 8; ++j) pa[j] = (short)f2bf(pb[bi][8 * s2 + j]);
#pragma unroll
                    for (int dt = 0; dt < 2; ++dt) {
                        const unsigned short* vp = Vt + (g * 64 + 32 * dt + q) * VPITCH + 32 * jb + 16 * s2 + 4 * hh;
                        const bf16x4 lo = *(const bf16x4*)vp, hi = *(const bf16x4*)(vp + 8);
                        const bf16x8 vf = (bf16x8){lo[0], lo[1], lo[2], lo[3], hi[0], hi[1], hi[2], hi[3]};
                        o[dt] = mfma32(pa, vf, o[dt]);
                    }
                }
            }
        }
        if (hh == 0) wsf[w * 32 + q] = 1.f / lsum;
        WSYNC();
        float ss[16];
#pragma unroll
        for (int r = 0; r < 16; ++r) { const float il = wsf[w * 32 + crow(r, hh)]; o[0][r] *= il; o[1][r] *= il; ss[r] = o[0][r] * o[0][r] + o[1][r] * o[1][r]; }
        WSYNC();
#pragma unroll
        for (int r = 0; r < 16; ++r) { const float s = half_sum(ss[r]); if (q == 0) ssl[(32 * it + crow(r, hh)) * 8 + w] = s; }
#pragma unroll
        for (int dt = 0; dt < 2; ++dt) {
            unsigned short* tb = ostg + (4 * hh) * 32 + q;
#pragma unroll
            for (int r = 0; r < 16; ++r) tb[((r & 3) + 8 * (r >> 2)) * 32] = (unsigned short)f2bf(o[dt][r]);
            WSYNC();
            const int rq = lane >> 1, hc = lane & 1;
            const u32x4 v0 = *(const u32x4*)(ostg + rq * 32 + 16 * hc), v1 = *(const u32x4*)(ostg + rq * 32 + 16 * hc + 8);
            unsigned short* yp = Y + (size_t)(tq_blk + 32 * it + rq) * D + 512 + w * 64 + 32 * dt + 16 * hc;
            *(u32x4*)yp = v0; *(u32x4*)(yp + 8) = v1;
            WSYNC();
        }
    }
    BSYNC();
    if (tid < 128) { float s = 0.f;
#pragma unroll
        for (int j = 0; j < 8; ++j) s += ssl[tid * 8 + j];
        rstdl[tid] = 1.0f / sqrtf(s * (1.f / 512.f) + RMS_EPS); }
    BSYNC();
    for (int i = tid; i < 128 * 64; i += NTHR) {
        const int qi = i >> 6, c8 = (i & 63) * 8;
        unsigned short* yp = Y + (size_t)(tq_blk + qi) * D + 512 + c8;
        const u32x4 v = *(const u32x4*)yp; const float rs = rstdl[qi];
        const f32x4 ga = *(const f32x4*)(p.attn_norm_g + c8), gb = *(const f32x4*)(p.attn_norm_g + c8 + 4);
        u32x4 ov;
        ov.x = pk2(bf_lo(v.x) * rs * ga[0], bf_hi(v.x) * rs * ga[1]); ov.y = pk2(bf_lo(v.y) * rs * ga[2], bf_hi(v.y) * rs * ga[3]);
        ov.z = pk2(bf_lo(v.z) * rs * gb[0], bf_hi(v.z) * rs * gb[1]); ov.w = pk2(bf_lo(v.w) * rs * gb[2], bf_hi(v.w) * rs * gb[3]);
        *(u32x4*)yp = ov;
    }
    BSYNC();
}

__device__ __forceinline__ void ce_desc(float& a, float& b) { const float hi = fmaxf(a, b), lo = fminf(a, b); a = hi; b = lo; }
__device__ __forceinline__ void sort16_desc(float (&k)[16]) {
#pragma unroll
    for (int size = 2; size <= 16; size *= 2)
#pragma unroll
        for (int stride = size / 2; stride > 0; stride /= 2)
#pragma unroll
            for (int i = 0; i < 16; ++i) { const int j = i ^ stride; if (j > i) { if ((i & size) == 0) ce_desc(k[i], k[j]); else ce_desc(k[j], k[i]); } }
}
__device__ __forceinline__ void merge_top16(float (&g)[16], const float (&s)[16]) {
#pragma unroll
    for (int i = 0; i < 16; ++i) g[i] = fmaxf(g[i], s[15 - i]);
#pragma unroll
    for (int stride = 8; stride > 0; stride /= 2)
#pragma unroll
        for (int i = 0; i < 16; ++i) { const int j = i ^ stride; if (j > i) ce_desc(g[i], g[j]); }
}
__device__ __forceinline__ float key7(float v, unsigned n) { return __builtin_bit_cast(float, (__builtin_bit_cast(unsigned, v) & ~127u) | (127u - n)); }
__device__ __forceinline__ float clean7(float k) { return __builtin_bit_cast(float, __builtin_bit_cast(unsigned, k) & ~127u); }
__device__ __forceinline__ float key8(float v, unsigned code) { return __builtin_bit_cast(float, (__builtin_bit_cast(unsigned, v) & ~255u) | code); }
__device__ __forceinline__ void topk_stage12(float* S, float* lists, const bool alias) {
    const int tid = TID, row = tid & 127, grp = (tid >> 7) & 1, half = tid >> 8;
    float g[16];
    {
        const float* src = S + row * 260 + grp * 128 + half * 64;
#pragma unroll 1
        for (int q = 0; q < 4; ++q) {
            float sgrp[16];
#pragma unroll
            for (int c = 0; c < 16; c += 4) { const f32x4 v = *(const f32x4*)(src + 16 * q + c); const float v0 = v[0], v1 = v[1], v2 = v[2], v3 = v[3];
                const unsigned nb = (unsigned)(half * 64 + 16 * q + c);
                sgrp[c] = key7(v0, nb); sgrp[c + 1] = key7(v1, nb + 1); sgrp[c + 2] = key7(v2, nb + 2); sgrp[c + 3] = key7(v3, nb + 3); }
            sort16_desc(sgrp);
            if (q == 0) {
#pragma unroll
                for (int i = 0; i < 16; ++i) g[i] = sgrp[i];
            } else merge_top16(g, sgrp);
        }
    }
    if (alias) BSYNC();
    float* slot = lists + (row * 2 + grp) * 16;
    if (half == 1) {
#pragma unroll
        for (int i = 0; i < 16; ++i) slot[i] = g[i];
    }
    BSYNC();
    if (half == 0) {
        float o[16];
#pragma unroll
        for (int i = 0; i < 16; ++i) o[i] = slot[i];
        merge_top16(g, o);
#pragma unroll
        for (int i = 0; i < 16; ++i) slot[i] = g[i];
    }
    BSYNC();
}
__device__ __forceinline__ void topk_stage3(const float* lists0, const float* lists1, int trow0, int hd, int* IDX, float* GATE) {
    const int tid = TID, row = tid & 127, which = (tid >> 7) & 1;
    if (tid < 256) {
        const float* al = (which ? lists1 : lists0) + (row * 2) * 16; const float* bl = al + 16;
        float a[16], bs[16];
#pragma unroll
        for (int i = 0; i < 16; ++i) { a[i] = clean7(al[i]); bs[i] = clean7(bl[i]); }
        const float NEGK = -3.0e38f;
        float m0[16], m1[16];
#pragma unroll
        for (int j = 0; j < 16; ++j) m0[j] = key8(a[0] + bs[j], (unsigned)j);
#pragma unroll
        for (int j = 0; j < 8; ++j) m1[j] = key8(a[1] + bs[j], (unsigned)(16 + j));
#pragma unroll
        for (int j = 0; j < 5; ++j) m1[8 + j] = key8(a[2] + bs[j], (unsigned)(32 + j));
        m1[13] = key8(a[8] + bs[0], 128u); m1[14] = key8(a[9] + bs[0], 144u); m1[15] = key8(a[10] + bs[0], 160u);
        sort16_desc(m1); merge_top16(m0, m1);
#pragma unroll
        for (int j = 0; j < 4; ++j) m1[j] = key8(a[3] + bs[j], (unsigned)(48 + j));
#pragma unroll
        for (int j = 0; j < 3; ++j) m1[4 + j] = key8(a[4] + bs[j], (unsigned)(64 + j));
#pragma unroll
        for (int j = 0; j < 2; ++j) { m1[7 + j] = key8(a[5] + bs[j], (unsigned)(80 + j)); m1[9 + j] = key8(a[6] + bs[j], (unsigned)(96 + j)); m1[11 + j] = key8(a[7] + bs[j], (unsigned)(112 + j)); }
        m1[13] = key8(a[11] + bs[0], 176u); m1[14] = key8(a[12] + bs[0], 192u); m1[15] = key8(a[13] + bs[0], 208u);
        sort16_desc(m1); merge_top16(m0, m1);
        { const float c0 = key8(a[14] + bs[0], 224u), c1 = key8(a[15] + bs[0], 240u);
          m1[0] = fmaxf(c0, c1); m1[1] = fminf(c0, c1);
#pragma unroll
          for (int i = 2; i < 16; ++i) m1[i] = NEGK; }
        merge_top16(m0, m1);
        float den = 0.f;
        const float mx = __builtin_bit_cast(float, __builtin_bit_cast(unsigned, m0[0]) & ~255u);
#pragma unroll
        for (int k = 0; k < 16; ++k) { const float sv = __builtin_bit_cast(float, __builtin_bit_cast(unsigned, m0[k]) & ~255u); den += fexp(sv - mx); }
        const float inv = 1.f / den;
        int* ip = IDX + (size_t)(trow0 + 128 * which + row) * 128 + hd * 16; float* gp = GATE + (size_t)(trow0 + 128 * which + row) * 128 + hd * 16;
#pragma unroll
        for (int k = 0; k < 16; ++k) {
            const unsigned kb = __builtin_bit_cast(unsigned, m0[k]); const unsigned code = kb & 255u;
            const unsigned abits = __builtin_bit_cast(unsigned, al[code >> 4]), bbits = __builtin_bit_cast(unsigned, bl[code & 15u]);
            ip[k] = (127 - (int)(abits & 127u)) * 128 + (127 - (int)(bbits & 127u)); gp[k] = fexp(__builtin_bit_cast(float, kb & ~255u) - mx) * inv;
        }
    }
    BSYNC();
}

__device__ __forceinline__ float gelu_erf(float v) { return 0.5f * v * (1.f + erff(v * 0.70710678118654752f)); }
__device__ __forceinline__ float reduce4(const float (&d)[4], int lane) {
    const bool b5 = (lane & 32) != 0, b4 = (lane & 16) != 0;
    float r[2];
#pragma unroll
    for (int i = 0; i < 2; ++i) { const float x = b5 ? d[2 + i] : d[i], y = b5 ? d[i] : d[2 + i]; r[i] = x + xor32_f(y, lane); }
    const float t = (b4 ? r[1] : r[0]) + xor16_f(b4 ? r[0] : r[1], lane);
    return row_sum(t);
}
__device__ __forceinline__ float gelu_fast(float v) {
    const float t = frcp(fabsf(v) * 0.2316418882f + 1.0f);
    float q = t * 0.5307027145f + (-0.7265760135f); q = q * t + 0.7107068705f; q = q * t + (-0.142248368f); q = q * t + 0.127414796f; q = q * t;
    const float m = v * (q * fexp2(v * v * (-0.72134752044f)));
    return v < 0.f ? m : v - m;
}
#define PEER_UBASE(p) (1024 * (p) + 16 * ((0xC8C84040u >> (4 * (p))) & 15) + ((p) >= 2 ? 256 : 0) + ((p) >= 6 ? 256 : 0))
constexpr int PEER_URING = 8896;
static_assert(PEER_UBASE(7) + 1024 == PEER_URING, "u ring extent");
constexpr int PEER_VRING = 2048;
constexpr int PEER_LIST = 3 * 1024;
constexpr int PEER_XROW = 2 * 2048;
constexpr int PEER_CF = 128;
constexpr int PEER_WAVE = PEER_URING + PEER_VRING + PEER_LIST + PEER_XROW + PEER_CF;
#ifndef PEER_MIDBAR
#define PEER_MIDBAR 0
#endif
static_assert((NTHR / 64) * PEER_WAVE + 8192 <= 163840, "PEER LDS map");
__device__ __forceinline__ void peer_phase(const Params& p, int bid, int nblk, float* OUT_, char* smem, int emask_ = 0x3fff, const int pass = 1) {
#if DUP & 128
#define OUT (pass ? p.out : (float*)(p.ws + WS_P))
#define emask (pass ? 0x3fff : PROBE_EMASK)
#else
#define OUT OUT_
#define emask emask_
#endif
    int lane = TID & 63; const int wv = rfl_i(TID >> 6);
    const int gw = bid * (NTHR / 64) + wv, ngw = nblk * (NTHR / 64);
    char* uring = smem + wv * PEER_WAVE; char* vring = uring + PEER_URING;
    unsigned* se = (unsigned*)(vring + PEER_VRING); float* su = (float*)(se + 256); float* sc = su + 256;
    unsigned short* xrowA = (unsigned short*)((char*)se + PEER_LIST); unsigned short* xrowB = xrowA + 1024;
    float* cfl = (float*)((char*)se + PEER_LIST + PEER_XROW);
    unsigned* keys = (unsigned*)uring; unsigned char* h8A = (unsigned char*)vring; unsigned char* h8B = h8A + 1024;
    const rsrc_t rU = make_rsrc(p.ws + WS_UV6, NEXP * 1024);
    const unsigned* ctl = (const unsigned*)(p.ws + WS_CTL);
    const float poison_scale = (ctl[1025] != 0u || ctl[1026] != 0u || ctl[1027] != 0u) ? 2.f : 1.f;
    const float* USC = (const float*)(p.ws + WS_USC); const float* VSC = (const float*)(p.ws + WS_VSC);
    const int* IDX = (const int*)(p.ws + WS_IDX); const float* GATE = (const float*)(p.ws + WS_GATE);
    const unsigned short* X1 = (const unsigned short*)(p.ws + WS_H);
    float* g2l = (float*)(smem + (NTHR / 64) * PEER_WAVE); float* gfl = g2l + D;
    for (int i_ = TID; i_ < D / 4; i_ += NTHR) { ((f32x4*)g2l)[i_] = ((const f32x4*)p.ln2_g)[i_]; ((f32x4*)gfl)[i_] = ((const f32x4*)p.lnf_g)[i_]; }
    BSYNC();
#define PEER_ROWS(b, O) do { _Pragma("unroll") for (int p_ = 0; p_ < 8; ++p_) O[p_] = (int)se[16 * (b) + 2 * p_ + (lane >> 5)] + vo16u; } while (0)
#define PEER_ISSUE_U(O) do { _Pragma("unroll") for (int p_ = 0; p_ < 8; ++p_) dma_piece(rU, uring + PEER_UBASE(p_), O[p_]); } while (0)
#define PEER_LOAD_V(IDX_, VQ) do { const int vo_ = (int)se[(IDX_) + (lane >> 5)] + voffv; VQ = bload16(rU, vo_, 0); } while (0)
#define PEER_LOAD_VO(VO, VQ) do { VQ = bload16(rU, (VO), 0); } while (0)
#define PEER_PRO_LOAD(tt, XA, XB, I0, I1, G0, G1) do { XA = *(const u32x4*)(X1 + (size_t)(tt) * D + 16 * lane); XB = *(const u32x4*)(X1 + (size_t)(tt) * D + 16 * lane + 8); \
        I0 = IDX[(size_t)(tt) * 128 + lane]; I1 = IDX[(size_t)(tt) * 128 + 64 + lane]; G0 = GATE[(size_t)(tt) * 128 + lane]; G1 = GATE[(size_t)(tt) * 128 + 64 + lane]; } while (0)
#define PEER_PRO_SCALES(I0, I1, G0, G1, U0, U1, C0, C1) do { U0 = USC[I0]; U1 = USC[I1]; C0 = G0 * VSC[I0]; C1 = G1 * VSC[I1]; } while (0)
#define PEER_PRO_SORT(XA, XB, I0, I1, U0, U1, C0, C1, H8, HINV, SE, SU, SC, FLIP, XROW) do { \
        float hf_[16]; float sq_ = 0.f; \
        *(u32x4*)((XROW) + 16 * lane) = XA; *(u32x4*)((XROW) + 16 * lane + 8) = XB; \
        _Pragma("unroll") for (int j = 0; j < 4; ++j) { hf_[2 * j] = bf_lo(XA[j]); hf_[2 * j + 1] = bf_hi(XA[j]); hf_[8 + 2 * j] = bf_lo(XB[j]); hf_[9 + 2 * j] = bf_hi(XB[j]); } \
        _Pragma("unroll") for (int i = 0; i < 16; ++i) sq_ += hf_[i] * hf_[i]; \
        const float rs2_ = 1.0f / sqrtf(wave_sum_u(sq_) * (1.f / D) + RMS_EPS); float hm_ = 0.f; \
        _Pragma("unroll") for (int j = 0; j < 4; ++j) { const f32x4 gv_ = *(const f32x4*)(g2l + 16 * lane + 4 * j); _Pragma("unroll") for (int i = 0; i < 4; ++i) { hf_[4 * j + i] *= rs2_ * gv_[i]; hm_ = fmaxf(hm_, fabsf(hf_[4 * j + i])); } } \
        hm_ = wave_max(hm_); \
        HINV = hm_ > 0.f ? hm_ * (1.f / 224.f) : 1.f; const float hs_ = 1.f / HINV; \
        u32x4 hq_; \
        _Pragma("unroll") for (int j = 0; j < 4; ++j) { unsigned w_ = 0u; w_ = cvt_pk_fp8_f32(hf_[4 * j] * hs_, hf_[4 * j + 1] * hs_, w_, false); w_ = cvt_pk_fp8_f32(hf_[4 * j + 2] * hs_, hf_[4 * j + 3] * hs_, w_, true); hq_[j] = w_; } \
        *(u32x4*)(H8 + 16 * lane) = hq_; \
          \
        const int b0_ = (int)((((unsigned)I0 ^ (FLIP)) >> 12) & 3u), b1_ = (int)((((unsigned)I1 ^ (FLIP)) >> 12) & 3u); \
        int r0_ = 0, r1_ = 0, base_ = 0; \
        _Pragma("unroll") for (int v_ = 0; v_ < 4; ++v_) { const unsigned long long m0_ = ballot64(b0_ == v_), m1_ = ballot64(b1_ == v_); const int c0n_ = __builtin_popcountll(m0_); \
            r0_ = (b0_ == v_) ? base_ + mbcnt64(m0_) : r0_; r1_ = (b1_ == v_) ? base_ + c0n_ + mbcnt64(m1_) : r1_; base_ += c0n_ + __builtin_popcountll(m1_); } \
        SE[r0_] = (unsigned)(I0 & emask) * 1024u; SE[r1_] = (unsigned)(I1 & emask) * 1024u; SU[r0_] = U0; SU[r1_] = U1; SC[r0_] = C0; SC[r1_] = C1; WSYNC(); } while (0)
#define PEER_BATCH(ACC2, HINV, H8, b) do { \
        SETPRIO(0);                                   \
        if ((b) == 0) VM_WAIT(4); else VM_WAIT(8);     \
        f32x4 cac = (f32x4){0.f, 0.f, 0.f, 0.f}; int on_[8]; int vo_[8];     \
        _Pragma("unroll") for (int s_ = 0; s_ < 8; ++s_) vo_[s_] = (int)se[16 * (b) + 8 + 2 * s_ + (lane >> 5)] + voffv; \
        _Pragma("unroll") for (int hf_ = 0; hf_ < 4; ++hf_) { u32x4 a6[2]; \
          _Pragma("unroll") for (int s_ = 0; s_ < 2; ++s_) a6[s_] = *(const u32x4*)(uring + ((2 * hf_ + s_) == 7 ? aoff7 : aoff + 64 * (2 * hf_ + s_))); \
          if (hf_ == 3) { if ((b) < 15) PEER_ROWS((b) + 1, on_); LGKM_WAIT0(); WSYNC(); if ((b) < 15) PEER_ISSUE_U(on_); } \
          _Pragma("unroll") for (int s_ = 0; s_ < 2; ++s_) cac = mfma_fp4_fp8(a6[s_], hB[2 * hf_ + s_], cac); \
          TIEM(cac); } \
        SETPRIO(1);                                   \
          \
        if ((lane & 15) == 0) *(f32x4*)(cfl + q4) = cac; \
        WSYNC(); \
        { const int pr_ = lane & 15; const float a1_ = gelu_fast(cfl[pr_] * su[16 * (b) + pr_] * (HINV)) * sc[16 * (b) + pr_]; \
          if (lane < 16) cfl[16 + lane] = a1_; } \
        WSYNC(); float cfv_[8]; \
        _Pragma("unroll") for (int s_ = 0; s_ < 8; ++s_) cfv_[s_] = cfl[16 + 2 * s_ + (lane >> 5)];     \
        _Pragma("unroll") for (int s_ = 0; s_ < 8; ++s_) { \
            const u32x4 vw_ = vq[s_ & 3]; \
            if (s_ < 4 || (b) < 15) PEER_LOAD_VO(vo_[s_], vq[s_ & 3]); \
            const float cf_ = cfv_[s_]; const f32x2 a2 = (f32x2){cf_, cf_}; \
            _Pragma("unroll") for (int j2 = 0; j2 < 2; ++j2) { f32x2 dd_[8];        \
                { const unsigned w0_ = vw_[2 * j2], w1_ = vw_[2 * j2 + 1]; dd_[0] = CVT_FP4X2(w0_, 0); dd_[1] = CVT_FP4X2(w0_, 1); dd_[2] = CVT_FP4X2(w0_, 2); dd_[3] = CVT_FP4X2(w0_, 3); \
                  dd_[4] = CVT_FP4X2(w1_, 0); dd_[5] = CVT_FP4X2(w1_, 1); dd_[6] = CVT_FP4X2(w1_, 2); dd_[7] = CVT_FP4X2(w1_, 3); } \
                TIE8(dd_, 0); \
                _Pragma("unroll") for (int e_ = 0; e_ < 8; ++e_) ACC2[8 * j2 + e_] = __builtin_elementwise_fma(a2, dd_[e_], ACC2[8 * j2 + e_]); } \
            TIE8(ACC2, 0); TIE8(ACC2, 8); } } while (0)
#define PEER_TOKEN_EPI(tt, ACC2, XROW) do { \
          \
        float v_[16]; float ssq_ = 0.f; const int eb_ = 32 * l31 + 16 * (lane >> 5); \
        _Pragma("unroll") for (int q = 0; q < 8; ++q) { v_[2 * q] = half_pair_sum(ACC2[q].x, ACC2[q + 8].x); v_[2 * q + 1] = half_pair_sum(ACC2[q].y, ACC2[q + 8].y); } \
        _Pragma("unroll") for (int j = 0; j < 2; ++j) { const u32x4 xw_ = *(const u32x4*)((XROW) + eb_ + 8 * j); \
            _Pragma("unroll") for (int i = 0; i < 4; ++i) { v_[8 * j + 2 * i] += bf_lo(xw_[i]); v_[8 * j + 2 * i + 1] += bf_hi(xw_[i]); ssq_ += v_[8 * j + 2 * i] * v_[8 * j + 2 * i] + v_[8 * j + 2 * i + 1] * v_[8 * j + 2 * i + 1]; } } \
        const float rstd_ = (1.0f / sqrtf(wave_sum_u(ssq_) * (1.f / D) + RMS_EPS)) * poison_scale; \
        _Pragma("unroll") for (int j = 0; j < 4; ++j) { const f32x4 gg_ = *(const f32x4*)(gfl + eb_ + 4 * j); f32x4 o_; \
            o_[0] = v_[4 * j] * rstd_ * gg_[0]; o_[1] = v_[4 * j + 1] * rstd_ * gg_[1]; o_[2] = v_[4 * j + 2] * rstd_ * gg_[2]; o_[3] = v_[4 * j + 3] * rstd_ * gg_[3]; \
            *(f32x4*)(OUT + (size_t)(tt) * D + eb_ + 4 * j) = o_; } } while (0)
    const int nround = T / (2 * ngw);
    u32x4 xaA, xbA, xaB, xbB; int i0A, i1A, i0B, i1B; float g0A, g1A, g0B, g1B;
    { const int t0_ = gw, t1_ = ngw + gw; PEER_PRO_LOAD(t0_, xaA, xbA, i0A, i1A, g0A, g1A); PEER_PRO_LOAD(t1_, xaB, xbB, i0B, i1B, g0B, g1B); }
#pragma unroll 1
    for (int rnd = 0; rnd < nround; ++rnd) {
        OPAQUE(lane);
        const int vo16 = 16 * lane, l31 = lane & 31, q4 = 4 * (lane >> 4); const bool lo32 = lane < 32;
        const int ur_ = lane & 15, up_ = ur_ >> 1, uh_ = ur_ & 1, ukg_ = lane >> 4;
        const int ubl_ = PEER_UBASE(up_) + 512 * uh_;
        const int aoff = ubl_ + 16 * (ukg_ + 2 * uh_), aoff7 = ubl_ + 16 * ((28 + ukg_ + 2 * uh_) & 31);
        const int vo16u = 16 * ((lane - 2 * (lane >> 5)) & 31);
        const int voffv = 512 + 16 * l31, hoff = 16 * (lane >> 4);
        const int tA = (2 * rnd) * ngw + gw, tB = (2 * rnd + 1) * ngw + gw;
        f32x2 acc[16]; float hinvA, hinvB;
        {
            float u0A, u1A, c0A, c1A, u0B, u1B, c0B, c1B;
            PEER_PRO_SCALES(i0A, i1A, g0A, g1A, u0A, u1A, c0A, c1A); PEER_PRO_SCALES(i0B, i1B, g0B, g1B, u0B, u1B, c0B, c1B);
            PEER_PRO_SORT(xaA, xbA, i0A, i1A, u0A, u1A, c0A, c1A, h8A, hinvA, se, su, sc, 0u, xrowA);
            PEER_PRO_SORT(xaB, xbB, i0B, i1B, u0B, u1B, c0B, c1B, h8B, hinvB, (se + 128), (su + 128), (sc + 128), 0x3fffu, xrowB);
        }
#pragma unroll
        for (int q = 0; q < 16; ++q) acc[q] = (f32x2){0.f, 0.f};
        LGKM_WAIT0(); WSYNC();
        VM_WAIT(0);
        u32x4 vq[4];
        { int oc_[8]; PEER_ROWS(0, oc_); PEER_ISSUE_U(oc_); WSYNC(); }
#pragma unroll
        for (int s_ = 0; s_ < 4; ++s_) PEER_LOAD_V(2 * s_, vq[s_]);
        i32x8 hB[8];
#pragma unroll 1
        for (int b = 0; b < 16; ++b) {
            const float hinvT = b < 8 ? hinvA : hinvB; const unsigned char* h8T = b < 8 ? h8A : h8B;
            if ((b & 7) == 0) {
#pragma unroll
                for (int s_ = 0; s_ < 8; ++s_) { const u32x4 lo_ = *(const u32x4*)(h8T + hoff + 128 * s_), hi_ = *(const u32x4*)(h8T + hoff + 128 * s_ + 64);
                    hB[s_] = (i32x8){(int)lo_.x, (int)lo_.y, (int)lo_.z, (int)lo_.w, (int)hi_.x, (int)hi_.y, (int)hi_.z, (int)hi_.w}; }
            }
            PEER_BATCH(acc, hinvT, h8T, b);
            if (false) RAW_BARRIER();
            if (b == 7) {
                int tA2 = tA; OPAQUE(tA2); PEER_TOKEN_EPI(tA2, acc, xrowA);
#pragma unroll
                for (int q = 0; q < 16; ++q) acc[q] = (f32x2){0.f, 0.f};
#if PEER_MIDBAR
                RAW_BARRIER();
#endif
            }
        }
        SETPRIO(0);
        if (rnd + 1 < nround) { int tn0_ = (2 * rnd + 2) * ngw + gw, tn1_ = (2 * rnd + 3) * ngw + gw; OPAQUE(tn0_); OPAQUE(tn1_);
            PEER_PRO_LOAD(tn0_, xaA, xbA, i0A, i1A, g0A, g1A); PEER_PRO_LOAD(tn1_, xaB, xbB, i0B, i1B, g0B, g1B); }
        { int tB2 = tB; OPAQUE(tB2); PEER_TOKEN_EPI(tB2, acc, xrowB); }
        BSYNC();
    }
#undef PEER_ISSUE_U
#undef PEER_ROWS
#undef PEER_LOAD_V
#undef PEER_LOAD_VO
#undef PEER_PRO_LOAD
#undef PEER_PRO_SCALES
#undef PEER_PRO_SORT
#undef PEER_BATCH
#undef PEER_TOKEN_EPI
#undef OUT
#undef emask
}

#ifndef EMU
namespace pg8 {
#define PG8_LAS __attribute__((address_space(3)))
typedef unsigned short bf16_t;
typedef short bf16x8 __attribute__((ext_vector_type(8)));
typedef float f32x4 __attribute__((ext_vector_type(4)));
typedef unsigned u32x4 __attribute__((ext_vector_type(4)));
constexpr int BM = 256, BK = 64, HALF = 128, HTB = HALF * BK * 2  , STAGE_BYTES = 8 * HTB, NXCD = 8, WGM = 8;

__host__ __device__ __forceinline__ int lds_byte(int r, int c) { const int st = (r >> 4) * 2 + (c >> 5), rr = r & 15, cc = c & 31, ob = rr * 64 + cc * 2; return st * 1024 + (ob ^ (((ob >> 9) & 1) << 5)); }
__host__ __device__ __forceinline__ void stage_rc(int b, int& R, int& C) { const int st = b / 1024, sb = b % 1024, swz = sb ^ (((sb >> 9) & 1) << 5); R = (st >> 1) * 16 + swz / 64; C = (st & 1) * 32 + (swz % 64) / 2; }
__host__ __device__ __forceinline__ int perm32(int rho) { const int n = rho >> 4, i = rho & 15; return 8 * (i >> 2) + 4 * n + (i & 3); }

struct Unit { int pm, pn; };
struct Gemm { const bf16_t* A; const bf16_t* Bt; int M, N, K; };

struct StaticOrder {
    int nM, nN, nwg, G, c;
    __host__ __device__ void init(int M, int N, int G_, int c_) { nM = M / BM; nN = N / BM; nwg = nM * nN; G = G_; c = c_; }
    __host__ __device__ bool next(int i, Unit& u) const {
        const long L = (long)i * G + c; if (L >= nwg) return false;
        int wgid = (int)L; { const int q = nwg / NXCD, r = nwg % NXCD, xcd = wgid % NXCD, off = wgid / NXCD; wgid = (xcd < r ? xcd * (q + 1) : r * (q + 1) + (xcd - r) * q) + off; }
        const int nig = WGM * nN, gid = wgid / nig, fm = gid * WGM, gsz = (nM - fm) < WGM ? (nM - fm) : WGM;
        u.pm = fm + ((wgid % nig) % gsz); u.pn = (wgid % nig) / gsz; return true;
    }
    __device__ __forceinline__ void a_ready(const Unit&) const {}
    __device__ __forceinline__ void done(const Unit&) const {}
};

__device__ __forceinline__ unsigned cvt_pk_bf16(float lo, float hi) { unsigned r; asm volatile("v_cvt_pk_bf16_f32 %0, %1, %2" : "=v"(r) : "v"(lo), "v"(hi)); return r; }
typedef float f32x2 __attribute__((ext_vector_type(2)));
__device__ __forceinline__ f32x2 gelu_pk(f32x2 v) {
    const f32x2 av = __builtin_elementwise_abs(v), d = av * 0.2316418882f + 1.0f;
    f32x2 t; t.x = __builtin_amdgcn_rcpf(d.x); t.y = __builtin_amdgcn_rcpf(d.y);
    f32x2 q = t * 0.5307027145f + (-0.7265760135f); q = q * t + 0.7107068705f; q = q * t + (-0.142248368f); q = q * t + 0.127414796f; q = q * t;
    const f32x2 s = (v * v) * (-0.72134752044f);
    f32x2 e; e.x = __builtin_amdgcn_exp2f(s.x); e.y = __builtin_amdgcn_exp2f(s.y);
    const f32x2 m = v * (q * e), r = v - m;
    f32x2 o; o.x = v.x < 0.f ? m.x : r.x; o.y = v.y < 0.f ? m.y : r.y; return o;
}

template <int ACT  > struct EpiBf16 {
    static constexpr bool PERM = true, AFTER_DRAIN = false; static_assert(ACT == 0 || ACT == 1, "EpiBf16: ACT is 0 (none) or 1 (gelu_pk)");
    bf16_t* O; int ldc; const float* bias; int split_cols; size_t split_stride; float scale0;
    __device__ __forceinline__ void operator()(const f32x4 (&acc)[2][2][4][2], const Unit& u, int wr, int wc, int fr, int fq) const {
        const int row0 = u.pm * BM + wr * 64 + fr; int colt = u.pn * BM; bf16_t* base = O;
        float sc = 1.f; if (split_cols) { const int t = colt / split_cols; base += (size_t)t * split_stride; colt -= t * split_cols; if (t == 0) sc = scale0; }
        const int col0 = colt + wc * 32 + 8 * fq, bcol0 = u.pn * BM + wc * 32 + 8 * fq;
        f32x4 bv[2][2];
#pragma unroll
        for (int bj = 0; bj < 2; ++bj)
#pragma unroll
            for (int n = 0; n < 2; ++n) bv[bj][n] = bias ? *(const f32x4*)(bias + bcol0 + bj * HALF + 4 * n) : (f32x4){0.f, 0.f, 0.f, 0.f};
#pragma unroll
        for (int ai = 0; ai < 2; ++ai)
#pragma unroll
            for (int m = 0; m < 4; ++m) { bf16_t* rowp = base + (size_t)(row0 + ai * HALF + m * 16) * ldc + col0;
#pragma unroll
                for (int bj = 0; bj < 2; ++bj) { f32x4 v0 = acc[ai][bj][m][0] + bv[bj][0], v1 = acc[ai][bj][m][1] + bv[bj][1];
                    if (ACT == 1) { f32x2 a = gelu_pk((f32x2){v0[0], v0[1]}), b = gelu_pk((f32x2){v0[2], v0[3]}), c = gelu_pk((f32x2){v1[0], v1[1]}), d = gelu_pk((f32x2){v1[2], v1[3]});
                        v0 = (f32x4){a.x, a.y, b.x, b.y}; v1 = (f32x4){c.x, c.y, d.x, d.y}; }
                    v0 = v0 * sc; v1 = v1 * sc; u32x4 w; w.x = cvt_pk_bf16(v0[0], v0[1]); w.y = cvt_pk_bf16(v0[2], v0[3]); w.z = cvt_pk_bf16(v1[0], v1[1]); w.w = cvt_pk_bf16(v1[2], v1[3]);
                    *(u32x4*)(rowp + bj * HALF) = w; } }
    }
};
template <class Epi, class Sched, bool ALIGN_EPI = false, bool SP2 = false>
__device__ __forceinline__ void gemm_phase(PG8_LAS unsigned char* lds, const Gemm g, const Sched& S, const Epi& E) {
    int tid = threadIdx.x; asm volatile("" : "+v"(tid));
    const int wid = __builtin_amdgcn_readfirstlane(tid >> 6), lane = tid & 63, wr = wid >> 2, wc = wid & 3, fr = lane & 15, fq = lane >> 4;
    const int K = g.K, nt = K / BK;
    unsigned voffA[2], voffB[2];
#pragma unroll
    for (int i = 0; i < 2; ++i) { int R, C; stage_rc(tid * 16 + i * 8192, R, C); const int Rb = Epi::PERM ? ((R & ~31) + perm32(R & 31)) : R;
        voffA[i] = (unsigned)(R * K + C) * 2u; voffB[i] = (unsigned)(Rb * K + C) * 2u; }
    const size_t kstep = (size_t)(BK * 2);
    const size_t hstep = (size_t)HALF * K * 2;
    const size_t tstep = 2 * hstep;
    const unsigned ldsw = (unsigned)wid * 1024u;
    const int aoff = lds_byte(wr * 64 + fr, fq * 8), boff = lds_byte(wc * 32 + fr, fq * 8);
#define PG8_SA(b, h) (((b) * 2 + (h)) * HTB)
#define PG8_SB(b, h) ((4 + (b) * 2 + (h)) * HTB)
#define PG8_STAGE(bufoff, gbase, voff) do { _Pragma("unroll") for (int _i = 0; _i < 2; ++_i) \
        __builtin_amdgcn_global_load_lds((const unsigned*)((const char*)(gbase) + (voff)[_i]), (PG8_LAS unsigned*)(lds + (bufoff) + ldsw + _i * 8192), 16, 0, 0); } while (0)
#define PG8_LDA(dst, b, h) do { _Pragma("unroll") for (int m = 0; m < 4; ++m) _Pragma("unroll") for (int k = 0; k < 2; ++k) dst[m][k] = *(const PG8_LAS bf16x8*)(lds + PG8_SA(b, h) + aoff + m * 2048 + k * 1024); } while (0)
#define PG8_LDB(dst, b, h) do { _Pragma("unroll") for (int n = 0; n < 2; ++n) _Pragma("unroll") for (int k = 0; k < 2; ++k) dst[n][k] = *(const PG8_LAS bf16x8*)(lds + PG8_SB(b, h) + boff + n * 2048 + k * 1024); } while (0)
#define PG8_MMA(ai, bj, At, Bt) do { __builtin_amdgcn_s_setprio(1); _Pragma("unroll") for (int m = 0; m < 4; ++m) _Pragma("unroll") for (int n = 0; n < 2; ++n) _Pragma("unroll") for (int k = 0; k < 2; ++k) \
        acc[ai][bj][m][n] = __builtin_amdgcn_mfma_f32_16x16x32_bf16(Bt[n][k], At[m][k], acc[ai][bj][m][n], 0, 0, 0); __builtin_amdgcn_s_setprio(0); } while (0)
#define PG8_WAIT_V(n) asm volatile("s_waitcnt vmcnt(" #n ")" ::: "memory")
#define PG8_WAIT_L(n) asm volatile("s_waitcnt lgkmcnt(" #n ")" ::: "memory")
#define PG8_BAR __builtin_amdgcn_s_barrier()
#define PG8_SCHED __builtin_amdgcn_sched_barrier(0)
    Unit cur, nxt; int ui = 0;
    if (!S.next(0, cur)) return;
    f32x4 acc[2][2][4][2];
#pragma unroll
    for (int a = 0; a < 2; ++a)
#pragma unroll
        for (int b = 0; b < 2; ++b)
#pragma unroll
            for (int m = 0; m < 4; ++m)
#pragma unroll
                for (int n = 0; n < 2; ++n) acc[a][b][m][n] = (f32x4){0.f, 0.f, 0.f, 0.f};
    bf16x8 At[4][2], B0[2][2], B1[2][2];
    const char* cA = (const char*)g.A + (size_t)cur.pm * tstep; const char* cB = (const char*)g.Bt + (size_t)cur.pn * tstep;
    S.a_ready(cur);
    if constexpr (SP2) {
        PG8_STAGE(PG8_SB(0, 0), cB, voffB); PG8_STAGE(PG8_SB(0, 1), cB + hstep, voffB); PG8_STAGE(PG8_SA(0, 0), cA, voffA); PG8_STAGE(PG8_SA(0, 1), cA + hstep, voffA);
        if (wr == 1) PG8_BAR;
        PG8_WAIT_V(2); PG8_BAR;
        PG8_STAGE(PG8_SB(1, 0), cB + kstep, voffB); PG8_STAGE(PG8_SA(1, 0), cA + kstep, voffA); PG8_STAGE(PG8_SB(1, 1), cB + hstep + kstep, voffB);
        PG8_WAIT_V(6); PG8_BAR;
    } else {
        PG8_STAGE(PG8_SB(0, 0), cB, voffB); PG8_STAGE(PG8_SA(0, 0), cA, voffA); PG8_STAGE(PG8_SB(0, 1), cB + hstep, voffB); PG8_STAGE(PG8_SA(0, 1), cA + hstep, voffA);
        if (wr == 1) PG8_BAR;
        PG8_WAIT_V(4); PG8_BAR;
        PG8_STAGE(PG8_SB(1, 0), cB + kstep, voffB); PG8_STAGE(PG8_SA(1, 0), cA + kstep, voffA); PG8_STAGE(PG8_SB(1, 1), cB + hstep + kstep, voffB);
        PG8_WAIT_V(6); PG8_BAR;
    }
    for (;;) {
        const bool has_next = S.next(ui + 1, nxt);
        const char* nA = has_next ? (const char*)g.A + (size_t)nxt.pm * tstep : cA; const char* nB = has_next ? (const char*)g.Bt + (size_t)nxt.pn * tstep : cB;
        for (int t = 0; t < nt; t += 2) {
            const bool last = (t == nt - 2);
            const char* a1 = cA + (size_t)(t + 1) * kstep;
            const char* a2 = last ? nA : cA + (size_t)(t + 2) * kstep; const char* b2 = last ? nB : cB + (size_t)(t + 2) * kstep;
            const char* a3 = a2 + kstep; const char* b3 = b2 + kstep;
            if (last && has_next) S.a_ready(nxt);
            if constexpr (SP2) {
            PG8_LDB(B0, 0, 0); PG8_LDB(B1, 0, 1); PG8_SCHED; PG8_LDA(At, 0, 0); PG8_STAGE(PG8_SA(1, 1), a1 + hstep, voffA);
            PG8_WAIT_V(8); PG8_WAIT_L(0); PG8_BAR; PG8_MMA(0, 0, At, B0); PG8_MMA(0, 1, At, B1); PG8_BAR; PG8_SCHED;
            PG8_LDA(At, 0, 1); PG8_STAGE(PG8_SB(0, 0), b2, voffB); PG8_STAGE(PG8_SB(0, 1), b2 + hstep, voffB); PG8_STAGE(PG8_SA(0, 0), a2, voffA);
            PG8_WAIT_V(8); PG8_WAIT_L(0); PG8_BAR; PG8_MMA(1, 0, At, B0); PG8_MMA(1, 1, At, B1); PG8_BAR; PG8_SCHED;
            PG8_LDB(B0, 1, 0); PG8_LDB(B1, 1, 1); PG8_SCHED; PG8_LDA(At, 1, 0); PG8_STAGE(PG8_SA(0, 1), a2 + hstep, voffA);
            PG8_WAIT_V(8); PG8_WAIT_L(0); PG8_BAR; PG8_MMA(0, 0, At, B0); PG8_MMA(0, 1, At, B1); PG8_BAR; PG8_SCHED;
            PG8_LDA(At, 1, 1); PG8_STAGE(PG8_SB(1, 0), b3, voffB); PG8_STAGE(PG8_SB(1, 1), b3 + hstep, voffB); PG8_STAGE(PG8_SA(1, 0), a3, voffA);
            PG8_WAIT_V(8); PG8_WAIT_L(0); PG8_BAR; PG8_MMA(1, 0, At, B0); PG8_MMA(1, 1, At, B1); PG8_BAR; PG8_SCHED;
            } else {
            PG8_LDB(B0, 0, 0); PG8_SCHED; PG8_LDA(At, 0, 0); PG8_STAGE(PG8_SA(1, 1), a1 + hstep, voffA);
            PG8_WAIT_L(8); PG8_BAR; PG8_WAIT_L(0); PG8_MMA(0, 0, At, B0); PG8_BAR; PG8_SCHED;
            PG8_LDB(B1, 0, 1); PG8_STAGE(PG8_SB(0, 0), b2, voffB);
            PG8_BAR; PG8_WAIT_L(0); PG8_MMA(0, 1, At, B1); PG8_BAR;
            PG8_LDA(At, 0, 1); PG8_STAGE(PG8_SA(0, 0), a2, voffA);
            PG8_BAR; PG8_WAIT_L(0); PG8_MMA(1, 0, At, B0); PG8_BAR; PG8_SCHED;
            PG8_STAGE(PG8_SB(0, 1), b2 + hstep, voffB);
            PG8_WAIT_V(6); PG8_BAR; PG8_MMA(1, 1, At, B1); PG8_BAR;
            PG8_LDB(B0, 1, 0); PG8_SCHED; PG8_LDA(At, 1, 0); PG8_STAGE(PG8_SA(0, 1), a2 + hstep, voffA);
            PG8_WAIT_L(8); PG8_BAR; PG8_WAIT_L(0); PG8_MMA(0, 0, At, B0); PG8_BAR; PG8_SCHED;
            PG8_LDB(B1, 1, 1); PG8_STAGE(PG8_SB(1, 0), b3, voffB);
            PG8_BAR; PG8_WAIT_L(0); PG8_MMA(0, 1, At, B1); PG8_BAR;
            PG8_LDA(At, 1, 1); PG8_STAGE(PG8_SA(1, 0), a3, voffA);
            PG8_BAR; PG8_WAIT_L(0); PG8_MMA(1, 0, At, B0); PG8_BAR; PG8_SCHED;
            PG8_STAGE(PG8_SB(1, 1), b3 + hstep, voffB);
            PG8_WAIT_V(6); PG8_BAR; PG8_MMA(1, 1, At, B1); PG8_BAR;
            }
        }
        if constexpr (ALIGN_EPI) { if (wr == 0) PG8_BAR; }
        if constexpr (!Epi::AFTER_DRAIN) { E(acc, cur, wr, wc, fr, fq); S.done(cur); }
        if (!has_next) break;
#pragma unroll
        for (int a = 0; a < 2; ++a)
#pragma unroll
            for (int b = 0; b < 2; ++b)
#pragma unroll
                for (int m = 0; m < 4; ++m)
#pragma unroll
                    for (int n = 0; n < 2; ++n) acc[a][b][m][n] = (f32x4){0.f, 0.f, 0.f, 0.f};
        cur = nxt; cA = nA; cB = nB; ++ui;
        if constexpr (ALIGN_EPI) { if (wr == 1) PG8_BAR; }
    }
    PG8_WAIT_V(0);
    if constexpr (!ALIGN_EPI) { if (wr == 0) PG8_BAR; }
    PG8_BAR;
    if constexpr (Epi::AFTER_DRAIN) { E.fused(acc, cur, wr, wc, fr, fq, lds, wid, lane); S.done(cur); }
#undef PG8_SA
#undef PG8_SB
#undef PG8_STAGE
#undef PG8_LDA
#undef PG8_LDB
#undef PG8_MMA
#undef PG8_WAIT_V
#undef PG8_WAIT_L
#undef PG8_BAR
#undef PG8_SCHED
}
}

struct OneUnit {
    pg8::Unit u;
    __device__ __forceinline__ bool next(int i, pg8::Unit& o) const { if (i) return false; o = u; return true; }
    __device__ __forceinline__ void a_ready(const pg8::Unit&) const {}
    __device__ __forceinline__ void done(const pg8::Unit&) const {}
};
struct EpiResF32 {
    static constexpr bool PERM = true, AFTER_DRAIN = false;
    const float* base; float* out; pg8::bf16_t* xb; float* ssq;
    __device__ __forceinline__ void operator()(const pg8::f32x4 (&acc)[2][2][4][2], const pg8::Unit& u, int wr, int wc, int fr, int fq) const {
#pragma unroll
        for (int ai = 0; ai < 2; ++ai)
#pragma unroll
            for (int m = 0; m < 4; ++m) {
                const size_t row = (size_t)u.pm * 256 + ai * 128 + wr * 64 + m * 16 + fr;
                float sq = 0.f;
#pragma unroll
                for (int bj = 0; bj < 2; ++bj) {
                    const size_t off = row * D + u.pn * 256 + bj * 128 + wc * 32 + 8 * fq;
                    const pg8::f32x4 b0 = *(const pg8::f32x4*)(base + off), b1 = *(const pg8::f32x4*)(base + off + 4);
                    const pg8::f32x4 v0 = b0 + acc[ai][bj][m][0], v1 = b1 + acc[ai][bj][m][1];
                    u32x4 w; w.x = pk2(v0[0], v0[1]); w.y = pk2(v0[2], v0[3]); w.z = pk2(v1[0], v1[1]); w.w = pk2(v1[2], v1[3]); *(u32x4*)(xb + off) = w;
                    sq += ((v0[0] * v0[0] + v0[1] * v0[1]) + (v0[2] * v0[2] + v0[3] * v0[3])) + ((v1[0] * v1[0] + v1[1] * v1[1]) + (v1[2] * v1[2] + v1[3] * v1[3]));
                }
                sq += __shfl_xor(sq, 16); sq += __shfl_xor(sq, 32);
                if (fq == 0) ssq[row * 16 + u.pn * 4 + wc] = sq;
            }
    }
};
struct EpiTopK {
    static constexpr bool PERM = false, AFTER_DRAIN = true;
    int* IDX; float* GATE; const float* ssq;
    __device__ __forceinline__ void fused(pg8::f32x4 (&acc)[2][2][4][2], const pg8::Unit& u, int wr, int wc, int fr, int fq, PG8_LAS unsigned char* lds, int wid, int lane) const {
        float* S = (float*)lds; float* lists = S + 128 * 260; float* rs = lists + 128 * 2 * 16;
        if (threadIdx.x < 256) {
            const pg8::f32x4* sp = (const pg8::f32x4*)(ssq + ((size_t)u.pm * 256 + threadIdx.x) * 16);
            const pg8::f32x4 a = sp[0], b = sp[1], c = sp[2], d = sp[3];
            const float tot = ((a[0] + a[1]) + (a[2] + a[3])) + ((b[0] + b[1]) + (b[2] + b[3])) + ((c[0] + c[1]) + (c[2] + c[3])) + ((d[0] + d[1]) + (d[2] + d[3]));
            rs[threadIdx.x] = 1.0f / sqrtf(tot * (1.f / D) + RMS_EPS);
        }
        __syncthreads();
#pragma unroll
        for (int ai = 0; ai < 2; ++ai) {
#pragma unroll
            for (int m = 0; m < 4; ++m) {
                const float r = rs[ai * 128 + wr * 64 + m * 16 + fr];
#pragma unroll
                for (int bj = 0; bj < 2; ++bj)
#pragma unroll
                    for (int n = 0; n < 2; ++n) *(pg8::f32x4*)(S + (wr * 64 + m * 16 + fr) * 260 + bj * 128 + wc * 32 + n * 16 + 4 * fq) = acc[ai][bj][m][n] * r;
            }
            __syncthreads();
            topk_stage12(S, ai == 0 ? lists : S, ai == 1);
        }
        topk_stage3(lists, S, u.pm * 256, u.pn, IDX, GATE);
    }
};

__device__ __forceinline__ void grid_bar(unsigned* cnt, unsigned epoch, unsigned nblk) {
    asm volatile("s_waitcnt vmcnt(0)" ::: "memory");
    __syncthreads();
    if (threadIdx.x == 0) {
        __builtin_amdgcn_fence(__ATOMIC_RELEASE, "agent");
        asm volatile("s_waitcnt vmcnt(0)" ::: "memory");
        __hip_atomic_fetch_add(cnt, 1u, __ATOMIC_RELAXED, __HIP_MEMORY_SCOPE_AGENT);
        const unsigned want = epoch * nblk;
        for (unsigned sp = 0; sp < (1u << 22); ++sp) { if (__hip_atomic_load(cnt, __ATOMIC_RELAXED, __HIP_MEMORY_SCOPE_AGENT) >= want) break; __builtin_amdgcn_s_sleep(2); }
        __builtin_amdgcn_fence(__ATOMIC_ACQUIRE, "agent");
        asm volatile("s_waitcnt vmcnt(0)" ::: "memory");
    }
    __syncthreads();
}

#ifndef PHM
#define PHM 255
#endif
#ifndef DUP
#define DUP 0
#endif
#ifndef PROBE_EMASK
#define PROBE_EMASK 0x3fff
#endif
#ifndef PROBE_PV
#define PROBE_PV 0
#endif
constexpr int LDS_BYTES = 163840;
__global__ void __launch_bounds__(NTHR, 2) fwd_kernel(Params p) {
    extern __shared__ __attribute__((aligned(16))) unsigned char lds[];
    cg::grid_group grid = cg::this_grid();
    const int bid = blockIdx.x, nblk = gridDim.x;
    unsigned char* ws = p.ws;
#if PHM & 1
    p0_prologue(p, bid, nblk, (char*)lds);
#if DUP & 1
    p0_prologue(p, bid, nblk, (char*)lds);
#endif
#endif
    grid.sync();
#if PHM & 2
    {
        pg8::Gemm g{(const pg8::bf16_t*)(ws + WS_H), (const pg8::bf16_t*)(ws + WS_WINT), T, PCOLS, D};
        pg8::StaticOrder S; S.init(T, PCOLS, nblk, bid);
        pg8::EpiBf16<0> E{(pg8::bf16_t*)(ws + WS_P), PCOLS, (const float*)(ws + WS_BIASP), 0, 0, 1.f};
        pg8::gemm_phase<pg8::EpiBf16<0>, pg8::StaticOrder, true, true>((PG8_LAS unsigned char*)lds, g, S, E);
    }
#if DUP & 2
    {
        pg8::Gemm g{(const pg8::bf16_t*)(ws + WS_H), (const pg8::bf16_t*)(ws + WS_WINT), T, PCOLS, D};
        pg8::StaticOrder S; S.init(T, PCOLS, nblk, bid);
        pg8::EpiBf16<0> E{(pg8::bf16_t*)(ws + WS_P), PCOLS, (const float*)(ws + WS_BIASP), 0, 0, 1.f};
        pg8::gemm_phase<pg8::EpiBf16<0>, pg8::StaticOrder, true, true>((PG8_LAS unsigned char*)lds, g, S, E);
    }
#endif
#endif
    grid_bar((unsigned*)(ws + WS_CTL) + 1024, 1u, (unsigned)nblk);
#if PHM & 4
#if DUP & 4
    for (int u = bid; u < BATCH * 8; u += nblk) rwkv_unit(p, u >> 3, u & 7, (char*)lds);
#endif
    for (int u = bid; u < BATCH * 8; u += nblk) rwkv_unit(p, u >> 3, u & 7, (char*)lds);
#endif
#if PHM & 8
    for (int u = bid; u < BATCH * (SEQ / 128); u += nblk) attn_unit(p, u / (SEQ / 128), u % (SEQ / 128), (char*)lds);
#if DUP & 8
    for (int u = bid; u < BATCH * (SEQ / 128); u += nblk) attn_unit(p, u / (SEQ / 128), u % (SEQ / 128), (char*)lds);
#endif
#endif
    grid_bar((unsigned*)(ws + WS_CTL) + 1024, 2u, (unsigned)nblk);
#if PHM & 16
    {
        pg8::Gemm g{(const pg8::bf16_t*)(ws + WS_Y), (const pg8::bf16_t*)(ws + WS_WOUTT), T, D, D};
        pg8::StaticOrder S; S.init(T, D, nblk, bid);
        EpiResF32 E{p.x, p.out, (pg8::bf16_t*)(ws + WS_H), (float*)(ws + WS_SSQ)};
        pg8::gemm_phase<EpiResF32, pg8::StaticOrder, true, true>((PG8_LAS unsigned char*)lds, g, S, E);
    }
#if DUP & 16
    {
        pg8::Gemm g{(const pg8::bf16_t*)(ws + WS_Y), (const pg8::bf16_t*)(ws + WS_WOUTT), T, D, D};
        pg8::StaticOrder S; S.init(T, D, nblk, bid);
        EpiResF32 E{p.x, p.out, (pg8::bf16_t*)(ws + WS_H), (float*)(ws + WS_SSQ)};
        pg8::gemm_phase<EpiResF32, pg8::StaticOrder, true, true>((PG8_LAS unsigned char*)lds, g, S, E);
    }
#endif
#endif
    grid_bar((unsigned*)(ws + WS_CTL) + 1024, 3u, (unsigned)nblk);
#if PHM & 64
    {
        pg8::Gemm g{(const pg8::bf16_t*)(ws + WS_H), (const pg8::bf16_t*)(ws + WS_WFT), T, 2048, D};
        pg8::StaticOrder S; S.init(T, 2048, nblk, bid);
        EpiTopK E{(int*)(ws + WS_IDX), (float*)(ws + WS_GATE), (const float*)(ws + WS_SSQ)};
        OneUnit one;
        for (int i = 0; S.next(i, one.u); ++i) pg8::gemm_phase<EpiTopK, OneUnit, false, true>((PG8_LAS unsigned char*)lds, g, one, E);
    }
#if DUP & 64
    {
        pg8::Gemm g{(const pg8::bf16_t*)(ws + WS_H), (const pg8::bf16_t*)(ws + WS_WFT), T, 2048, D};
        pg8::StaticOrder S; S.init(T, 2048, nblk, bid);
        EpiTopK E{(int*)(ws + WS_IDX), (float*)(ws + WS_GATE), (const float*)(ws + WS_SSQ)};
        OneUnit one;
        for (int i = 0; S.next(i, one.u); ++i) pg8::gemm_phase<EpiTopK, OneUnit, false, true>((PG8_LAS unsigned char*)lds, g, one, E);
    }
#endif
#endif
    grid_bar((unsigned*)(ws + WS_CTL) + 1024, 4u, (unsigned)nblk);
#if PHM & 128
#if DUP & 128
#pragma unroll 1
    for (int pass = 0; pass < 2; ++pass) peer_phase(p, bid, nblk, p.out, (char*)lds, 0x3fff, pass);
#else
    peer_phase(p, bid, nblk, p.out, (char*)lds);
#endif
#endif
}

extern "C" void kernel_launch(void* const* d_in, const int* in_sizes, int n_in, void* d_out, int out_size, void* d_ws, size_t ws_size, hipStream_t stream) {
    static int grid = 0;
    if (grid == 0) {
        if (n_in != 24 || out_size != T * D || ws_size < WS_END) { fprintf(stderr, "kernel_launch: unexpected shapes (n_in %d, out %d, ws %zu < %zu)\n", n_in, out_size, ws_size, (size_t)WS_END); grid = -1; return; }
        int dev = 0, cus = 0, per_cu = 0;
        hipGetDevice(&dev);
        hipDeviceGetAttribute(&cus, hipDeviceAttributeMultiprocessorCount, dev);
        hipFuncSetAttribute((const void*)fwd_kernel, hipFuncAttributeMaxDynamicSharedMemorySize, LDS_BYTES);
        hipOccupancyMaxActiveBlocksPerMultiprocessor(&per_cu, (const void*)fwd_kernel, NTHR, LDS_BYTES);
        if (per_cu < 1) { fprintf(stderr, "kernel_launch: occupancy query says %d blocks per CU\n", per_cu); per_cu = 1; }
        if (per_cu > 1) per_cu = 1;
        grid = cus * per_cu;
        if (T % (4 * grid * (NTHR / 64)) != 0 || NEXP % (2 * grid * (NTHR / 64)) != 0) { fprintf(stderr, "kernel_launch: T = %d is not a multiple of 2 * %d waves\n", T, grid * (NTHR / 64)); grid = -1; return; }
        (void)hipGetLastError();
    }
    if (grid < 0) return;
    Params p{};
    const float** pp = (const float**)&p;
    for (int i = 0; i < 24; ++i) pp[i] = (const float*)d_in[i];
    p.out = (float*)d_out; p.ws = (unsigned char*)d_ws;
    void* args[] = {&p};
    hipError_t e = hipLaunchCooperativeKernel((const void*)fwd_kernel, dim3(grid), dim3(NTHR), args, LDS_BYTES, stream);
    if (e != hipSuccess) fprintf(stderr, "cooperative launch failed: %s (grid %d)\n", hipGetErrorString(e), grid);
}
#endif
```
